# Optimizing an MI355X kernel written in HIP

```python
import jax
import jax.numpy as jnp
from jax import lax
import numpy as np

D_MODEL = 1024
BATCH = 16
SEQ = 4096
DEPTH = 4

HEAD_DIM = 64
H_TOTAL = D_MODEL // HEAD_DIM
H_RET = H_TOTAL // 4
H_HGRN = (H_TOTAL - H_RET) // 2
H_FOX = H_TOTAL - H_RET - H_HGRN
D_HGRN = H_HGRN * HEAD_DIM
D_FOX = H_FOX * HEAD_DIM
D_RET = H_RET * HEAD_DIM
D_MIX = D_HGRN + D_FOX + D_RET
IN_COLS = 4 * D_HGRN + 4 * D_FOX + H_FOX + 4 * D_RET
D_FF = 2816
CONV_W = 3
CHUNK = 64
Q_BLOCK = 128
ROPE_BASE = 10000.0
EPS = 1e-6
MIN_FORGET = 1e-12
MASK_VALUE = -1e30

kernel_name = "hymba_style_hgrn2_fox_retnet_convffn"


def rmsnorm(x, gain):
    xf = x.astype(jnp.float32)
    y = xf * lax.rsqrt(jnp.mean(xf * xf, axis=-1, keepdims=True) + EPS)
    return (y * gain.astype(jnp.float32)).astype(x.dtype)


def heads(a, n_heads):
    return a.astype(jnp.float32).reshape(a.shape[0], a.shape[1], n_heads, HEAD_DIM)


def to_chunks(a):
    b, t, h, d = a.shape
    return a.reshape(b, t // CHUNK, CHUNK, h, d).transpose(1, 0, 3, 2, 4)


def from_chunks(a):
    n, b, h, c, d = a.shape
    return a.transpose(1, 0, 3, 2, 4).reshape(b, n * c, h, d)


def rotary_tables(t):
    inv_freq = 1.0 / (ROPE_BASE ** (jnp.arange(0, HEAD_DIM, 2, dtype=jnp.float32) / HEAD_DIM))
    ang = jnp.arange(t, dtype=jnp.float32)[:, None] * inv_freq[None, :]
    return jnp.cos(ang), jnp.sin(ang)


def apply_rotary(x, cos, sin):
    x1, x2 = jnp.split(x, 2, axis=-1)
    c = cos[None, :, None, :]
    s = sin[None, :, None, :]
    return jnp.concatenate([x1 * c - x2 * s, x1 * s + x2 * c], axis=-1)


def hgrn2_mixer(q_in, f_in, i_in, g_in, lb, out_gain):
    b = q_in.shape[0]
    q = heads(q_in, H_HGRN)
    v = heads(i_in, H_HGRN)
    z = heads(f_in, H_HGRN)
    lb = lb.astype(jnp.float32).reshape(H_HGRN, HEAD_DIM)
    f = lb + (1.0 - lb) * jax.nn.sigmoid(z)
    log_f = jnp.log(jnp.maximum(f, MIN_FORGET))
    k = (1.0 - lb) * jax.nn.sigmoid(-z)
    causal = jnp.tril(jnp.ones((CHUNK, CHUNK), dtype=bool))[:, :, None]

    def step(S, inp):
        qc, kc, vc, lfc = inp
        cum = jnp.cumsum(lfc, axis=2)
        diff = cum[:, :, :, None, :] - cum[:, :, None, :, :]
        decay = jnp.where(causal, jnp.exp(jnp.where(causal, diff, 0.0)), 0.0)
        scores = jnp.einsum('bhtk,bhtsk,bhsk->bhts', qc, decay, kc)
        o = (jnp.einsum('bhts,bhsv->bhtv', scores, vc)
             + jnp.einsum('bhtk,bhkv->bhtv', qc * jnp.exp(cum), S))
        last = cum[:, :, -1:, :]
        S = (jnp.exp(last[:, :, 0, :, None]) * S
             + jnp.einsum('bhsk,bhsv->bhkv', kc * jnp.exp(last - cum), vc))
        return S, o

    S0 = jnp.zeros((b, H_HGRN, HEAD_DIM, HEAD_DIM), jnp.float32)
    _, o = lax.scan(step, S0, (to_chunks(q), to_chunks(k), to_chunks(v), to_chunks(log_f)))
    o = from_chunks(o)
    o = rmsnorm(o, out_gain) * jax.nn.silu(heads(g_in, H_HGRN))
    return o.reshape(b, -1, D_HGRN)


def fox_mixer(q_in, k_in, v_in, f_in, g_in, b_f, q_gain, k_gain):
    b, t, _ = q_in.shape
    q = rmsnorm(heads(q_in, H_FOX), q_gain).transpose(0, 2, 1, 3)
    k = rmsnorm(heads(k_in, H_FOX), k_gain).transpose(0, 2, 1, 3)
    v = heads(v_in, H_FOX).transpose(0, 2, 1, 3)
    log_f = jax.nn.log_sigmoid(f_in.astype(jnp.float32) + b_f.astype(jnp.float32))
    F = jnp.cumsum(log_f, axis=1).transpose(0, 2, 1)
    scale = HEAD_DIM ** -0.5
    outs = []
    for blk in range(t // Q_BLOCK):
        t0, t1 = blk * Q_BLOCK, (blk + 1) * Q_BLOCK
        logits = (jnp.einsum('bhtd,bhsd->bhts', q[:, :, t0:t1], k[:, :, :t1]) * scale
                  + (F[:, :, t0:t1, None] - F[:, :, None, :t1]))
        mask = (t0 + jnp.arange(Q_BLOCK))[:, None] >= jnp.arange(t1)[None, :]
        p = jax.nn.softmax(jnp.where(mask, logits, MASK_VALUE), axis=-1)
        outs.append(jnp.einsum('bhts,bhsd->bhtd', p, v[:, :, :t1]))
    o = jnp.concatenate(outs, axis=2).transpose(0, 2, 1, 3)
    o = o * jax.nn.sigmoid(heads(g_in, H_FOX))
    return o.reshape(b, t, D_FOX)


def retention_mixer(q_in, k_in, v_in, g_in, out_gain, cos, sin):
    b = q_in.shape[0]
    q = apply_rotary(heads(q_in, H_RET), cos, sin)
    k = apply_rotary(heads(k_in, H_RET), cos, sin) * (HEAD_DIM ** -0.5)
    v = heads(v_in, H_RET)
    log_gamma = jnp.log1p(-jnp.exp2(-5.0 - jnp.arange(H_RET, dtype=jnp.float32)))
    pos = jnp.arange(CHUNK, dtype=jnp.float32)
    rel = pos[:, None] - pos[None, :]
    intra = jnp.where(rel >= 0, jnp.exp(log_gamma[:, None, None] * jnp.maximum(rel, 0.0)), 0.0)
    q_scale = jnp.exp(log_gamma[:, None] * (pos + 1.0))[:, :, None]
    k_scale = jnp.exp(log_gamma[:, None] * (CHUNK - 1.0 - pos))[:, :, None]
    chunk_decay = jnp.exp(log_gamma * CHUNK)[:, None, None]

    def step(R, inp):
        qc, kc, vc = inp
        scores = jnp.einsum('bhtd,bhsd->bhts', qc, kc) * intra
        o = (jnp.einsum('bhts,bhsv->bhtv', scores, vc)
             + jnp.einsum('bhtd,bhdv->bhtv', qc * q_scale, R))
        R = chunk_decay * R + jnp.einsum('bhsd,bhsv->bhdv', kc * k_scale, vc)
        return R, o

    R0 = jnp.zeros((b, H_RET, HEAD_DIM, HEAD_DIM), jnp.float32)
    _, o = lax.scan(step, R0, (to_chunks(q), to_chunks(k), to_chunks(v)))
    o = from_chunks(o)
    o = rmsnorm(o, out_gain) * jax.nn.silu(heads(g_in, H_RET))
    return o.reshape(b, -1, D_RET)


def conv_gated_mlp(h, w_up, conv_w, conv_b, w_down):
    t = h.shape[1]
    u = h @ w_up
    u_pad = jnp.pad(u, ((0, 0), (CONV_W - 1, 0), (0, 0)))
    acc = conv_b
    for j in range(CONV_W):
        acc = acc + conv_w[j] * u_pad[:, j:j + t]
    gate, val = jnp.split(acc, 2, axis=-1)
    return (jax.nn.silu(gate) * val) @ w_down


def setup_inputs(seed: int = 0) -> dict:
    key = jax.random.key(seed)
    ks = jax.random.split(key, 20)
    f32 = jnp.float32

    def gain(k, shape):
        return 1.0 + 0.02 * jax.random.normal(k, shape, f32)

    x = jax.random.normal(ks[0], (BATCH, SEQ, D_MODEL), f32)
    w_in = jax.random.normal(ks[1], (DEPTH, D_MODEL, IN_COLS), f32) * D_MODEL ** -0.5
    b_fox_f = jax.random.uniform(ks[2], (DEPTH, H_FOX), f32, 1.0, 4.0)
    fox_q_gain = gain(ks[3], (DEPTH, HEAD_DIM))
    fox_k_gain = gain(ks[4], (DEPTH, HEAD_DIM))
    hgrn_lb = 1.0 + 0.1 * jax.random.normal(ks[5], (DEPTH, D_HGRN), f32)
    hgrn_out_gain = gain(ks[6], (DEPTH, H_HGRN, HEAD_DIM))
    ret_out_gain = gain(ks[7], (DEPTH, H_RET, HEAD_DIM))
    w_out = jax.random.normal(ks[8], (DEPTH, D_MIX, D_MODEL), f32) * D_MIX ** -0.5
    g_mix_pre = gain(ks[9], (DEPTH, D_MODEL))
    g_mix_post = gain(ks[10], (DEPTH, D_MODEL))
    w_up = jax.random.normal(ks[11], (DEPTH, D_MODEL, 2 * D_FF), f32) * D_MODEL ** -0.5
    conv_w = 0.2 * jax.random.normal(ks[12], (DEPTH, CONV_W, 2 * D_FF), f32)
    conv_w = conv_w.at[:, CONV_W - 1, :].add(1.0)
    conv_b = 0.02 * jax.random.normal(ks[13], (DEPTH, 2 * D_FF), f32)
    w_down = jax.random.normal(ks[14], (DEPTH, D_FF, D_MODEL), f32) * D_FF ** -0.5
    g_ffn_pre = gain(ks[15], (DEPTH, D_MODEL))
    g_ffn_post = gain(ks[16], (DEPTH, D_MODEL))
    return {"x": x, "w_in": w_in, "b_fox_f": b_fox_f, "fox_q_gain": fox_q_gain,
            "fox_k_gain": fox_k_gain, "hgrn_lb": hgrn_lb, "hgrn_out_gain": hgrn_out_gain,
            "ret_out_gain": ret_out_gain, "w_out": w_out, "g_mix_pre": g_mix_pre,
            "g_mix_post": g_mix_post, "w_up": w_up, "conv_w": conv_w, "conv_b": conv_b,
            "w_down": w_down, "g_ffn_pre": g_ffn_pre, "g_ffn_post": g_ffn_post}


def reference(x, w_in, b_fox_f, fox_q_gain, fox_k_gain, hgrn_lb, hgrn_out_gain, ret_out_gain,
              w_out, g_mix_pre, g_mix_post, w_up, conv_w, conv_b, w_down, g_ffn_pre, g_ffn_post):
    t = x.shape[1]
    widths = [D_HGRN] * 4 + [D_FOX] * 3 + [H_FOX] + [D_FOX] + [D_RET] * 4
    splits = []
    off = 0
    for w in widths[:-1]:
        off += w
        splits.append(off)
    p_lb = jax.nn.softmax(hgrn_lb.astype(jnp.float32), axis=0)
    lower_bounds = jnp.cumsum(p_lb, axis=0) - p_lb[0]
    cos, sin = rotary_tables(t)
    for l in range(DEPTH):
        h = rmsnorm(x, g_mix_pre[l])
        (a_q, a_f, a_i, a_g,
         b_q, b_k, b_v, b_f, b_g,
         c_q, c_k, c_v, c_g) = jnp.split(h @ w_in[l], splits, axis=-1)
        o_a = hgrn2_mixer(a_q, a_f, a_i, a_g, lower_bounds[l], hgrn_out_gain[l])
        o_b = fox_mixer(b_q, b_k, b_v, b_f, b_g, b_fox_f[l], fox_q_gain[l], fox_k_gain[l])
        o_c = retention_mixer(c_q, c_k, c_v, c_g, ret_out_gain[l], cos, sin)
        mixed = jnp.concatenate([o_a, o_b, o_c], axis=-1).astype(x.dtype) @ w_out[l]
        x = x + rmsnorm(mixed, g_mix_post[l])
        h = rmsnorm(x, g_ffn_pre[l])
        x = x + rmsnorm(conv_gated_mlp(h, w_up[l], conv_w[l], conv_b[l], w_down[l]), g_ffn_post[l])
    return x
```

```cpp
#include <hip/hip_runtime.h>
#include <cstdio>
#include <cstdint>
#include <cmath>
namespace pg8 {
#define PG8_LAS __attribute__((address_space(3)))
typedef unsigned short bf16_t;
typedef short bf16x8 __attribute__((ext_vector_type(8)));
typedef float f32x4 __attribute__((ext_vector_type(4)));
typedef unsigned u32x4 __attribute__((ext_vector_type(4)));
constexpr int BM = 256, BK = 64, HALF = 128, HTB = HALF * BK * 2  , STAGE_BYTES = 8 * HTB, NXCD = 8, WGM = 8;

__host__ __device__ __forceinline__ int lds_byte(int r, int c) { const int st = (r >> 4) * 2 + (c >> 5), rr = r & 15, cc = c & 31, ob = rr * 64 + cc * 2; return st * 1024 + (ob ^ (((ob >> 9) & 1) << 5)); }
__host__ __device__ __forceinline__ void stage_rc(int b, int& R, int& C) { const int st = b / 1024, sb = b % 1024, swz = sb ^ (((sb >> 9) & 1) << 5); R = (st >> 1) * 16 + swz / 64; C = (st & 1) * 32 + (swz % 64) / 2; }
__host__ __device__ __forceinline__ int perm32(int rho) { const int n = rho >> 4, i = rho & 15; return 8 * (i >> 2) + 4 * n + (i & 3); }

struct Unit { int pm, pn; };
struct Gemm { const bf16_t* A; const bf16_t* Bt; int M, N, K, lda, ldb; };

struct StaticOrder {
    int nM, nN, nwg, G, c;
    __host__ __device__ void init(int M, int N, int G_, int c_) { nM = M / BM; nN = N / BM; nwg = nM * nN; G = G_; c = c_; }
    __host__ __device__ bool next(int i, Unit& u) const {
        const long L = (long)i * G + c; if (L >= nwg) return false;
        int wgid = (int)L; { const int q = nwg / NXCD, r = nwg % NXCD, xcd = wgid % NXCD, off = wgid / NXCD; wgid = (xcd < r ? xcd * (q + 1) : r * (q + 1) + (xcd - r) * q) + off; }
        const int nig = WGM * nN, gid = wgid / nig, fm = gid * WGM, gsz = (nM - fm) < WGM ? (nM - fm) : WGM;
        u.pm = fm + ((wgid % nig) % gsz); u.pn = (wgid % nig) / gsz; return true;
    }
    __device__ __forceinline__ void a_ready(const Unit&) const {}
    __device__ __forceinline__ void done(const Unit&) const {}
};


__device__ __forceinline__ unsigned cvt_pk_bf16(float lo, float hi) { unsigned r; asm volatile("v_cvt_pk_bf16_f32 %0, %1, %2" : "=v"(r) : "v"(lo), "v"(hi)); return r; }
typedef float f32x2 __attribute__((ext_vector_type(2)));

template <int ACT  > struct EpiBf16 {
    static constexpr bool PERM = true, AFTER_DRAIN = false; static_assert(ACT == 0, "EpiBf16: ACT is 0");
    bf16_t* O; int ldc; const float* bias; int split_cols; size_t split_stride; float scale0;
    __device__ __forceinline__ void operator()(const f32x4 (&acc)[2][2][4][2], const Unit& u, int wr, int wc, int fr, int fq) const {
        const int row0 = u.pm * BM + wr * 64 + fr; int colt = u.pn * BM; bf16_t* base = O;
        float sc = 1.f; if (split_cols) { const int t = colt / split_cols; base += (size_t)t * split_stride; colt -= t * split_cols; if (t == 0) sc = scale0; }
        const int col0 = colt + wc * 32 + 8 * fq, bcol0 = u.pn * BM + wc * 32 + 8 * fq;
        f32x4 bv[2][2];
#pragma unroll
        for (int bj = 0; bj < 2; ++bj)
#pragma unroll
            for (int n = 0; n < 2; ++n) bv[bj][n] = bias ? *(const f32x4*)(bias + bcol0 + bj * HALF + 4 * n) : (f32x4){0.f, 0.f, 0.f, 0.f};
#pragma unroll
        for (int ai = 0; ai < 2; ++ai)
#pragma unroll
            for (int m = 0; m < 4; ++m) { bf16_t* rowp = base + (size_t)(row0 + ai * HALF + m * 16) * ldc + col0;
#pragma unroll
                for (int bj = 0; bj < 2; ++bj) { f32x4 v0 = acc[ai][bj][m][0] + bv[bj][0], v1 = acc[ai][bj][m][1] + bv[bj][1];

                    v0 = v0 * sc; v1 = v1 * sc; u32x4 w; w.x = cvt_pk_bf16(v0[0], v0[1]); w.y = cvt_pk_bf16(v0[2], v0[3]); w.z = cvt_pk_bf16(v1[0], v1[1]); w.w = cvt_pk_bf16(v1[2], v1[3]);
                    *(u32x4*)(rowp + bj * HALF) = w; } }
    }
};

template <class Epi, class Sched, bool ALIGN_EPI = false, bool SP2 = false>
__device__ __forceinline__ void gemm_phase(PG8_LAS unsigned char* lds, const Gemm g, const Sched& S, const Epi& E) {
    int tid_ = threadIdx.x; asm volatile("" : "+v"(tid_)); const int tid = tid_, wid = __builtin_amdgcn_readfirstlane(tid >> 6), lane = tid & 63, wr = wid >> 2, wc = wid & 3, fr = lane & 15, fq = lane >> 4;
    const int K = g.K, nt = K / BK, lda = g.lda, ldb = g.ldb;
    unsigned voffA[2], voffB[2];
#pragma unroll
    for (int i = 0; i < 2; ++i) { int R, C; stage_rc(tid * 16 + i * 8192, R, C); const int Rb = Epi::PERM ? ((R & ~31) + perm32(R & 31)) : R;
        voffA[i] = (unsigned)(R * lda + C) * 2u; voffB[i] = (unsigned)(Rb * ldb + C) * 2u; }
    const size_t kstep = (size_t)(BK * 2);
    const size_t hstepA = (size_t)HALF * lda * 2, hstepB = (size_t)HALF * ldb * 2;
    const size_t tstepA = 2 * hstepA, tstepB = 2 * hstepB;
    const unsigned ldsw = (unsigned)wid * 1024u;
    const int aoff = lds_byte(wr * 64 + fr, fq * 8), boff = lds_byte(wc * 32 + fr, fq * 8);
#define PG8_SA(b, h) (((b) * 2 + (h)) * HTB)
#define PG8_SB(b, h) ((4 + (b) * 2 + (h)) * HTB)
#define PG8_STAGE(bufoff, gbase, voff) do { _Pragma("unroll") for (int _i = 0; _i < 2; ++_i) \
        __builtin_amdgcn_global_load_lds((const unsigned*)((const char*)(gbase) + (voff)[_i]), (PG8_LAS unsigned*)(lds + (bufoff) + ldsw + _i * 8192), 16, 0, 0); } while (0)
#define PG8_LDA(dst, b, h) do { _Pragma("unroll") for (int m = 0; m < 4; ++m) _Pragma("unroll") for (int k = 0; k < 2; ++k) dst[m][k] = *(const PG8_LAS bf16x8*)(lds + PG8_SA(b, h) + aoff + m * 2048 + k * 1024); } while (0)
#define PG8_LDB(dst, b, h) do { _Pragma("unroll") for (int n = 0; n < 2; ++n) _Pragma("unroll") for (int k = 0; k < 2; ++k) dst[n][k] = *(const PG8_LAS bf16x8*)(lds + PG8_SB(b, h) + boff + n * 2048 + k * 1024); } while (0)
#define PG8_MMA(ai, bj, At, Bt) do { __builtin_amdgcn_s_setprio(1); _Pragma("unroll") for (int m = 0; m < 4; ++m) _Pragma("unroll") for (int n = 0; n < 2; ++n) _Pragma("unroll") for (int k = 0; k < 2; ++k) \
        acc[ai][bj][m][n] = __builtin_amdgcn_mfma_f32_16x16x32_bf16(Bt[n][k], At[m][k], acc[ai][bj][m][n], 0, 0, 0); __builtin_amdgcn_s_setprio(0); } while (0)
#define PG8_WAIT_V(n) asm volatile("s_waitcnt vmcnt(" #n ")" ::: "memory")
#define PG8_WAIT_L(n) asm volatile("s_waitcnt lgkmcnt(" #n ")" ::: "memory")
#define PG8_BAR __builtin_amdgcn_s_barrier()
#define PG8_SCHED __builtin_amdgcn_sched_barrier(0)
    Unit cur, nxt; int ui = 0;
    if (!S.next(0, cur)) return;
    f32x4 acc[2][2][4][2];
#pragma unroll
    for (int a = 0; a < 2; ++a)
#pragma unroll
        for (int b = 0; b < 2; ++b)
#pragma unroll
            for (int m = 0; m < 4; ++m)
#pragma unroll
                for (int n = 0; n < 2; ++n) acc[a][b][m][n] = (f32x4){0.f, 0.f, 0.f, 0.f};
    bf16x8 At[4][2], B0[2][2], B1[2][2];
    const char* cA = (const char*)g.A + (size_t)cur.pm * tstepA; const char* cB = (const char*)g.Bt + (size_t)cur.pn * tstepB;
    S.a_ready(cur);
    if constexpr (SP2) {
        PG8_STAGE(PG8_SB(0, 0), cB, voffB); PG8_STAGE(PG8_SB(0, 1), cB + hstepB, voffB); PG8_STAGE(PG8_SA(0, 0), cA, voffA); PG8_STAGE(PG8_SA(0, 1), cA + hstepA, voffA);
        if (wr == 1) PG8_BAR;
        PG8_WAIT_V(2); PG8_BAR;
        PG8_STAGE(PG8_SB(1, 0), cB + kstep, voffB); PG8_STAGE(PG8_SA(1, 0), cA + kstep, voffA); PG8_STAGE(PG8_SB(1, 1), cB + hstepB + kstep, voffB);
        PG8_WAIT_V(6); PG8_BAR;
    } else {
        PG8_STAGE(PG8_SB(0, 0), cB, voffB); PG8_STAGE(PG8_SA(0, 0), cA, voffA); PG8_STAGE(PG8_SB(0, 1), cB + hstepB, voffB); PG8_STAGE(PG8_SA(0, 1), cA + hstepA, voffA);
        if (wr == 1) PG8_BAR;
        PG8_WAIT_V(4); PG8_BAR;
        PG8_STAGE(PG8_SB(1, 0), cB + kstep, voffB); PG8_STAGE(PG8_SA(1, 0), cA + kstep, voffA); PG8_STAGE(PG8_SB(1, 1), cB + hstepB + kstep, voffB);
        PG8_WAIT_V(6); PG8_BAR;
    }
    for (;;) {
        const bool has_next = S.next(ui + 1, nxt);
        const char* nA = has_next ? (const char*)g.A + (size_t)nxt.pm * tstepA : cA; const char* nB = has_next ? (const char*)g.Bt + (size_t)nxt.pn * tstepB : cB;
        for (int t = 0; t < nt; t += 2) {
            const bool last = (t == nt - 2);
            const char* a1 = cA + (size_t)(t + 1) * kstep;
            const char* a2 = last ? nA : cA + (size_t)(t + 2) * kstep; const char* b2 = last ? nB : cB + (size_t)(t + 2) * kstep;
            const char* a3 = a2 + kstep; const char* b3 = b2 + kstep;
            if (last && has_next) S.a_ready(nxt);
            if constexpr (SP2) {
            PG8_LDB(B0, 0, 0); PG8_LDB(B1, 0, 1); PG8_SCHED; PG8_LDA(At, 0, 0); PG8_STAGE(PG8_SA(1, 1), a1 + hstepA, voffA);
            PG8_WAIT_V(8); PG8_WAIT_L(0); PG8_BAR; PG8_MMA(0, 0, At, B0); PG8_MMA(0, 1, At, B1); PG8_BAR; PG8_SCHED;
            PG8_LDA(At, 0, 1); PG8_STAGE(PG8_SB(0, 0), b2, voffB); PG8_STAGE(PG8_SB(0, 1), b2 + hstepB, voffB); PG8_STAGE(PG8_SA(0, 0), a2, voffA);
            PG8_WAIT_V(8); PG8_WAIT_L(0); PG8_BAR; PG8_MMA(1, 0, At, B0); PG8_MMA(1, 1, At, B1); PG8_BAR; PG8_SCHED;
            PG8_LDB(B0, 1, 0); PG8_LDB(B1, 1, 1); PG8_SCHED; PG8_LDA(At, 1, 0); PG8_STAGE(PG8_SA(0, 1), a2 + hstepA, voffA);
            PG8_WAIT_V(8); PG8_WAIT_L(0); PG8_BAR; PG8_MMA(0, 0, At, B0); PG8_MMA(0, 1, At, B1); PG8_BAR; PG8_SCHED;
            PG8_LDA(At, 1, 1); PG8_STAGE(PG8_SB(1, 0), b3, voffB); PG8_STAGE(PG8_SB(1, 1), b3 + hstepB, voffB); PG8_STAGE(PG8_SA(1, 0), a3, voffA);
            PG8_WAIT_V(8); PG8_WAIT_L(0); PG8_BAR; PG8_MMA(1, 0, At, B0); PG8_MMA(1, 1, At, B1); PG8_BAR; PG8_SCHED;
            } else {
            PG8_LDB(B0, 0, 0); PG8_SCHED; PG8_LDA(At, 0, 0); PG8_STAGE(PG8_SA(1, 1), a1 + hstepA, voffA);
            PG8_WAIT_L(8); PG8_BAR; PG8_WAIT_L(0); PG8_MMA(0, 0, At, B0); PG8_BAR; PG8_SCHED;
            PG8_LDB(B1, 0, 1); PG8_STAGE(PG8_SB(0, 0), b2, voffB);
            PG8_BAR; PG8_WAIT_L(0); PG8_MMA(0, 1, At, B1); PG8_BAR;
            PG8_LDA(At, 0, 1); PG8_STAGE(PG8_SA(0, 0), a2, voffA);
            PG8_BAR; PG8_WAIT_L(0); PG8_MMA(1, 0, At, B0); PG8_BAR; PG8_SCHED;
            PG8_STAGE(PG8_SB(0, 1), b2 + hstepB, voffB);
            PG8_WAIT_V(6); PG8_BAR; PG8_MMA(1, 1, At, B1); PG8_BAR;
            PG8_LDB(B0, 1, 0); PG8_SCHED; PG8_LDA(At, 1, 0); PG8_STAGE(PG8_SA(0, 1), a2 + hstepA, voffA);
            PG8_WAIT_L(8); PG8_BAR; PG8_WAIT_L(0); PG8_MMA(0, 0, At, B0); PG8_BAR; PG8_SCHED;
            PG8_LDB(B1, 1, 1); PG8_STAGE(PG8_SB(1, 0), b3, voffB);
            PG8_BAR; PG8_WAIT_L(0); PG8_MMA(0, 1, At, B1); PG8_BAR;
            PG8_LDA(At, 1, 1); PG8_STAGE(PG8_SA(1, 0), a3, voffA);
            PG8_BAR; PG8_WAIT_L(0); PG8_MMA(1, 0, At, B0); PG8_BAR; PG8_SCHED;
            PG8_STAGE(PG8_SB(1, 1), b3 + hstepB, voffB);
            PG8_WAIT_V(6); PG8_BAR; PG8_MMA(1, 1, At, B1); PG8_BAR;
            }
        }
        if constexpr (ALIGN_EPI) { if (wr == 0) PG8_BAR; }
        if constexpr (!Epi::AFTER_DRAIN) { E(acc, cur, wr, wc, fr, fq); S.done(cur); }
        if (!has_next) break;
#pragma unroll
        for (int a = 0; a < 2; ++a)
#pragma unroll
            for (int b = 0; b < 2; ++b)
#pragma unroll
                for (int m = 0; m < 4; ++m)
#pragma unroll
                    for (int n = 0; n < 2; ++n) acc[a][b][m][n] = (f32x4){0.f, 0.f, 0.f, 0.f};
        cur = nxt; cA = nA; cB = nB; ++ui;
        if constexpr (ALIGN_EPI) { if (wr == 1) PG8_BAR; }
    }
    PG8_WAIT_V(0);
    if constexpr (!ALIGN_EPI) { if (wr == 0) PG8_BAR; }
    PG8_BAR;
    if constexpr (Epi::AFTER_DRAIN) { E.fused(acc, cur, wr, wc, fr, fq, lds, wid, lane); S.done(cur); }
#undef PG8_SA
#undef PG8_SB
#undef PG8_STAGE
#undef PG8_LDA
#undef PG8_LDB
#undef PG8_MMA
#undef PG8_WAIT_V
#undef PG8_WAIT_L
#undef PG8_BAR
#undef PG8_SCHED
}
}

#define GAS __attribute__((address_space(1)))
#define LAS __attribute__((address_space(3)))
typedef unsigned short bf16;
typedef unsigned v4u __attribute__((ext_vector_type(4)));
typedef float f32x4 __attribute__((ext_vector_type(4)));
typedef short bf16x8 __attribute__((ext_vector_type(8)));
typedef GAS unsigned gu32;
typedef GAS unsigned long long gu64;
#define RLX_AGENT __ATOMIC_RELAXED, __HIP_MEMORY_SCOPE_AGENT
#define LDS_WAIT() asm volatile("s_waitcnt lgkmcnt(0)" ::: "memory")
#define VM_WAIT() asm volatile("s_waitcnt vmcnt(0)" ::: "memory")
__device__ __forceinline__ unsigned long long rt() { return __builtin_amdgcn_s_memrealtime(); }
__device__ __forceinline__ unsigned f2bf(float f) { unsigned u = __builtin_bit_cast(unsigned, f); return (u + 0x7fffu + ((u >> 16) & 1u)) >> 16; }
__device__ __forceinline__ unsigned pk2(float lo, float hi) { return f2bf(lo) | (f2bf(hi) << 16); }

#define XB_TMO      128
#define XB_XCNT(j)  (256  + 64 * (j))
#define XB_XSUB(j)  (1280 + 64 * (j))
#define XB_XGEN(j)  (2304 + 64 * (j))
#define XB_TOP      3328
#define XB_TOPGEN   3392
#define XCD_BAR_WORDS 3456
#define XB_SPIN_CAP (1u << 18)

__device__ __forceinline__ unsigned xb_ld(unsigned* p)              { return __hip_atomic_load(p, __ATOMIC_RELAXED, __HIP_MEMORY_SCOPE_AGENT); }
__device__ __forceinline__ unsigned xb_add(unsigned* p, unsigned v) { return __hip_atomic_fetch_add(p, v, __ATOMIC_RELAXED, __HIP_MEMORY_SCOPE_AGENT); }
__device__ __forceinline__ unsigned xb_xcc_id() { return (unsigned)__builtin_amdgcn_s_getreg((3 << 11) | 20) & 0xFu; }
#define XB_SPIN(cond, bar) do { unsigned _sp = 0; while (cond) { __builtin_amdgcn_s_sleep(1); \
    if ((++_sp & 255u) == 0u) { if (xb_ld(&(bar)[XB_TMO])) break; if (_sp > XB_SPIN_CAP) { atomicAdd(&(bar)[XB_TMO], 1u); break; } } } } while (0)

struct XcdBarrier {
    unsigned* bar; unsigned x;
    volatile LAS unsigned* st;
};

__device__ __forceinline__ XcdBarrier xcd_barrier_post(unsigned* bar, volatile LAS unsigned* st) {
    XcdBarrier b; b.bar = bar; b.x = xb_xcc_id(); b.st = st;
    if (threadIdx.x == 0) (void)xb_add(&bar[XB_XCNT(b.x)], 1u);
    return b;
}
__device__ __forceinline__ void xcd_barrier_complete(unsigned* bar, unsigned x, unsigned& nloc, unsigned& nx) {
    const unsigned G = gridDim.x * gridDim.y * gridDim.z;
    unsigned sum, cnt, mine, sp = 0u;
    for (;;) {
        sum = 0u; cnt = 0u; mine = 0u;
#pragma unroll
        for (unsigned j = 0; j < 16; ++j) { const unsigned c = xb_ld(&bar[XB_XCNT(j)]); sum += c; cnt += (c > 0u) ? 1u : 0u; mine = (j == x) ? c : mine; }
        if (sum == G) break;
        __builtin_amdgcn_s_sleep(1);
        if ((++sp & 255u) == 0u) { if (xb_ld(&bar[XB_TMO])) break; if (sp > XB_SPIN_CAP) { atomicAdd(&bar[XB_TMO], 1u); break; } }
    }
    nloc = mine > 0u ? mine : 1u; nx = cnt > 0u ? cnt : 1u;
}

__device__ __forceinline__ void xcd_barrier(const XcdBarrier& b) {
    asm volatile("s_waitcnt vmcnt(0)" ::: "memory");
    __syncthreads();
    if (threadIdx.x == 0) {
        unsigned* bar = b.bar;
        __builtin_amdgcn_s_waitcnt(0);
        unsigned nloc = b.st[0], nx = b.st[1];
        if (nloc == 0u) { xcd_barrier_complete(bar, b.x, nloc, nx); b.st[0] = nloc; b.st[1] = nx; }
        const unsigned old = xb_add(&bar[XB_XSUB(b.x)], 1u);
        const unsigned gen = old / nloc;
        if (old + 1u == (gen + 1u) * nloc) {
            __builtin_amdgcn_fence(__ATOMIC_RELEASE, "agent");
            asm volatile("s_waitcnt vmcnt(0)" ::: "memory");
            const unsigned og = xb_add(&bar[XB_TOP], 1u);
            const unsigned tg = og / nx;
            if (og + 1u == (tg + 1u) * nx) xb_add(&bar[XB_TOPGEN], 1u);
            else XB_SPIN(xb_ld(&bar[XB_TOPGEN]) == tg, bar);
            __builtin_amdgcn_fence(__ATOMIC_ACQUIRE, "agent");
            xb_add(&bar[XB_XGEN(b.x)], 1u);
            asm volatile("s_waitcnt vmcnt(0)" ::: "memory");
        } else {
            XB_SPIN(xb_ld(&bar[XB_XGEN(b.x)]) == gen, bar);
            __builtin_amdgcn_fence(__ATOMIC_ACQUIRE, "agent");
            asm volatile("s_waitcnt vmcnt(0)" ::: "memory");
        }
    }
    __syncthreads();
}


constexpr int NB = 16, T = 4096, D = 1024, DEPTH = 4, M = NB * T;
constexpr int HD = 64, H_HGRN = 6, H_FOX = 6, H_RET = 4;
constexpr int IN_COLS = 4102, NP = 4096, D_FF = 2816, NUP = 2 * D_FF;
constexpr float EPS = 1e-6f;
constexpr int OC_AQ = 0, OC_AF = 384, OC_AI = 768, OC_AG = 1152, OC_BQ = 1536, OC_BK = 1920, OC_BV = 2304, OC_BF = 2688, OC_BG = 2694, OC_CQ = 3078, OC_CK = 3334, OC_CV = 3590, OC_CG = 3846;
constexpr int PC_AQ = 0, PC_BQ = 384, PC_CQ = 768, PC_AF = 1024, PC_AI = 1408, PC_AG = 1792, PC_BK = 2176, PC_BV = 2560, PC_BG = 2944, PC_CK = 3328, PC_CV = 3584, PC_CG = 3840;
__device__ __forceinline__ int pcol_to_orig(int n) {
    if (n < 384) return OC_AQ + n; if (n < 768) return OC_BQ + (n - 384); if (n < 1024) return OC_CQ + (n - 768);
    if (n < 1408) return OC_AF + (n - 1024); if (n < 1792) return OC_AI + (n - 1408); if (n < 2176) return OC_AG + (n - 1792);
    if (n < 2560) return OC_BK + (n - 2176); if (n < 2944) return OC_BV + (n - 2560); if (n < 3328) return OC_BG + (n - 2944);
    if (n < 3584) return OC_CK + (n - 3328); if (n < 3840) return OC_CV + (n - 3584); return OC_CG + (n - 3840);
}
constexpr size_t MiB = 1u << 20;
constexpr size_t WS_CTL = 0, CTL_ZERO_BYTES = 1 * MiB;
constexpr size_t WS_WIN = 2 * MiB, WS_WOUT = 34 * MiB, WS_WUP = 42 * MiB, WS_WDN = 86 * MiB;
constexpr size_t WS_WF = 108 * MiB;
constexpr size_t WS_COS = 109 * MiB, WS_SIN = WS_COS + 512 * 1024;
constexpr size_t WS_LB = 110 * MiB;
constexpr size_t WS_LOGF = 111 * MiB;
constexpr size_t WS_FCUM = 113 * MiB;
constexpr size_t WS_H = 116 * MiB;
constexpr size_t WS_MIX = 244 * MiB;
constexpr size_t WS_P = 372 * MiB;
constexpr size_t WS_UQ = WS_P, WS_ACTQ = WS_P + 176 * MiB;
constexpr size_t WS_END = 884 * MiB;
constexpr int CW_BAR = 4096;
constexpr int RING_BYTES = 131072, LDSCTL_OFF = RING_BYTES, MISC_OFF = LDSCTL_OFF + 320, LDS_BYTES = 147456;
constexpr int NWAVES = 8;

__device__ __forceinline__ float wave_sum(float v) {
#pragma unroll
    for (int o = 1; o < 64; o <<= 1) v += __shfl_xor(v, o);
    return v;
}
__device__ __forceinline__ float bf_lo(unsigned w) { return __uint_as_float(w << 16); }
__device__ __forceinline__ float bf_hi(unsigned w) { return __uint_as_float(w & 0xffff0000u); }
__device__ __forceinline__ float bf1(bf16 w) { return __uint_as_float(((unsigned)w) << 16); }

__device__ __forceinline__ void tr_item(const float* W, int ldw, int src_col0, int k0, bf16* WT, int ldt, int dst_row0, LAS float* scr, int lane) {
#pragma unroll 8
    for (int i = 0; i < 32; ++i) { const int kk = 2 * i + (lane >> 5); scr[kk * 33 + (lane & 31)] = W[(size_t)(k0 + kk) * ldw + src_col0 + (lane & 31)]; }
    LDS_WAIT(); asm volatile("" ::: "memory");
    const int c = lane & 7;
#pragma unroll
    for (int j = 0; j < 4; ++j) { const int n = (lane >> 3) + 8 * j; const LAS float* s = scr + (8 * c) * 33 + n;
        v4u o; o.x = pk2(s[0 * 33], s[1 * 33]); o.y = pk2(s[2 * 33], s[3 * 33]); o.z = pk2(s[4 * 33], s[5 * 33]); o.w = pk2(s[6 * 33], s[7 * 33]);
        *(GAS v4u*)(WT + (size_t)(dst_row0 + n) * ldt + k0 + 8 * c) = o; }
    LDS_WAIT(); asm volatile("" ::: "memory");
}

__device__ __forceinline__ float log_sigmoid_f(float v) { return v >= 0.f ? -log1pf(__expf(-v)) : v - log1pf(__expf(v)); }

__device__ __forceinline__ void row_update(int lane, const float* xin_row, float* xout_row, const bf16* add_row, const float* gpost,
                                           const float* gnext, bf16* hrow, const float* wf, const float* bfox, float* logf_row) {
    f32x4 v[4];
#pragma unroll
    for (int j = 0; j < 4; ++j) v[j] = *(const f32x4*)(xin_row + 4 * lane + 256 * j);
    if (add_row) {
        f32x4 a[4]; float ss = 0.f;
#pragma unroll
        for (int j = 0; j < 4; ++j) { const uint2 w = *(const uint2*)(add_row + 4 * lane + 256 * j); a[j] = (f32x4){bf_lo(w.x), bf_hi(w.x), bf_lo(w.y), bf_hi(w.y)};
            ss += (a[j].x * a[j].x + a[j].y * a[j].y) + (a[j].z * a[j].z + a[j].w * a[j].w); }
        const float rs = 1.0f / sqrtf(wave_sum(ss) * (1.f / D) + EPS);
#pragma unroll
        for (int j = 0; j < 4; ++j) { const f32x4 g = *(const f32x4*)(gpost + 4 * lane + 256 * j); v[j] = v[j] + a[j] * rs * g; *(f32x4*)(xout_row + 4 * lane + 256 * j) = v[j]; }
    }
    if (gnext) {
        float ss = 0.f;
#pragma unroll
        for (int j = 0; j < 4; ++j) ss += (v[j].x * v[j].x + v[j].y * v[j].y) + (v[j].z * v[j].z + v[j].w * v[j].w);
        const float rs = 1.0f / sqrtf(wave_sum(ss) * (1.f / D) + EPS);
#pragma unroll
        for (int j = 0; j < 4; ++j) { const f32x4 g = *(const f32x4*)(gnext + 4 * lane + 256 * j); v[j] = v[j] * rs * g;
            uint2 w; w.x = pk2(v[j].x, v[j].y); w.y = pk2(v[j].z, v[j].w); *(uint2*)(hrow + 4 * lane + 256 * j) = w; }
        if (wf) {
            float mine = 0.f;
#pragma unroll
            for (int jj = 0; jj < 6; ++jj) { float d = 0.f;
#pragma unroll
                for (int j = 0; j < 4; ++j) { const f32x4 w = *(const f32x4*)(wf + jj * 1024 + 4 * lane + 256 * j); d += (v[j].x * w.x + v[j].y * w.y) + (v[j].z * w.z + v[j].w * w.w); }
                d = wave_sum(d); if (lane == jj) mine = d; }
            if (lane < 6) logf_row[lane] = log_sigmoid_f(mine + bfox[lane]);
        }
    }
}

__device__ __forceinline__ void qknorm_row(int lane, bf16* prow, const float* qg, const float* kg) {
    const int l = lane < 48 ? lane : 47;
#pragma unroll
    for (int pass = 0; pass < 2; ++pass) {
        bf16* base = prow + (pass ? PC_BK : PC_BQ) + 8 * l; const float* g = (pass ? kg : qg) + (l & 7) * 8;
        const v4u w = *(const v4u*)base;
        float x[8] = {bf_lo(w.x), bf_hi(w.x), bf_lo(w.y), bf_hi(w.y), bf_lo(w.z), bf_hi(w.z), bf_lo(w.w), bf_hi(w.w)};
        float ss = 0.f;
#pragma unroll
        for (int e = 0; e < 8; ++e) ss += x[e] * x[e];
        ss += __shfl_xor(ss, 1); ss += __shfl_xor(ss, 2); ss += __shfl_xor(ss, 4);
        const float rs = 1.0f / sqrtf(ss * (1.f / 64.f) + EPS);
#pragma unroll
        for (int e = 0; e < 8; ++e) x[e] = x[e] * rs * g[e];
        v4u o; o.x = pk2(x[0], x[1]); o.y = pk2(x[2], x[3]); o.z = pk2(x[4], x[5]); o.w = pk2(x[6], x[7]);
        if (lane < 48) *(v4u*)base = o;
    }
}

__device__ __forceinline__ void attn_v1(LAS unsigned char* lds, bf16* P, const float* FCUM, int tid) {
    LAS float* Ks = (LAS float*)lds; LAS float* Vs = Ks + 4096; LAS float* Fs = Vs + 4096;
    for (int u = blockIdx.x; u < 768; u += gridDim.x) {
        const int qblk = 7 - u / 96, bh = u % 96, b = bh / 6, h = bh % 6;
        const int t = qblk * 512 + tid; const size_t row = (size_t)b * T + t;
        float q[64];
        { const bf16* qp = P + row * NP + PC_BQ + h * 64;
#pragma unroll
          for (int c = 0; c < 8; ++c) { const v4u w = *(const v4u*)(qp + 8 * c); q[8 * c + 0] = bf_lo(w.x); q[8 * c + 1] = bf_hi(w.x); q[8 * c + 2] = bf_lo(w.y); q[8 * c + 3] = bf_hi(w.y);
              q[8 * c + 4] = bf_lo(w.z); q[8 * c + 5] = bf_hi(w.z); q[8 * c + 6] = bf_lo(w.w); q[8 * c + 7] = bf_hi(w.w); } }
        const float Ft = FCUM[(size_t)bh * T + t];
        float m = -1e30f, l = 0.f; float acc[64];
#pragma unroll
        for (int d = 0; d < 64; ++d) acc[d] = 0.f;
        const int ntile = (qblk * 512 + 512) / 64;
        for (int j = 0; j < ntile; ++j) {
            __syncthreads();
            { const int r = tid >> 3, ch = tid & 7; const size_t krow = (size_t)b * T + j * 64 + r;
              const v4u kw = *(const v4u*)(P + krow * NP + PC_BK + h * 64 + ch * 8); const v4u vw = *(const v4u*)(P + krow * NP + PC_BV + h * 64 + ch * 8);
              LAS f32x4* kd = (LAS f32x4*)(Ks + r * 64 + ch * 8); LAS f32x4* vd = (LAS f32x4*)(Vs + r * 64 + ch * 8);
              kd[0] = (f32x4){bf_lo(kw.x), bf_hi(kw.x), bf_lo(kw.y), bf_hi(kw.y)}; kd[1] = (f32x4){bf_lo(kw.z), bf_hi(kw.z), bf_lo(kw.w), bf_hi(kw.w)};
              vd[0] = (f32x4){bf_lo(vw.x), bf_hi(vw.x), bf_lo(vw.y), bf_hi(vw.y)}; vd[1] = (f32x4){bf_lo(vw.z), bf_hi(vw.z), bf_lo(vw.w), bf_hi(vw.w)};
              if (tid < 64) Fs[tid] = FCUM[(size_t)bh * T + j * 64 + tid]; }
            __syncthreads();
            if (j * 64 <= t) {
                const int smax = (t - j * 64) < 63 ? (t - j * 64) : 63;
#pragma unroll 1
                for (int kr = 0; kr <= smax; ++kr) {
                    float d0 = 0.f, d1 = 0.f;
#pragma unroll
                    for (int d4 = 0; d4 < 16; ++d4) { const f32x4 k4 = *(const LAS f32x4*)(Ks + kr * 64 + 4 * d4); d0 += q[4 * d4] * k4.x + q[4 * d4 + 1] * k4.y; d1 += q[4 * d4 + 2] * k4.z + q[4 * d4 + 3] * k4.w; }
                    const float val = (d0 + d1) * 0.125f + (Ft - Fs[kr]);
                    if (val > m) { const float alpha = __expf(m - val); l *= alpha;
#pragma unroll
                        for (int d = 0; d < 64; ++d) acc[d] *= alpha;
                        m = val; }
                    const float e = __expf(val - m); l += e;
#pragma unroll
                    for (int d4 = 0; d4 < 16; ++d4) { const f32x4 v4 = *(const LAS f32x4*)(Vs + kr * 64 + 4 * d4); acc[4 * d4] += e * v4.x; acc[4 * d4 + 1] += e * v4.y; acc[4 * d4 + 2] += e * v4.z; acc[4 * d4 + 3] += e * v4.w; }
                }
            }
        }
        const float inv = 1.0f / l;
        const bf16* gp = P + row * NP + PC_BG + h * 64; bf16* op = P + row * NP + PC_BQ + h * 64;
#pragma unroll
        for (int c = 0; c < 8; ++c) { const v4u w = *(const v4u*)(gp + 8 * c);
            const float g[8] = {bf_lo(w.x), bf_hi(w.x), bf_lo(w.y), bf_hi(w.y), bf_lo(w.z), bf_hi(w.z), bf_lo(w.w), bf_hi(w.w)}; float o[8];
#pragma unroll
            for (int e = 0; e < 8; ++e) o[e] = acc[8 * c + e] * inv * (1.0f / (1.0f + __expf(-g[e])));
            v4u ow; ow.x = pk2(o[0], o[1]); ow.y = pk2(o[2], o[3]); ow.z = pk2(o[4], o[5]); ow.w = pk2(o[6], o[7]); *(v4u*)(op + 8 * c) = ow; }
    }
}

__device__ __forceinline__ float rl(float v, int k) { return __uint_as_float((unsigned)__builtin_amdgcn_readlane((int)__float_as_uint(v), k)); }
__device__ __forceinline__ void hgrn_v1(bf16* P, int b, int h, int lane, float lbv, float gain) {
    float S[64];
#pragma unroll
    for (int k = 0; k < 64; ++k) S[k] = 0.f;
    bf16* base = P + (size_t)b * T * NP + h * 64 + lane;
    bf16 nq = base[PC_AQ], nz = base[PC_AF], ni = base[PC_AI], ng = base[PC_AG];
    for (int t = 0; t < T; ++t) {
        bf16* cur = base + (size_t)t * NP;
        const float qv = bf1(nq), zv = bf1(nz), iv = bf1(ni), gv = bf1(ng);
        if (t + 1 < T) { const bf16* nx = cur + NP; nq = nx[PC_AQ]; nz = nx[PC_AF]; ni = nx[PC_AI]; ng = nx[PC_AG]; }
        const float sig = 1.0f / (1.0f + __expf(-zv)), sgn = 1.0f / (1.0f + __expf(zv));
        const float f = lbv + (1.0f - lbv) * sig, kk = (1.0f - lbv) * sgn;
        float o = 0.f;
#pragma unroll
        for (int k = 0; k < 64; ++k) { const float fk = rl(f, k), kkk = rl(kk, k), qk = rl(qv, k); S[k] = fk * S[k] + kkk * iv; o += qk * S[k]; }
        const float ss = wave_sum(o * o); const float y = o * (1.0f / sqrtf(ss * (1.f / 64.f) + EPS)) * gain * (gv / (1.0f + __expf(-gv)));
        cur[PC_AQ] = (bf16)f2bf(y);
    }
}
__device__ __forceinline__ void ret_v1(bf16* P, const float* COS, const float* SIN, int b, int h, int lane, float gain) {
    float S[64];
#pragma unroll
    for (int k = 0; k < 64; ++k) S[k] = 0.f;
    const float gamma = 1.0f - exp2f(-5.0f - (float)h);
    bf16* base = P + (size_t)b * T * NP + h * 64 + lane;
    bf16 nq = base[PC_CQ], nk = base[PC_CK], nv = base[PC_CV], ng = base[PC_CG]; float nc = COS[lane & 31], ns = SIN[lane & 31];
    for (int t = 0; t < T; ++t) {
        bf16* cur = base + (size_t)t * NP;
        const float qx = bf1(nq), kx = bf1(nk), vv = bf1(nv), gv = bf1(ng), c = nc, s = ns;
        if (t + 1 < T) { const bf16* nx = cur + NP; nq = nx[PC_CQ]; nk = nx[PC_CK]; nv = nx[PC_CV]; ng = nx[PC_CG]; nc = COS[(t + 1) * 32 + (lane & 31)]; ns = SIN[(t + 1) * 32 + (lane & 31)]; }
        const float qp = __shfl_xor(qx, 32), kp = __shfl_xor(kx, 32);
        const float qr = lane < 32 ? qx * c - qp * s : qp * s + qx * c;
        const float kr = (lane < 32 ? kx * c - kp * s : kp * s + kx * c) * 0.125f;
        float o = 0.f;
#pragma unroll
        for (int k = 0; k < 64; ++k) { const float kk = rl(kr, k), qk = rl(qr, k); S[k] = gamma * S[k] + kk * vv; o += qk * S[k]; }
        const float ss = wave_sum(o * o); const float y = o * (1.0f / sqrtf(ss * (1.f / 64.f) + EPS)) * gain * (gv / (1.0f + __expf(-gv)));
        cur[PC_CQ] = (bf16)f2bf(y);
    }
}

struct Args { const float* in[17]; float* out; unsigned char* ws; };
enum { I_X = 0, I_WIN, I_BFOX, I_QG, I_KG, I_HLB, I_HOG, I_ROG, I_WOUT, I_GMPRE, I_GMPOST, I_WUP, I_CW, I_CB, I_WDN, I_GFPRE, I_GFPOST };
typedef const __attribute__((address_space(4))) Args* CArgs;
__device__ __forceinline__ int opaque_tid() { int t = threadIdx.x; asm volatile("" : "+v"(t)); return t; }
__device__ __forceinline__ CArgs opaque_args() { CArgs p = (CArgs)__builtin_amdgcn_kernarg_segment_ptr(); asm volatile("" : "+s"(p)); return p; }
#define PH_BEGIN const int tid = opaque_tid(), lane = tid & 63, wave = __builtin_amdgcn_readfirstlane(tid >> 6); const int G = gridDim.x, gw = blockIdx.x * NWAVES + wave, NGW = G * NWAVES; \
    CArgs ap = opaque_args(); unsigned char* ws = ap->ws; (void)lane; (void)gw; (void)NGW; (void)ws;

__global__ void __launch_bounds__(NWAVES * 64, 2) fwd(Args args_unused) {
    extern __shared__ __attribute__((aligned(16))) unsigned char lds_raw[];
    LAS unsigned char* lds = (LAS unsigned char*)lds_raw;
    XcdBarrier bar;
    { volatile LAS unsigned* MISC = (volatile LAS unsigned*)(lds + MISC_OFF);
      CArgs ap0 = opaque_args();
      for (int u = threadIdx.x; u < (LDS_BYTES - LDSCTL_OFF) / 4; u += NWAVES * 64) ((LAS unsigned*)(lds + LDSCTL_OFF))[u] = 0u;
      __syncthreads();
      bar = xcd_barrier_post((unsigned*)((gu32*)(ap0->ws + WS_CTL) + CW_BAR), MISC + 8); }
#define GRID_BAR() xcd_barrier(bar)

    { PH_BEGIN
        bf16* WinT = (bf16*)(ws + WS_WIN); bf16* WoutT = (bf16*)(ws + WS_WOUT); bf16* WupT = (bf16*)(ws + WS_WUP); bf16* WdnT = (bf16*)(ws + WS_WDN);
        float* WF = (float*)(ws + WS_WF); float* COS = (float*)(ws + WS_COS); float* SIN = (float*)(ws + WS_SIN); float* LB = (float*)(ws + WS_LB);
        LAS float* scr = (LAS float*)(lds + wave * 16384);
        constexpr int I_IN = 16 * 128, I_OUT = 16 * 32, I_UP = 16 * 176, I_DN = 44 * 32, I_L = I_IN + I_OUT + I_UP + I_DN;
        for (int it = gw; it < DEPTH * I_L; it += NGW) {
            const int l = it / I_L; int r = it % I_L;
            if (r < I_IN) { const int kb = r / 128, nb = r % 128; tr_item(ap->in[I_WIN] + (size_t)l * D * IN_COLS, IN_COLS, pcol_to_orig(32 * nb), 64 * kb, WinT + (size_t)l * NP * D, D, 32 * nb, scr, lane); continue; } r -= I_IN;
            if (r < I_OUT) { const int kb = r / 32, nb = r % 32; tr_item(ap->in[I_WOUT] + (size_t)l * D * D, D, 32 * nb, 64 * kb, WoutT + (size_t)l * D * D, D, 32 * nb, scr, lane); continue; } r -= I_OUT;
            if (r < I_UP) { const int kb = r / 176, nb = r % 176; tr_item(ap->in[I_WUP] + (size_t)l * D * NUP, NUP, 32 * nb, 64 * kb, WupT + (size_t)l * NUP * D, D, 32 * nb, scr, lane); continue; } r -= I_UP;
            { const int kb = r / 32, nb = r % 32; tr_item(ap->in[I_WDN] + (size_t)l * D_FF * D, D, 32 * nb, 64 * kb, WdnT + (size_t)l * D * D_FF, D_FF, 32 * nb, scr, lane); }
        }
        const int gt = blockIdx.x * (NWAVES * 64) + tid, NGT = G * NWAVES * 64;
        for (int i = gt; i < DEPTH * 8 * 1024; i += NGT) { const int l = i / 8192, j = (i / 1024) & 7, k = i & 1023; WF[i] = j < 6 ? ap->in[I_WIN][((size_t)l * D + k) * IN_COLS + OC_BF + j] : 0.f; }
        for (int i = gt; i < 384; i += NGT) { float v[DEPTH], mx = -1e30f;
#pragma unroll
            for (int l = 0; l < DEPTH; ++l) { v[l] = ap->in[I_HLB][l * 384 + i]; mx = fmaxf(mx, v[l]); }
            float sum = 0.f;
#pragma unroll
            for (int l = 0; l < DEPTH; ++l) { v[l] = expf(v[l] - mx); sum += v[l]; }
            float run = 0.f; const float p0 = v[0] / sum;
#pragma unroll
            for (int l = 0; l < DEPTH; ++l) { run += v[l] / sum; LB[l * 384 + i] = run - p0; } }
        for (int i = gt; i < T * 32; i += NGT) { const int t = i >> 5, f = i & 31;
            const float invf = 1.0f / (float)exp2((double)f * (13.287712379549449 / 32.0));
            const float ang = (float)t * invf; const double rev = (double)ang * 0.15915494309189535; const float fr = (float)(rev - floor(rev));
            COS[i] = __builtin_amdgcn_cosf(fr); SIN[i] = __builtin_amdgcn_sinf(fr); }
    }
    GRID_BAR();
    { PH_BEGIN
      for (int m = gw; m < M; m += NGW)
        row_update(lane, ap->in[I_X] + (size_t)m * D, nullptr, nullptr, nullptr, ap->in[I_GMPRE], (bf16*)(ws + WS_H) + (size_t)m * D, (const float*)(ws + WS_WF), ap->in[I_BFOX], (float*)(ws + WS_LOGF) + (size_t)m * 8);
    }
    GRID_BAR();

#pragma unroll 1
    for (int l = 0; l < DEPTH; ++l) {
        { PH_BEGIN
          pg8::Gemm g{(const bf16*)(ws + WS_H), (const bf16*)(ws + WS_WIN) + (size_t)l * NP * D, M, NP, D, D, D}; pg8::StaticOrder S; S.init(M, NP, G, (int)blockIdx.x);
          pg8::EpiBf16<0> E{(bf16*)(ws + WS_P), NP, nullptr, 0, 0, 1.f};
          pg8::gemm_phase<pg8::EpiBf16<0>, pg8::StaticOrder, true, true>(lds, g, S, E); }
        GRID_BAR();
        { PH_BEGIN
          bf16* P = (bf16*)(ws + WS_P); const float* LOGF = (const float*)(ws + WS_LOGF); float* FCUM = (float*)(ws + WS_FCUM);
          for (int m = gw; m < M; m += NGW) qknorm_row(lane, P + (size_t)m * NP, ap->in[I_QG] + l * 64, ap->in[I_KG] + l * 64);
          if (gw < 96) { const int b = gw / 6, h = gw % 6; const float* lf = LOGF + ((size_t)b * T + 64 * lane) * 8 + h; float s = 0.f;
            for (int i = 0; i < 64; ++i) s += lf[i * 8];
            float inc = s;
#pragma unroll
            for (int o = 1; o < 64; o <<= 1) { const float tt = __shfl_up(inc, o); if (lane >= o) inc += tt; }
            float run = inc - s; float* Fo = FCUM + (size_t)gw * T + 64 * lane;
            for (int i = 0; i < 64; ++i) { run += lf[i * 8]; Fo[i] = run; } } }
        GRID_BAR();
        { PH_BEGIN
          attn_v1(lds, (bf16*)(ws + WS_P), (const float*)(ws + WS_FCUM), tid); }
        __syncthreads();
        { PH_BEGIN
          bf16* P = (bf16*)(ws + WS_P);
          if (wave == 0 && blockIdx.x < 160) { const int c = blockIdx.x;
            if (c < 96) { const int b = c / 6, h = c % 6; hgrn_v1(P, b, h, lane, ((const float*)(ws + WS_LB))[l * 384 + h * 64 + lane], ap->in[I_HOG][l * 384 + h * 64 + lane]); }
            else { const int cc = c - 96, b = cc / 4, h = cc % 4; ret_v1(P, (const float*)(ws + WS_COS), (const float*)(ws + WS_SIN), b, h, lane, ap->in[I_ROG][l * 256 + h * 64 + lane]); } } }
        GRID_BAR();
        { PH_BEGIN
          pg8::Gemm g{(const bf16*)(ws + WS_P), (const bf16*)(ws + WS_WOUT) + (size_t)l * D * D, M, D, D, NP, D}; pg8::StaticOrder S; S.init(M, D, G, (int)blockIdx.x);
          pg8::EpiBf16<0> E{(bf16*)(ws + WS_MIX), D, nullptr, 0, 0, 1.f};
          pg8::gemm_phase<pg8::EpiBf16<0>, pg8::StaticOrder, true, true>(lds, g, S, E); }
        GRID_BAR();
        { PH_BEGIN
          const float* xi = l == 0 ? ap->in[I_X] : ap->out; float* xo = ap->out; const bf16* MIX = (const bf16*)(ws + WS_MIX); bf16* H = (bf16*)(ws + WS_H);
          for (int m = gw; m < M; m += NGW) row_update(lane, xi + (size_t)m * D, xo + (size_t)m * D, MIX + (size_t)m * D, ap->in[I_GMPOST] + l * D, ap->in[I_GFPRE] + l * D, H + (size_t)m * D, nullptr, nullptr, nullptr); }
        GRID_BAR();
#pragma unroll 1
        for (int qt = 0; qt < 4; ++qt) {
            constexpr int MQ = M / 4;
            { PH_BEGIN
              pg8::Gemm g{(const bf16*)(ws + WS_H) + (size_t)qt * MQ * D, (const bf16*)(ws + WS_WUP) + (size_t)l * NUP * D, MQ, NUP, D, D, D}; pg8::StaticOrder S; S.init(MQ, NUP, G, (int)blockIdx.x);
              pg8::EpiBf16<0> E{(bf16*)(ws + WS_UQ), NUP, nullptr, 0, 0, 1.f};
              pg8::gemm_phase<pg8::EpiBf16<0>, pg8::StaticOrder, true, true>(lds, g, S, E); }
            GRID_BAR();
            { PH_BEGIN
              const bf16* UQ = (const bf16*)(ws + WS_UQ); bf16* ACTQ = (bf16*)(ws + WS_ACTQ);
              const float* cw = ap->in[I_CW] + (size_t)l * 3 * NUP; const float* cb = ap->in[I_CB] + (size_t)l * NUP;
              const int gt = blockIdx.x * (NWAVES * 64) + tid, NGT = G * NWAVES * 64;
              for (int it = gt; it < MQ * (D_FF / 8); it += NGT) { const int r = it / (D_FF / 8), c0 = (it % (D_FF / 8)) * 8; const int t = r % T;
                  float ga[8], va[8];
#pragma unroll
                  for (int e = 0; e < 8; ++e) { ga[e] = cb[c0 + e]; va[e] = cb[D_FF + c0 + e]; }
#pragma unroll
                  for (int j = 0; j < 3; ++j) { if (t - (2 - j) < 0) continue; const bf16* ur = UQ + (size_t)(r - (2 - j)) * NUP + c0;
                      const v4u gw4 = *(const v4u*)ur; const v4u vw4 = *(const v4u*)(ur + D_FF);
                      const float gg[8] = {bf_lo(gw4.x), bf_hi(gw4.x), bf_lo(gw4.y), bf_hi(gw4.y), bf_lo(gw4.z), bf_hi(gw4.z), bf_lo(gw4.w), bf_hi(gw4.w)};
                      const float vv[8] = {bf_lo(vw4.x), bf_hi(vw4.x), bf_lo(vw4.y), bf_hi(vw4.y), bf_lo(vw4.z), bf_hi(vw4.z), bf_lo(vw4.w), bf_hi(vw4.w)};
#pragma unroll
                      for (int e = 0; e < 8; ++e) { ga[e] += cw[j * NUP + c0 + e] * gg[e]; va[e] += cw[j * NUP + D_FF + c0 + e] * vv[e]; } }
                  float o[8];
#pragma unroll
                  for (int e = 0; e < 8; ++e) o[e] = ga[e] / (1.0f + __expf(-ga[e])) * va[e];
                  v4u ow; ow.x = pk2(o[0], o[1]); ow.y = pk2(o[2], o[3]); ow.z = pk2(o[4], o[5]); ow.w = pk2(o[6], o[7]);
                  *(v4u*)(ACTQ + (size_t)r * D_FF + c0) = ow; } }
            GRID_BAR();
            { PH_BEGIN
              pg8::Gemm g{(const bf16*)(ws + WS_ACTQ), (const bf16*)(ws + WS_WDN) + (size_t)l * D * D_FF, MQ, D, D_FF, D_FF, D_FF}; pg8::StaticOrder S; S.init(MQ, D, G, (int)blockIdx.x);
              pg8::EpiBf16<0> E{(bf16*)(ws + WS_MIX) + (size_t)qt * MQ * D, D, nullptr, 0, 0, 1.f};
              pg8::gemm_phase<pg8::EpiBf16<0>, pg8::StaticOrder, true, true>(lds, g, S, E); }
            GRID_BAR();
        }
        { PH_BEGIN
          const bool last = (l == DEPTH - 1); float* xo = ap->out; const bf16* MIX = (const bf16*)(ws + WS_MIX); bf16* H = (bf16*)(ws + WS_H); float* LOGF = (float*)(ws + WS_LOGF); const float* WF = (const float*)(ws + WS_WF);
          for (int m = gw; m < M; m += NGW) row_update(lane, xo + (size_t)m * D, xo + (size_t)m * D, MIX + (size_t)m * D, ap->in[I_GFPOST] + l * D,
                                                         last ? nullptr : ap->in[I_GMPRE] + (l + 1) * D, H + (size_t)m * D, last ? nullptr : WF + (l + 1) * 8192, last ? nullptr : ap->in[I_BFOX] + (l + 1) * 6, LOGF + (size_t)m * 8); }
        GRID_BAR();
    }
}

extern "C" void kernel_launch(void* const* d_in, const int* in_sizes, int n_in, void* d_out, int out_size, void* d_ws, size_t ws_size, hipStream_t stream) {
    static int grid = 0;
    if (grid == 0) {
        if (n_in != 17 || in_sizes[0] != M * D || out_size != M * D || ws_size < WS_END) { fprintf(stderr, "kernel_launch: unexpected shapes (n_in %d, in0 %d, out %d, ws %zu)\n", n_in, n_in > 0 ? in_sizes[0] : -1, out_size, ws_size); grid = -1; return; }
        int dev = 0, cus = 0;
        if (hipGetDevice(&dev) != hipSuccess || hipDeviceGetAttribute(&cus, hipDeviceAttributeMultiprocessorCount, dev) != hipSuccess) { grid = -1; return; }
        if (hipFuncSetAttribute((const void*)fwd, hipFuncAttributeMaxDynamicSharedMemorySize, LDS_BYTES) != hipSuccess) { grid = -1; return; }
        (void)hipGetLastError();
        grid = cus;
    }
    if (grid < 0) return;
    if (hipMemsetAsync((char*)d_ws + WS_CTL, 0, CTL_ZERO_BYTES, stream) != hipSuccess) return;
    Args a{};
    for (int i = 0; i < 17; ++i) a.in[i] = (const float*)d_in[i];
    a.out = (float*)d_out; a.ws = (unsigned char*)d_ws;
    hipLaunchKernelGGL(fwd, dim3(grid), dim3(NWAVES * 64), LDS_BYTES, stream, a);
}
```

```cpp
#include <hip/hip_runtime.h>
#include <cstdio>
#include <cstdint>
#include <cmath>
__device__ __forceinline__ float shfl_i(float v, int src) { return __uint_as_float((unsigned)__builtin_amdgcn_ds_bpermute(src << 2, (int)__float_as_uint(v))); }
template <int CTRL> __device__ __forceinline__ float dppf(float v) { return __uint_as_float((unsigned)__builtin_amdgcn_update_dpp(0, (int)__float_as_uint(v), CTRL, 0xf, 0xf, true)); }
namespace pg8 {
#define PG8_LAS __attribute__((address_space(3)))
__device__ __forceinline__ int fresh_lane() { int l; asm volatile("v_mbcnt_lo_u32_b32 %0, -1, 0\n\tv_mbcnt_hi_u32_b32 %0, -1, %0\n\ts_nop 1" : "=v"(l)); return l; }
typedef unsigned short bf16_t;
typedef short bf16x8 __attribute__((ext_vector_type(8)));
typedef float f32x4 __attribute__((ext_vector_type(4)));
typedef unsigned u32x4 __attribute__((ext_vector_type(4)));
constexpr int BM = 256, BK = 64, HALF = 128, HTB = HALF * BK * 2  , STAGE_BYTES = 8 * HTB, NXCD = 8, WGM = 8;

__host__ __device__ __forceinline__ int lds_byte(int r, int c) { const int st = (r >> 4) * 2 + (c >> 5), rr = r & 15, cc = c & 31, ob = rr * 64 + cc * 2; return st * 1024 + (ob ^ (((ob >> 9) & 1) << 5)); }
__host__ __device__ __forceinline__ void stage_rc(int b, int& R, int& C) { const int st = b / 1024, sb = b % 1024, swz = sb ^ (((sb >> 9) & 1) << 5); R = (st >> 1) * 16 + swz / 64; C = (st & 1) * 32 + (swz % 64) / 2; }
__host__ __device__ __forceinline__ int perm32(int rho) { const int n = rho >> 4, i = rho & 15; return 8 * (i >> 2) + 4 * n + (i & 3); }

struct Unit { int pm, pn; };
struct Gemm { const bf16_t* A; const bf16_t* Bt; int M, N, K, lda, ldb; size_t kstrA, kstrB; };

struct StaticOrder {
    int nM, nN, nwg, G, c;
    __host__ __device__ void init(int M, int N, int G_, int c_) { nM = M / BM; nN = N / BM; nwg = nM * nN; G = G_; c = c_; }
    __host__ __device__ bool next(int i, Unit& u) const {
        const long L = (long)i * G + c; if (L >= nwg) return false;
        int wgid = (int)L; { const int q = nwg / NXCD, r = nwg % NXCD, xcd = wgid % NXCD, off = wgid / NXCD; wgid = (xcd < r ? xcd * (q + 1) : r * (q + 1) + (xcd - r) * q) + off; }
        const int nig = WGM * nN, gid = wgid / nig, fm = gid * WGM, gsz = (nM - fm) < WGM ? (nM - fm) : WGM;
        u.pm = fm + ((wgid % nig) % gsz); u.pn = (wgid % nig) / gsz; return true;
    }
    __device__ __forceinline__ void a_ready(const Unit&) const {}
    __device__ __forceinline__ void done(const Unit&) const {}
};


__device__ __forceinline__ unsigned cvt_pk_bf16(float lo, float hi) { unsigned r; asm volatile("v_cvt_pk_bf16_f32 %0, %1, %2" : "=v"(r) : "v"(lo), "v"(hi)); return r; }
typedef float f32x2 __attribute__((ext_vector_type(2)));

template <int ACT  > struct EpiBf16 {
    static constexpr bool PERM = true, AFTER_DRAIN = false, PREFETCH = false; static_assert(ACT == 0, "EpiBf16: ACT is 0");
    bf16_t* O; int ldc; const float* bias; int split_cols; size_t split_stride; float scale0;
    __device__ __forceinline__ void operator()(const f32x4 (&acc)[2][2][4][2], const Unit& u, int wr, int wc, int fr, int fq) const {
        const int row0 = u.pm * BM + wr * 64 + fr; int colt = u.pn * BM; bf16_t* base = O;
        float sc = 1.f; if (split_cols) { const int t = colt / split_cols; base += (size_t)t * split_stride; colt -= t * split_cols; if (t == 0) sc = scale0; }
        const int col0 = colt + wc * 32 + 8 * fq, bcol0 = u.pn * BM + wc * 32 + 8 * fq;
        f32x4 bv[2][2];
#pragma unroll
        for (int bj = 0; bj < 2; ++bj)
#pragma unroll
            for (int n = 0; n < 2; ++n) bv[bj][n] = bias ? *(const f32x4*)(bias + bcol0 + bj * HALF + 4 * n) : (f32x4){0.f, 0.f, 0.f, 0.f};
#pragma unroll
        for (int ai = 0; ai < 2; ++ai)
#pragma unroll
            for (int m = 0; m < 4; ++m) { bf16_t* rowp = base + (size_t)(row0 + ai * HALF + m * 16) * ldc + col0;
#pragma unroll
                for (int bj = 0; bj < 2; ++bj) { f32x4 v0 = acc[ai][bj][m][0] + bv[bj][0], v1 = acc[ai][bj][m][1] + bv[bj][1];

                    v0 = v0 * sc; v1 = v1 * sc; u32x4 w; w.x = cvt_pk_bf16(v0[0], v0[1]); w.y = cvt_pk_bf16(v0[2], v0[3]); w.z = cvt_pk_bf16(v1[0], v1[1]); w.w = cvt_pk_bf16(v1[2], v1[3]);
                    *(u32x4*)(rowp + bj * HALF) = w; } }
    }
};


struct EpiBf16RS {
    static constexpr bool PERM = true, AFTER_DRAIN = false, PREFETCH = true;
    bf16_t* O; int ldc; const float* rs; const float* cosT; const float* sinT; int pn_q, pn_k; PG8_LAS unsigned char* rbuf;
    __device__ __forceinline__ void prefetch(const Unit& u, int par, int wid, int lane) const {
        if (wid < 4) __builtin_amdgcn_global_load_lds((const unsigned*)(rs + ((size_t)u.pm * BM + wid * 64 + lane) * 4), (PG8_LAS unsigned*)(rbuf + par * 4096 + wid * 1024), 16, 0, 0); }
    __device__ __forceinline__ void operator()(const f32x4 (&acc)[2][2][4][2], const Unit& u, int wr, int wc, int fr, int fq, int par) const {
        const int row0 = u.pm * BM + wr * 64 + fr, col0 = u.pn * BM + wc * 64 + 8 * fq;
        const bool rot = (u.pn == pn_q) || (u.pn == pn_k); const float ksc = (u.pn == pn_k) ? 0.125f : 1.0f; const int p0 = 4 * fq;
        float scv[2][4];
#pragma unroll
        for (int ai = 0; ai < 2; ++ai)
#pragma unroll
            for (int m = 0; m < 4; ++m) { const f32x4 q4 = *(const PG8_LAS f32x4*)(rbuf + par * 4096 + (wr * 64 + fr + ai * HALF + m * 16) * 16); scv[ai][m] = __builtin_amdgcn_rsqf(((q4[0] + q4[1]) + (q4[2] + q4[3])) * (1.f / 1024.f) + 1e-6f); }
        bf16_t* rowb = O + ((size_t)(col0 >> 6) * (size_t)ldc + row0) * 64 + (col0 & 63);
        if (!rot) {
#pragma unroll
            for (int ai = 0; ai < 2; ++ai)
#pragma unroll
                for (int m = 0; m < 4; ++m) { const float sc = scv[ai][m]; bf16_t* rowp = rowb + (ai * HALF + m * 16) * 64;
#pragma unroll
                    for (int bj = 0; bj < 2; ++bj) { const f32x4 v0 = acc[ai][bj][m][0] * sc, v1 = acc[ai][bj][m][1] * sc;
                        u32x4 w; w.x = cvt_pk_bf16(v0[0], v0[1]); w.y = cvt_pk_bf16(v0[2], v0[3]); w.z = cvt_pk_bf16(v1[0], v1[1]); w.w = cvt_pk_bf16(v1[2], v1[3]);
                        *(u32x4*)(rowp + bj * 32) = w; } }
        } else {
            f32x4 cn[2], sn[2];
#pragma unroll
            for (int bj = 0; bj < 2; ++bj) { const int t = row0 & 4095; cn[bj] = *(const f32x4*)(cosT + t * 32 + p0 + 16 * bj); sn[bj] = *(const f32x4*)(sinT + t * 32 + p0 + 16 * bj); }
#pragma unroll
            for (int i = 0; i < 8; ++i) { const int ai = i >> 2, m = i & 3; const float sc = scv[ai][m]; bf16_t* rowp = rowb + (ai * HALF + m * 16) * 64;
                f32x4 c4b[2], s4b[2];
#pragma unroll
                for (int bj = 0; bj < 2; ++bj) { c4b[bj] = cn[bj] * ksc; s4b[bj] = sn[bj] * ksc; }
                if (i < 7) { const int t = (row0 + ((i + 1) >> 2) * HALF + ((i + 1) & 3) * 16) & 4095;
#pragma unroll
                    for (int bj = 0; bj < 2; ++bj) { cn[bj] = *(const f32x4*)(cosT + t * 32 + p0 + 16 * bj); sn[bj] = *(const f32x4*)(sinT + t * 32 + p0 + 16 * bj); } }
                asm volatile("" ::: "memory");
#pragma unroll
                for (int bj = 0; bj < 2; ++bj) { f32x4 v0 = acc[ai][bj][m][0] * sc, v1 = acc[ai][bj][m][1] * sc; const f32x4 c4 = c4b[bj], s4 = s4b[bj];
                    const f32x4 a0 = v0, a1 = v1;
                    v0[0] = a0[0] * c4[0] - a0[1] * s4[0]; v0[1] = a0[0] * s4[0] + a0[1] * c4[0]; v0[2] = a0[2] * c4[1] - a0[3] * s4[1]; v0[3] = a0[2] * s4[1] + a0[3] * c4[1];
                    v1[0] = a1[0] * c4[2] - a1[1] * s4[2]; v1[1] = a1[0] * s4[2] + a1[1] * c4[2]; v1[2] = a1[2] * c4[3] - a1[3] * s4[3]; v1[3] = a1[2] * s4[3] + a1[3] * c4[3];
                    u32x4 w; w.x = cvt_pk_bf16(v0[0], v0[1]); w.y = cvt_pk_bf16(v0[2], v0[3]); w.z = cvt_pk_bf16(v1[0], v1[1]); w.w = cvt_pk_bf16(v1[2], v1[3]);
                    *(u32x4*)(rowp + bj * 32) = w; } }
        }
    }
};

typedef float f32x2e __attribute__((ext_vector_type(2))); typedef __bf16 bf16x2e __attribute__((ext_vector_type(2)));
__device__ __forceinline__ unsigned cvt_pk_bf16_v(float lo, float hi) { f32x2e v = {lo, hi}; bf16x2e b = __builtin_convertvector(v, bf16x2e); return __builtin_bit_cast(unsigned, b); }
struct EpiConvAct {
    static constexpr bool PERM = true, AFTER_DRAIN = false, PREFETCH = true;
    bf16_t* ACT; const float* cw; const float* cb; float* EDGEL; float* EDGEP; PG8_LAS unsigned char* halo; int dff; const float* rs; size_t blk; PG8_LAS unsigned char* wbuf;
    __device__ __forceinline__ void prefetch(const Unit& u, int par, int wid, int lane) const {
        if (wid < 4) { const int sg = 2 * wid + (lane >> 5); const float* src = (sg < 6 ? cw + (size_t)(sg >> 1) * (2 * dff) : cb) + (sg & 1) * dff + 128 * u.pn + (lane & 31) * 4;
            __builtin_amdgcn_global_load_lds((const unsigned*)src, (PG8_LAS unsigned*)(wbuf + par * 8192 + wid * 1024), 16, 0, 0); }
        else { const float* src = rs + ((size_t)u.pm * BM + (wid - 4) * 64 + lane) * 4;
            __builtin_amdgcn_global_load_lds((const unsigned*)src, (PG8_LAS unsigned*)(wbuf + par * 8192 + 4096 + (wid - 4) * 1024), 16, 0, 0); } }
    __device__ __forceinline__ void operator()(const f32x4 (&acc)[2][2][4][2], const Unit& u, int wr, int wc, int fr, int fq, int par) const {
        { const int l_ = fresh_lane(); fr = l_ & 15; fq = l_ >> 4; }
        const int wave = wr * 4 + wc, lane = fq * 16 + fr, nup = 2 * dff;
        const int ch0 = 128 * u.pn + 32 * wc + 8 * fq;
        float rsv[2][4];
#pragma unroll
        for (int ai = 0; ai < 2; ++ai)
#pragma unroll
            for (int m = 0; m < 4; ++m) { const f32x4 q4 = *(const PG8_LAS f32x4*)(wbuf + par * 8192 + 4096 + (ai * HALF + wr * 64 + m * 16 + fr) * 16); rsv[ai][m] = __builtin_amdgcn_rsqf(((q4[0] + q4[1]) + (q4[2] + q4[3])) * (1.f / 1024.f) + 1e-6f); }
#pragma unroll
        for (int ai = 0; ai < 2; ++ai) if (fr >= 14) {
#pragma unroll
            for (int bj = 0; bj < 2; ++bj)
#pragma unroll
                for (int n = 0; n < 2; ++n) *(PG8_LAS f32x4*)(halo + ((((wave * 2 + ai) * 2 + (fr - 14)) * 4 + fq) * 64) + (bj * 2 + n) * 16) = acc[ai][bj][3][n] * rsv[ai][3]; }
        if (wr == 1 && fr >= 14) {
#pragma unroll
            for (int bj = 0; bj < 2; ++bj)
#pragma unroll
                for (int n = 0; n < 2; ++n) *(f32x4*)(EDGEL + ((size_t)(u.pm * 2 + (fr - 14))) * nup + 256 * u.pn + 128 * bj + 32 * wc + 8 * fq + 4 * n) = acc[1][bj][3][n] * rsv[1][3]; }
        asm volatile("s_waitcnt lgkmcnt(0)" ::: "memory"); __builtin_amdgcn_s_barrier(); asm volatile("" ::: "memory");
        const size_t acb = (size_t)(ch0 >> 6) * blk + (ch0 & 63);
        typedef unsigned u32x2 __attribute__((ext_vector_type(2)));
        u32x2 pend[2][4];
#pragma unroll
        for (int n = 0; n < 2; ++n) {
            f32x4 w[3][2], bb[2];
#pragma unroll
            for (int bj = 0; bj < 2; ++bj) { const PG8_LAS float* wl_ = (const PG8_LAS float*)(wbuf + par * 8192) + bj * 128 + 32 * wc + 8 * fq + 4 * n; bb[bj] = *(const PG8_LAS f32x4*)(wl_ + 6 * 128);
#pragma unroll
                for (int j = 0; j < 3; ++j) w[j][bj] = *(const PG8_LAS f32x4*)(wl_ + j * 256); }
#pragma unroll
            for (int ai = 0; ai < 2; ++ai) {
                const bool none = (ai == 0 && wr == 0); const int pw = wr == 1 ? wave - 4 : wave + 4, pai = wr == 1 ? ai : 0;
                float r1p[2][4], r2p[2][4];
#pragma unroll
                for (int bj = 0; bj < 2; ++bj) { f32x4 h = (f32x4){0.f, 0.f, 0.f, 0.f};
                    if (!none && fr >= 14) h = *(const PG8_LAS f32x4*)(halo + ((((pw * 2 + pai) * 2 + (fr - 14)) * 4 + fq) * 64) + (bj * 2 + n) * 16);
#pragma unroll
                    for (int e = 0; e < 4; ++e) { r1p[bj][e] = dppf<0x121>(h[e]); r2p[bj][e] = dppf<0x122>(h[e]); } }
#pragma unroll
                for (int m = 0; m < 4; ++m) { f32x4 c[2];
#pragma unroll
                    for (int bj = 0; bj < 2; ++bj)
#pragma unroll
                        for (int e = 0; e < 4; ++e) { const float x = acc[ai][bj][m][n][e] * rsv[ai][m]; const float r1 = dppf<0x121>(x), r2 = dppf<0x122>(x);
                            const float u1 = fr == 0 ? r1p[bj][e] : r1, u2 = fr < 2 ? r2p[bj][e] : r2;
                            c[bj][e] = bb[bj][e] + w[0][bj][e] * u2 + w[1][bj][e] * u1 + w[2][bj][e] * x; r1p[bj][e] = r1; r2p[bj][e] = r2; }
                    if (none && m == 0 && fr < 2) {
#pragma unroll
                        for (int bj = 0; bj < 2; ++bj) *(f32x4*)(EDGEP + ((size_t)(u.pm * 2 + fr)) * nup + 256 * u.pn + 128 * bj + 32 * wc + 8 * fq + 4 * n) = c[bj]; }
                    float o[4];
#pragma unroll
                    for (int e = 0; e < 4; ++e) { const float g = c[0][e]; o[e] = g * __builtin_amdgcn_rcpf(1.0f + __builtin_amdgcn_exp2f(-g * 1.4426950408889634f)) * c[1][e]; }
                    u32x2 ow; ow.x = cvt_pk_bf16_v(o[0], o[1]); ow.y = cvt_pk_bf16_v(o[2], o[3]);
                    if (n == 0) { pend[ai][m] = ow; asm volatile("" : "+v"(pend[ai][m])); }
                    else { u32x4 w4; w4.x = pend[ai][m].x; w4.y = pend[ai][m].y; w4.z = ow.x; w4.w = ow.y; *(u32x4*)(ACT + acb + (u.pm * BM + ai * HALF + wr * 64 + m * 16 + fr) * 64) = w4; } }
            }
        }
    }
};

template <class Epi, class Sched, bool ALIGN_EPI = false, bool SP2 = false>
__device__ __forceinline__ void gemm_phase(PG8_LAS unsigned char* lds, const Gemm g, const Sched& S, const Epi& E, int tid_) {
    asm volatile("" : "+v"(tid_)); const int tid = tid_, wid = __builtin_amdgcn_readfirstlane(tid >> 6), lane = tid & 63, wr = wid >> 2, wc = wid & 3, fr = lane & 15, fq = lane >> 4;
    const int K = g.K, nt = K / BK, lda = g.lda, ldb = g.ldb;
    unsigned voffA[2], voffB[2];
#pragma unroll
    for (int i = 0; i < 2; ++i) { int R, C; stage_rc(tid * 16 + i * 8192, R, C); const int Rb = Epi::PERM ? ((R & ~31) + perm32(R & 31)) : R;
        voffA[i] = (unsigned)(R * lda + C) * 2u; voffB[i] = (unsigned)(Rb * ldb + C) * 2u; }
    const size_t kstepB = g.kstrB ? g.kstrB : (size_t)(BK * 2), kstepA = g.kstrA ? g.kstrA : (size_t)(BK * 2);
    const size_t hstepA = (size_t)HALF * lda * 2, hstepB = (size_t)HALF * ldb * 2;
    const size_t tstepA = 2 * hstepA, tstepB = 2 * hstepB;
    const unsigned ldsw = (unsigned)wid * 1024u;
    const int aoff = lds_byte(wr * 64 + fr, fq * 8), boff = lds_byte(wc * 32 + fr, fq * 8);
#define PG8_SA(b, h) (((b) * 2 + (h)) * HTB)
#define PG8_SB(b, h) ((4 + (b) * 2 + (h)) * HTB)
#define PG8_STAGE(bufoff, gbase, voff) do { _Pragma("unroll") for (int _i = 0; _i < 2; ++_i) \
        __builtin_amdgcn_global_load_lds((const unsigned*)((const char*)(gbase) + (voff)[_i]), (PG8_LAS unsigned*)(lds + (bufoff) + ldsw + _i * 8192), 16, 0, 0); } while (0)
#define PG8_LDA(dst, b, h) do { _Pragma("unroll") for (int m = 0; m < 4; ++m) _Pragma("unroll") for (int k = 0; k < 2; ++k) dst[m][k] = *(const PG8_LAS bf16x8*)(lds + PG8_SA(b, h) + aoff + m * 2048 + k * 1024); } while (0)
#define PG8_LDB(dst, b, h) do { _Pragma("unroll") for (int n = 0; n < 2; ++n) _Pragma("unroll") for (int k = 0; k < 2; ++k) dst[n][k] = *(const PG8_LAS bf16x8*)(lds + PG8_SB(b, h) + boff + n * 2048 + k * 1024); } while (0)
#define PG8_MMA(ai, bj, At, Bt) do { __builtin_amdgcn_s_setprio(1); _Pragma("unroll") for (int m = 0; m < 4; ++m) _Pragma("unroll") for (int n = 0; n < 2; ++n) _Pragma("unroll") for (int k = 0; k < 2; ++k) \
        acc[ai][bj][m][n] = __builtin_amdgcn_mfma_f32_16x16x32_bf16(Bt[n][k], At[m][k], acc[ai][bj][m][n], 0, 0, 0); __builtin_amdgcn_s_setprio(0); } while (0)
#define PG8_WAIT_V(n) asm volatile("s_waitcnt vmcnt(" #n ")" ::: "memory")
#define PG8_WAIT_L(n) asm volatile("s_waitcnt lgkmcnt(" #n ")" ::: "memory")
#define PG8_BAR __builtin_amdgcn_s_barrier()
#define PG8_SCHED __builtin_amdgcn_sched_barrier(0)
    Unit cur, nxt; int ui = 0;
    if (!S.next(0, cur)) return;
    f32x4 acc[2][2][4][2];
#pragma unroll
    for (int a = 0; a < 2; ++a)
#pragma unroll
        for (int b = 0; b < 2; ++b)
#pragma unroll
            for (int m = 0; m < 4; ++m)
#pragma unroll
                for (int n = 0; n < 2; ++n) acc[a][b][m][n] = (f32x4){0.f, 0.f, 0.f, 0.f};
    bf16x8 At[4][2], B0[2][2], B1[2][2];
    const char* cA = (const char*)g.A + (size_t)cur.pm * tstepA; const char* cB = (const char*)g.Bt + (size_t)cur.pn * tstepB;
    S.a_ready(cur);
    if constexpr (Epi::PREFETCH) E.prefetch(cur, 0, wid, lane);
    if constexpr (SP2) {
        PG8_STAGE(PG8_SB(0, 0), cB, voffB); PG8_STAGE(PG8_SB(0, 1), cB + hstepB, voffB); PG8_STAGE(PG8_SA(0, 0), cA, voffA); PG8_STAGE(PG8_SA(0, 1), cA + hstepA, voffA);
        if (wr == 1) PG8_BAR;
        PG8_WAIT_V(2); PG8_BAR;
        PG8_STAGE(PG8_SB(1, 0), cB + kstepB, voffB); PG8_STAGE(PG8_SA(1, 0), cA + kstepA, voffA); PG8_STAGE(PG8_SB(1, 1), cB + hstepB + kstepB, voffB);
        PG8_WAIT_V(6); PG8_BAR;
    } else {
        PG8_STAGE(PG8_SB(0, 0), cB, voffB); PG8_STAGE(PG8_SA(0, 0), cA, voffA); PG8_STAGE(PG8_SB(0, 1), cB + hstepB, voffB); PG8_STAGE(PG8_SA(0, 1), cA + hstepA, voffA);
        if (wr == 1) PG8_BAR;
        PG8_WAIT_V(4); PG8_BAR;
        PG8_STAGE(PG8_SB(1, 0), cB + kstepB, voffB); PG8_STAGE(PG8_SA(1, 0), cA + kstepA, voffA); PG8_STAGE(PG8_SB(1, 1), cB + hstepB + kstepB, voffB);
        PG8_WAIT_V(6); PG8_BAR;
    }
    for (;;) {
        const bool has_next = S.next(ui + 1, nxt);
        const char* nA = has_next ? (const char*)g.A + (size_t)nxt.pm * tstepA : cA; const char* nB = has_next ? (const char*)g.Bt + (size_t)nxt.pn * tstepB : cB;
        for (int t = 0; t < nt; t += 2) {
            const bool last = (t == nt - 2);
            const char* a1 = cA + (size_t)(t + 1) * kstepA;
            const char* a2 = last ? nA : cA + (size_t)(t + 2) * kstepA; const char* b2 = last ? nB : cB + (size_t)(t + 2) * kstepB;
            const char* a3 = a2 + kstepA; const char* b3 = b2 + kstepB;
            if (last && has_next) { S.a_ready(nxt); if constexpr (Epi::PREFETCH) E.prefetch(nxt, (ui + 1) & 1, wid, lane); }
            if constexpr (SP2) {
            PG8_LDB(B0, 0, 0); PG8_LDB(B1, 0, 1); PG8_SCHED; PG8_LDA(At, 0, 0); PG8_STAGE(PG8_SA(1, 1), a1 + hstepA, voffA);
            PG8_WAIT_V(8); PG8_WAIT_L(0); PG8_BAR; PG8_MMA(0, 0, At, B0); PG8_MMA(0, 1, At, B1); PG8_BAR; PG8_SCHED;
            PG8_LDA(At, 0, 1); PG8_STAGE(PG8_SB(0, 0), b2, voffB); PG8_STAGE(PG8_SB(0, 1), b2 + hstepB, voffB); PG8_STAGE(PG8_SA(0, 0), a2, voffA);
            PG8_WAIT_V(8); PG8_WAIT_L(0); PG8_BAR; PG8_MMA(1, 0, At, B0); PG8_MMA(1, 1, At, B1); PG8_BAR; PG8_SCHED;
            PG8_LDB(B0, 1, 0); PG8_LDB(B1, 1, 1); PG8_SCHED; PG8_LDA(At, 1, 0); PG8_STAGE(PG8_SA(0, 1), a2 + hstepA, voffA);
            PG8_WAIT_V(8); PG8_WAIT_L(0); PG8_BAR; PG8_MMA(0, 0, At, B0); PG8_MMA(0, 1, At, B1); PG8_BAR; PG8_SCHED;
            PG8_LDA(At, 1, 1); PG8_STAGE(PG8_SB(1, 0), b3, voffB); PG8_STAGE(PG8_SB(1, 1), b3 + hstepB, voffB); PG8_STAGE(PG8_SA(1, 0), a3, voffA);
            PG8_WAIT_V(8); PG8_WAIT_L(0); PG8_BAR; PG8_MMA(1, 0, At, B0); PG8_MMA(1, 1, At, B1); PG8_BAR; PG8_SCHED;
            } else {
            PG8_LDB(B0, 0, 0); PG8_SCHED; PG8_LDA(At, 0, 0); PG8_STAGE(PG8_SA(1, 1), a1 + hstepA, voffA);
            PG8_WAIT_L(8); PG8_BAR; PG8_WAIT_L(0); PG8_MMA(0, 0, At, B0); PG8_BAR; PG8_SCHED;
            PG8_LDB(B1, 0, 1); PG8_STAGE(PG8_SB(0, 0), b2, voffB);
            PG8_BAR; PG8_WAIT_L(0); PG8_MMA(0, 1, At, B1); PG8_BAR;
            PG8_LDA(At, 0, 1); PG8_STAGE(PG8_SA(0, 0), a2, voffA);
            PG8_BAR; PG8_WAIT_L(0); PG8_MMA(1, 0, At, B0); PG8_BAR; PG8_SCHED;
            PG8_STAGE(PG8_SB(0, 1), b2 + hstepB, voffB);
            PG8_WAIT_V(6); PG8_BAR; PG8_MMA(1, 1, At, B1); PG8_BAR;
            PG8_LDB(B0, 1, 0); PG8_SCHED; PG8_LDA(At, 1, 0); PG8_STAGE(PG8_SA(0, 1), a2 + hstepA, voffA);
            PG8_WAIT_L(8); PG8_BAR; PG8_WAIT_L(0); PG8_MMA(0, 0, At, B0); PG8_BAR; PG8_SCHED;
            PG8_LDB(B1, 1, 1); PG8_STAGE(PG8_SB(1, 0), b3, voffB);
            PG8_BAR; PG8_WAIT_L(0); PG8_MMA(0, 1, At, B1); PG8_BAR;
            PG8_LDA(At, 1, 1); PG8_STAGE(PG8_SA(1, 0), a3, voffA);
            PG8_BAR; PG8_WAIT_L(0); PG8_MMA(1, 0, At, B0); PG8_BAR; PG8_SCHED;
            PG8_STAGE(PG8_SB(1, 1), b3 + hstepB, voffB);
            PG8_WAIT_V(6); PG8_BAR; PG8_MMA(1, 1, At, B1); PG8_BAR;
            }
        }
        if constexpr (ALIGN_EPI) { if (wr == 0) PG8_BAR; }
        if constexpr (!Epi::AFTER_DRAIN) { if constexpr (Epi::PREFETCH) E(acc, cur, wr, wc, fr, fq, ui & 1); else E(acc, cur, wr, wc, fr, fq); S.done(cur); }
        if (!has_next) break;
#pragma unroll
        for (int a = 0; a < 2; ++a)
#pragma unroll
            for (int b = 0; b < 2; ++b)
#pragma unroll
                for (int m = 0; m < 4; ++m)
#pragma unroll
                    for (int n = 0; n < 2; ++n) acc[a][b][m][n] = (f32x4){0.f, 0.f, 0.f, 0.f};
        cur = nxt; cA = nA; cB = nB; ++ui;
        if constexpr (ALIGN_EPI) { if (wr == 1) PG8_BAR; }
    }
    PG8_WAIT_V(0);
    if constexpr (!ALIGN_EPI) { if (wr == 0) PG8_BAR; }
    PG8_BAR;
    if constexpr (Epi::AFTER_DRAIN) { E.fused(acc, cur, wr, wc, fr, fq, lds, wid, lane); S.done(cur); }
#undef PG8_SA
#undef PG8_SB
#undef PG8_STAGE
#undef PG8_LDA
#undef PG8_LDB
#undef PG8_MMA
#undef PG8_WAIT_V
#undef PG8_WAIT_L
#undef PG8_BAR
#undef PG8_SCHED
}
}

#define GAS __attribute__((address_space(1)))
#define LAS __attribute__((address_space(3)))
typedef unsigned short bf16;
typedef unsigned v4u __attribute__((ext_vector_type(4)));
typedef unsigned v2u __attribute__((ext_vector_type(2)));
typedef float f32x4 __attribute__((ext_vector_type(4)));
typedef short bf16x8 __attribute__((ext_vector_type(8)));
typedef GAS unsigned gu32;
typedef GAS unsigned long long gu64;
#define RLX_AGENT __ATOMIC_RELAXED, __HIP_MEMORY_SCOPE_AGENT
#define LDS_WAIT() asm volatile("s_waitcnt lgkmcnt(0)" ::: "memory")
#define VM_WAIT() asm volatile("s_waitcnt vmcnt(0)" ::: "memory")
__device__ __forceinline__ unsigned long long rt() { return __builtin_amdgcn_s_memrealtime(); }
__device__ __forceinline__ unsigned f2bf(float f) { unsigned u = __builtin_bit_cast(unsigned, f); return (u + 0x7fffu + ((u >> 16) & 1u)) >> 16; }
__device__ __forceinline__ unsigned pk2(float lo, float hi) { return f2bf(lo) | (f2bf(hi) << 16); }

#define XB_TMO      128
#define XB_XCNT(j)  (256  + 64 * (j))
#define XB_XSUB(j)  (1280 + 64 * (j))
#define XB_XGEN(j)  (2304 + 64 * (j))
#define XB_TOP      3328
#define XB_TOPGEN   3392
#define XCD_BAR_WORDS 3456
#define XB_SPIN_CAP (1u << 18)

__device__ __forceinline__ unsigned xb_ld(unsigned* p)              { return __hip_atomic_load(p, __ATOMIC_RELAXED, __HIP_MEMORY_SCOPE_AGENT); }
__device__ __forceinline__ unsigned xb_add(unsigned* p, unsigned v) { return __hip_atomic_fetch_add(p, v, __ATOMIC_RELAXED, __HIP_MEMORY_SCOPE_AGENT); }
__device__ __forceinline__ unsigned xb_xcc_id() { return (unsigned)__builtin_amdgcn_s_getreg((3 << 11) | 20) & 0xFu; }
#define XB_SPIN(cond, bar) do { unsigned _sp = 0; while (cond) { __builtin_amdgcn_s_sleep(1); \
    if ((++_sp & 255u) == 0u) { if (xb_ld(&(bar)[XB_TMO])) break; if (_sp > XB_SPIN_CAP) { atomicAdd(&(bar)[XB_TMO], 1u); break; } } } } while (0)

struct XcdBarrier {
    unsigned* bar; unsigned x;
    volatile LAS unsigned* st;
};

__device__ __forceinline__ XcdBarrier xcd_barrier_post(unsigned* bar, volatile LAS unsigned* st) {
    XcdBarrier b; b.bar = bar; b.x = xb_xcc_id(); b.st = st;
    if (threadIdx.x == 0) (void)xb_add(&bar[XB_XCNT(b.x)], 1u);
    return b;
}
__device__ __forceinline__ void xcd_barrier_complete(unsigned* bar, unsigned x, unsigned& nloc, unsigned& nx) {
    const unsigned G = gridDim.x * gridDim.y * gridDim.z;
    unsigned sum, cnt, mine, sp = 0u;
    for (;;) {
        sum = 0u; cnt = 0u; mine = 0u;
#pragma unroll
        for (unsigned j = 0; j < 16; ++j) { const unsigned c = xb_ld(&bar[XB_XCNT(j)]); sum += c; cnt += (c > 0u) ? 1u : 0u; mine = (j == x) ? c : mine; }
        if (sum == G) break;
        __builtin_amdgcn_s_sleep(1);
        if ((++sp & 255u) == 0u) { if (xb_ld(&bar[XB_TMO])) break; if (sp > XB_SPIN_CAP) { atomicAdd(&bar[XB_TMO], 1u); break; } }
    }
    nloc = mine > 0u ? mine : 1u; nx = cnt > 0u ? cnt : 1u;
}

__device__ __forceinline__ void xcd_barrier(const XcdBarrier& b, bool is_t0) {
    asm volatile("s_waitcnt vmcnt(0)" ::: "memory");
    __syncthreads();
    if (is_t0) {
        unsigned* bar = b.bar;
        __builtin_amdgcn_s_waitcnt(0);
        unsigned nloc = b.st[0], nx = b.st[1];
        if (nloc == 0u) { xcd_barrier_complete(bar, b.x, nloc, nx); b.st[0] = nloc; b.st[1] = nx; }
        const unsigned old = xb_add(&bar[XB_XSUB(b.x)], 1u);
        const unsigned gen = old / nloc;
        if (old + 1u == (gen + 1u) * nloc) {
            __builtin_amdgcn_fence(__ATOMIC_RELEASE, "agent");
            asm volatile("s_waitcnt vmcnt(0)" ::: "memory");
            const unsigned og = xb_add(&bar[XB_TOP], 1u);
            const unsigned tg = og / nx;
            if (og + 1u == (tg + 1u) * nx) xb_add(&bar[XB_TOPGEN], 1u);
            else XB_SPIN(xb_ld(&bar[XB_TOPGEN]) == tg, bar);
            __builtin_amdgcn_fence(__ATOMIC_ACQUIRE, "agent");
            xb_add(&bar[XB_XGEN(b.x)], 1u);
            asm volatile("s_waitcnt vmcnt(0)" ::: "memory");
        } else {
            XB_SPIN(xb_ld(&bar[XB_XGEN(b.x)]) == gen, bar);
            __builtin_amdgcn_fence(__ATOMIC_ACQUIRE, "agent");
            asm volatile("s_waitcnt vmcnt(0)" ::: "memory");
        }
    }
    __syncthreads();
}


constexpr int NB = 16, T = 4096, D = 1024, DEPTH = 4, M = NB * T;
constexpr int HD = 64, H_HGRN = 6, H_FOX = 6, H_RET = 4;
constexpr int IN_COLS = 4102, NP = 4096, D_FF = 2816, NUP = 2 * D_FF;
constexpr float EPS = 1e-6f;
constexpr int OC_AQ = 0, OC_AF = 384, OC_AI = 768, OC_AG = 1152, OC_BQ = 1536, OC_BK = 1920, OC_BV = 2304, OC_BF = 2688, OC_BG = 2694, OC_CQ = 3078, OC_CK = 3334, OC_CV = 3590, OC_CG = 3846;
constexpr int PC_AQ = 0, PC_BQ = 384, PC_CQ = 768, PC_AF = 1024, PC_AI = 1408, PC_AG = 1792, PC_BK = 2176, PC_BV = 2560, PC_BG = 2944, PC_CK = 3328, PC_CV = 3584, PC_CG = 3840;
#define CB(pc) ((size_t)((pc) >> 6) * (size_t)M * 64)
__device__ __forceinline__ int pcol_to_orig(int n) {
    if (n < 384) return OC_AQ + n; if (n < 768) return OC_BQ + (n - 384); if (n < 1024) return OC_CQ + (n - 768);
    if (n < 1408) return OC_AF + (n - 1024); if (n < 1792) return OC_AI + (n - 1408); if (n < 2176) return OC_AG + (n - 1792);
    if (n < 2560) return OC_BK + (n - 2176); if (n < 2944) return OC_BV + (n - 2560); if (n < 3328) return OC_BG + (n - 2944);
    if (n < 3584) return OC_CK + (n - 3328); if (n < 3840) return OC_CV + (n - 3584); return OC_CG + (n - 3840);
}
constexpr size_t MiB = 1u << 20;
constexpr size_t WS_CTL = 0, CTL_ZERO_BYTES = 1 * MiB;
constexpr size_t WS_WIN = 2 * MiB, WS_WOUT = 34 * MiB, WS_WUP = 42 * MiB, WS_WDN = 86 * MiB;
constexpr size_t WS_WF = 108 * MiB;
constexpr size_t WS_COS = 109 * MiB, WS_SIN = WS_COS + 512 * 1024;
constexpr size_t WS_LB = 110 * MiB;
constexpr size_t WS_LOGF = 111 * MiB;
constexpr size_t WS_FCUM = 113 * MiB;
constexpr size_t WS_H = 116 * MiB;
constexpr size_t WS_MIX = 244 * MiB;
constexpr size_t WS_P = 372 * MiB;
constexpr size_t WS_ACT = WS_P;
constexpr size_t WS_EDGEL = WS_P + 352 * MiB, WS_EDGEP = WS_P + 364 * MiB;
constexpr size_t WS_SLOT1 = WS_MIX, WS_SLOT2 = WS_MIX + 1 * MiB, WS_LPART = WS_MIX + 2 * MiB;
constexpr size_t WS_XB = 884 * MiB;
constexpr size_t WS_RS = 114 * MiB + 512 * 1024;
constexpr size_t WS_END = 1012 * MiB;
constexpr int CW_BAR = 4096, CW_QUEUE = 16384, CW_FLAGS = 20480, CW_CNT = 65536;
constexpr int RING_BYTES = 131072, LDSCTL_OFF = RING_BYTES, MISC_OFF = LDSCTL_OFF + 320, HALO_OFF = RING_BYTES + 1024, GAIN_OFF = RING_BYTES + 10240, LGL_OFF = RING_BYTES + 6400, LDS_BYTES = 163840;
constexpr int NWAVES = 8;

__device__ __forceinline__ float wave_sum(float v, int lane) {
    (void)lane;
    v += dppf<0xB1>(v); v += dppf<0x4E>(v); v += dppf<0x141>(v); v += dppf<0x140>(v);
    { auto r = __builtin_amdgcn_permlane16_swap(__float_as_uint(v), __float_as_uint(v), false, false); v = __uint_as_float(r[0]) + __uint_as_float(r[1]); }
    { auto r = __builtin_amdgcn_permlane32_swap(__float_as_uint(v), __float_as_uint(v), false, false); v = __uint_as_float(r[0]) + __uint_as_float(r[1]); }
    return v;
}
__device__ __forceinline__ float bf_lo(unsigned w) { return __uint_as_float(w << 16); }
__device__ __forceinline__ float bf_hi(unsigned w) { return __uint_as_float(w & 0xffff0000u); }
__device__ __forceinline__ float bf1(bf16 w) { return __uint_as_float(((unsigned)w) << 16); }

__device__ __forceinline__ void tr_item(const float* W, int ldw, int src_col0, int k0, bf16* WT, int ldt, int dst_row0_, LAS float* scr, int lane, const float* gk = nullptr, bool ilv = false, bool wperm = false) {
    const int dst_row0 = wperm ? ((dst_row0_ & ~255) | (((dst_row0_ >> 5) & 1) << 7) | (((dst_row0_ >> 6) & 3) << 5)) : dst_row0_;
    const int j_ = lane & 31, scol = src_col0 + (ilv ? ((j_ & 1) ? (j_ >> 1) + 32 : (j_ >> 1)) : j_);
    float wv[32];
#pragma unroll
    for (int i = 0; i < 32; ++i) { const int kk = 2 * i + (lane >> 5); wv[i] = W[(size_t)(k0 + kk) * ldw + scol]; }
    asm volatile("" ::: "memory");
#pragma unroll
    for (int i = 0; i < 32; ++i) { const int kk = 2 * i + (lane >> 5); scr[kk * 33 + (lane & 31)] = wv[i] * (gk ? gk[k0 + kk] : 1.0f); }
    LDS_WAIT(); asm volatile("" ::: "memory");
    const int c = lane & 7;
#pragma unroll
    for (int j = 0; j < 4; ++j) { const int n = (lane >> 3) + 8 * j; const LAS float* s = scr + (8 * c) * 33 + n;
        v4u o; o.x = pk2(s[0 * 33], s[1 * 33]); o.y = pk2(s[2 * 33], s[3 * 33]); o.z = pk2(s[4 * 33], s[5 * 33]); o.w = pk2(s[6 * 33], s[7 * 33]);
        *(GAS v4u*)(WT + ((size_t)(k0 >> 6) * ldt + dst_row0 + n) * 64 + 8 * c) = o; }
    LDS_WAIT(); asm volatile("" ::: "memory");
}

__device__ __forceinline__ float log_sigmoid_f(float v) { return fminf(v, 0.f) - 0.6931471805599453f * __builtin_amdgcn_logf(1.0f + __builtin_amdgcn_exp2f(-fabsf(v) * 1.4426950408889634f)); }

template <int R> __device__ __forceinline__ void row_updateNx(int lane, size_t m, size_t dm, const float* xf_base, const bf16* xb_base, const bf16* add_base, const float* gpost,
                                             bf16* xb_obase, float* xf_obase, float* rs_base, const float* wf, const float* bfox, float* logf_base, const f32x4 (*pre)[4] = nullptr) {
    const float bfl = wf ? bfox[lane < 6 ? lane : 0] : 0.f;
    f32x4 v[R][4];
#pragma unroll
    for (int r = 0; r < R; ++r) { const size_t row = m + r * dm;
        if (pre) {
#pragma unroll
            for (int j = 0; j < 4; ++j) v[r][j] = pre[r][j];
        } else if (xf_base) {
#pragma unroll
            for (int j = 0; j < 4; ++j) v[r][j] = *(const f32x4*)(xf_base + row * D + 4 * lane + 256 * j);
        } else {
#pragma unroll
            for (int j = 0; j < 4; ++j) { const uint2 w = *(const uint2*)(xb_base + row * D + 4 * lane + 256 * j); v[r][j] = (f32x4){bf_lo(w.x), bf_hi(w.x), bf_lo(w.y), bf_hi(w.y)}; }
        } }
    if (add_base) {
        f32x4 a[R][4]; float ss[R];
#pragma unroll
        for (int r = 0; r < R; ++r) ss[r] = 0.f;
#pragma unroll
        for (int r = 0; r < R; ++r)
#pragma unroll
            for (int j = 0; j < 4; ++j) { const uint2 w = *(const uint2*)(add_base + (m + r * dm) * D + 4 * lane + 256 * j); a[r][j] = (f32x4){bf_lo(w.x), bf_hi(w.x), bf_lo(w.y), bf_hi(w.y)};
                ss[r] += (a[r][j].x * a[r][j].x + a[r][j].y * a[r][j].y) + (a[r][j].z * a[r][j].z + a[r][j].w * a[r][j].w); }
        f32x4 g[4];
#pragma unroll
        for (int j = 0; j < 4; ++j) g[j] = *(const f32x4*)(gpost + 4 * lane + 256 * j);
#pragma unroll
        for (int r = 0; r < R; ++r) { const float rs = 1.0f / sqrtf(wave_sum(ss[r], lane) * (1.f / D) + EPS);
#pragma unroll
            for (int j = 0; j < 4; ++j) v[r][j] = v[r][j] + a[r][j] * rs * g[j]; }
    }
#pragma unroll
    for (int r = 0; r < R; ++r) { const size_t row = m + r * dm;
        if (xf_obase) {
#pragma unroll
            for (int j = 0; j < 4; ++j) *(f32x4*)(xf_obase + row * D + 4 * lane + 256 * j) = v[r][j];
        }
        if (xb_obase) {
#pragma unroll
            for (int j = 0; j < 4; ++j) { uint2 w; w.x = pk2(v[r][j].x, v[r][j].y); w.y = pk2(v[r][j].z, v[r][j].w); *(uint2*)(xb_obase + ((size_t)(4 * j + (lane >> 4)) * M + row) * 64 + ((4 * lane) & 63)) = w; }
        } }
    if (rs_base) {
        float rs[R];
#pragma unroll
        for (int r = 0; r < R; ++r) { float ss = 0.f;
#pragma unroll
            for (int j = 0; j < 4; ++j) ss += (v[r][j].x * v[r][j].x + v[r][j].y * v[r][j].y) + (v[r][j].z * v[r][j].z + v[r][j].w * v[r][j].w);
            const float sst = wave_sum(ss, lane); rs[r] = 1.0f / sqrtf(sst * (1.f / D) + EPS);
            if (lane == 0) *(f32x4*)(rs_base + 4 * (m + r * dm)) = (f32x4){sst, 0.f, 0.f, 0.f}; }
        if (wf) {
            float mine[R];
#pragma unroll
            for (int r = 0; r < R; ++r) mine[r] = 0.f;
#pragma unroll
            for (int jj = 0; jj < 6; ++jj) { f32x4 w[4];
#pragma unroll
                for (int j = 0; j < 4; ++j) w[j] = *(const f32x4*)(wf + jj * 1024 + 4 * lane + 256 * j);
#pragma unroll
                for (int r = 0; r < R; ++r) { float d = 0.f;
#pragma unroll
                    for (int j = 0; j < 4; ++j) d += (v[r][j].x * w[j].x + v[r][j].y * w[j].y) + (v[r][j].z * w[j].z + v[r][j].w * w[j].w);
                    d = wave_sum(d, lane); if (lane == jj) mine[r] = d; } }
            if (lane < 6) {
#pragma unroll
                for (int r = 0; r < R; ++r) logf_base[(m + r * dm) * 8 + lane] = log_sigmoid_f(mine[r] * rs[r] + bfl); }
        }
    }
}


template <int R> __device__ __forceinline__ void row_pass_pf(int lane, int gw, int NGW, bf16* XB, const bf16* MIXp, const float* gpost, bool write_xb, float* xf_obase, float* rs_base,
                                                             const float* wf, const float* bfox, float* logf_base) {
    uint2 xr[R][4], ar[R][4];
    const size_t step = (size_t)R * NGW; size_t m = (size_t)R * gw;
#pragma unroll
    for (int r = 0; r < R; ++r)
#pragma unroll
        for (int j = 0; j < 4; ++j) { xr[r][j] = *(const uint2*)(XB + (m + r) * D + 4 * lane + 256 * j); ar[r][j] = *(const uint2*)(MIXp + (m + r) * D + 4 * lane + 256 * j); }
    f32x4 g[4];
#pragma unroll
    for (int j = 0; j < 4; ++j) g[j] = *(const f32x4*)(gpost + 4 * lane + 256 * j);
    for (; m < (size_t)M; m += step) {
        f32x4 v[R][4], a[R][4]; float ss[R];
#pragma unroll
        for (int r = 0; r < R; ++r) { ss[r] = 0.f;
#pragma unroll
            for (int j = 0; j < 4; ++j) { v[r][j] = (f32x4){bf_lo(xr[r][j].x), bf_hi(xr[r][j].x), bf_lo(xr[r][j].y), bf_hi(xr[r][j].y)}; a[r][j] = (f32x4){bf_lo(ar[r][j].x), bf_hi(ar[r][j].x), bf_lo(ar[r][j].y), bf_hi(ar[r][j].y)};
                ss[r] += (a[r][j].x * a[r][j].x + a[r][j].y * a[r][j].y) + (a[r][j].z * a[r][j].z + a[r][j].w * a[r][j].w); } }
        const size_t mn = m + step;
        if (mn < (size_t)M) {
#pragma unroll
            for (int r = 0; r < R; ++r)
#pragma unroll
                for (int j = 0; j < 4; ++j) { xr[r][j] = *(const uint2*)(XB + (mn + r) * D + 4 * lane + 256 * j); ar[r][j] = *(const uint2*)(MIXp + (mn + r) * D + 4 * lane + 256 * j); } }
        asm volatile("" ::: "memory");
        float rs2[R], s2t[R];
#pragma unroll
        for (int r = 0; r < R; ++r) { const float rs = 1.0f / sqrtf(wave_sum(ss[r], lane) * (1.f / D) + EPS); float s2 = 0.f;
#pragma unroll
            for (int j = 0; j < 4; ++j) { v[r][j] = v[r][j] + a[r][j] * rs * g[j]; s2 += (v[r][j].x * v[r][j].x + v[r][j].y * v[r][j].y) + (v[r][j].z * v[r][j].z + v[r][j].w * v[r][j].w); }
            s2t[r] = wave_sum(s2, lane); rs2[r] = 1.0f / sqrtf(s2t[r] * (1.f / D) + EPS); }
#pragma unroll
        for (int r = 0; r < R; ++r) {
            if (write_xb) {
#pragma unroll
                for (int j = 0; j < 4; ++j) { uint2 w; w.x = pk2(v[r][j].x, v[r][j].y); w.y = pk2(v[r][j].z, v[r][j].w); *(uint2*)(XB + (m + r) * D + 4 * lane + 256 * j) = w; }
            } else {
#pragma unroll
                for (int j = 0; j < 4; ++j) *(f32x4*)(xf_obase + (m + r) * D + 4 * lane + 256 * j) = v[r][j];
            }
            if (rs_base && lane == 0) *(f32x4*)(rs_base + 4 * (m + r)) = (f32x4){s2t[r], 0.f, 0.f, 0.f}; }
        if (wf) {
            float mine[R];
#pragma unroll
            for (int r = 0; r < R; ++r) mine[r] = 0.f;
#pragma unroll
            for (int jj = 0; jj < 6; ++jj) { f32x4 w[4];
#pragma unroll
                for (int j = 0; j < 4; ++j) w[j] = *(const f32x4*)(wf + jj * 1024 + 4 * lane + 256 * j);
#pragma unroll
                for (int r = 0; r < R; ++r) { float d = 0.f;
#pragma unroll
                    for (int j = 0; j < 4; ++j) d += (v[r][j].x * w[j].x + v[r][j].y * w[j].y) + (v[r][j].z * w[j].z + v[r][j].w * w[j].w);
                    d = wave_sum(d, lane); if (lane == jj) mine[r] = d; } }
            if (lane < 6) {
#pragma unroll
                for (int r = 0; r < R; ++r) logf_base[(m + r) * 8 + lane] = log_sigmoid_f(mine[r] * rs2[r] + bfox[lane]); }
        }
    }
}

namespace pg8 {
__device__ __forceinline__ float fq_sum(float v) {
    { auto r = __builtin_amdgcn_permlane16_swap(__float_as_uint(v), __float_as_uint(v), false, false); v = __uint_as_float(r[0]) + __uint_as_float(r[1]); }
    { auto r = __builtin_amdgcn_permlane32_swap(__float_as_uint(v), __float_as_uint(v), false, false); v = __uint_as_float(r[0]) + __uint_as_float(r[1]); }
    return v; }
struct EpiNormRes {
    static constexpr bool PERM = true, AFTER_DRAIN = false, PREFETCH = false;
    bf16_t* XB; const PG8_LAS float* gl; float* SLOT1; unsigned* CNT1; float* RS; PG8_LAS float* red;
    __device__ __forceinline__ void operator()(f32x4 (&acc)[2][2][4][2], const Unit& u, int wr, int wc, int fr, int fq) const {
        { const int l_ = fresh_lane(); fr = l_ & 15; fq = l_ >> 4; }
        const int tid = (wr * 4 + wc) * 64 + fq * 16 + fr, rl0 = wr * 64 + fr;
        PG8_LAS float* rowfac = red + 1024; volatile PG8_LAS unsigned* bc = (volatile PG8_LAS unsigned*)(red + 1280);
        const int col0 = u.pn * BM + wc * 64 + 8 * fq;
#pragma unroll
        for (int ai = 0; ai < 2; ++ai)
#pragma unroll
            for (int m = 0; m < 4; ++m) { float s = 0.f;
#pragma unroll
                for (int bj = 0; bj < 2; ++bj)
#pragma unroll
                    for (int n = 0; n < 2; ++n) { const f32x4 a = acc[ai][bj][m][n]; s += (a[0] * a[0] + a[1] * a[1]) + (a[2] * a[2] + a[3] * a[3]); }
                s = fq_sum(s); if (fq == 0) red[(rl0 + ai * HALF + m * 16) * 4 + wc] = s; }
        asm volatile("s_waitcnt lgkmcnt(0)" ::: "memory"); __builtin_amdgcn_s_barrier(); asm volatile("" ::: "memory");
        if (tid < 128) { const f32x4 q0 = *(const PG8_LAS f32x4*)(red + 8 * tid), q1 = *(const PG8_LAS f32x4*)(red + 8 * tid + 4);
            const float t0 = (q0[0] + q0[1]) + (q0[2] + q0[3]), t1 = (q1[0] + q1[1]) + (q1[2] + q1[3]);
            __hip_atomic_store((unsigned long long*)(SLOT1 + (size_t)(u.pm * 4 + u.pn) * 256 + 2 * tid), (unsigned long long)__float_as_uint(t0) | ((unsigned long long)__float_as_uint(t1) << 32), __ATOMIC_RELAXED, __HIP_MEMORY_SCOPE_AGENT); }
        asm volatile("s_waitcnt vmcnt(0)" ::: "memory"); __builtin_amdgcn_s_barrier(); asm volatile("" ::: "memory");
        u32x4 xw[2][4][2];
#pragma unroll
        for (int ai = 0; ai < 2; ++ai)
#pragma unroll
            for (int m = 0; m < 4; ++m)
#pragma unroll
                for (int bj = 0; bj < 2; ++bj) xw[ai][m][bj] = *(const u32x4*)(XB + ((size_t)(col0 >> 6) * M + (u.pm * BM + rl0 + ai * HALF + m * 16)) * 64 + (col0 & 63) + 32 * bj);
        if (tid == 0) { unsigned* c = CNT1 + u.pm * 16; __hip_atomic_fetch_add(c, 1u, __ATOMIC_RELAXED, __HIP_MEMORY_SCOPE_AGENT); unsigned sp = 0u;
            while (__hip_atomic_load(c, __ATOMIC_RELAXED, __HIP_MEMORY_SCOPE_AGENT) < 4u) { __builtin_amdgcn_s_sleep(1); if (++sp > (1u << 22)) break; }
            __builtin_amdgcn_fence(__ATOMIC_ACQUIRE, "agent"); asm volatile("s_waitcnt vmcnt(0)" ::: "memory"); }
        __builtin_amdgcn_s_barrier(); asm volatile("" ::: "memory");
        if (tid < 256) { float sl_[4];
#pragma unroll
            for (int q = 0; q < 4; ++q) sl_[q] = SLOT1[(size_t)(u.pm * 4 + q) * 256 + tid];
            const float tot = ((sl_[0] + sl_[1]) + sl_[2]) + sl_[3];
            rowfac[tid] = __builtin_amdgcn_rsqf(tot * (1.f / 1024.f) + 1e-6f); }
        asm volatile("s_waitcnt lgkmcnt(0)" ::: "memory"); __builtin_amdgcn_s_barrier(); asm volatile("" ::: "memory");
#pragma unroll
        for (int ai = 0; ai < 2; ++ai)
#pragma unroll
            for (int m = 0; m < 4; ++m) { const int rl = rl0 + ai * HALF + m * 16; const float ry = rowfac[rl]; float s2 = 0.f;
#pragma unroll
                for (int bj = 0; bj < 2; ++bj) { const u32x4 xo = xw[ai][m][bj];
                    const PG8_LAS float* gp = gl + col0 + bj * 32;
                    f32x4 v0 = acc[ai][bj][m][0] * ry * *(const PG8_LAS f32x4*)gp, v1 = acc[ai][bj][m][1] * ry * *(const PG8_LAS f32x4*)(gp + 4);
                    v0[0] += __uint_as_float(xo.x << 16); v0[1] += __uint_as_float(xo.x & 0xffff0000u); v0[2] += __uint_as_float(xo.y << 16); v0[3] += __uint_as_float(xo.y & 0xffff0000u);
                    v1[0] += __uint_as_float(xo.z << 16); v1[1] += __uint_as_float(xo.z & 0xffff0000u); v1[2] += __uint_as_float(xo.w << 16); v1[3] += __uint_as_float(xo.w & 0xffff0000u);
                    s2 += ((v0[0] * v0[0] + v0[1] * v0[1]) + (v0[2] * v0[2] + v0[3] * v0[3])) + ((v1[0] * v1[0] + v1[1] * v1[1]) + (v1[2] * v1[2] + v1[3] * v1[3]));
                    acc[ai][bj][m][0] = v0; acc[ai][bj][m][1] = v1; }
                s2 = fq_sum(s2); if (fq == 0) red[rl * 4 + wc] = s2; }
        asm volatile("s_waitcnt lgkmcnt(0)" ::: "memory"); __builtin_amdgcn_s_barrier(); asm volatile("" ::: "memory");
        if (tid < 256) { const f32x4 q = *(const PG8_LAS f32x4*)(red + 4 * tid); RS[(size_t)(u.pm * BM + tid) * 4 + u.pn] = (q[0] + q[1]) + (q[2] + q[3]); }
#pragma unroll
        for (int ai = 0; ai < 2; ++ai)
#pragma unroll
            for (int m = 0; m < 4; ++m) { bf16_t* rowp = XB + ((size_t)(col0 >> 6) * M + (u.pm * BM + rl0 + ai * HALF + m * 16)) * 64 + (col0 & 63);
#pragma unroll
                for (int bj = 0; bj < 2; ++bj) { const f32x4 v0 = acc[ai][bj][m][0], v1 = acc[ai][bj][m][1];
                    u32x4 w; w.x = cvt_pk_bf16_v(v0[0], v0[1]); w.y = cvt_pk_bf16_v(v0[2], v0[3]); w.z = cvt_pk_bf16_v(v1[0], v1[1]); w.w = cvt_pk_bf16_v(v1[2], v1[3]);
                    *(u32x4*)(rowp + bj * 32) = w; } }
    }
};
struct EpiNormResFFN {
    static constexpr bool PERM = true, AFTER_DRAIN = false, PREFETCH = false;
    bf16_t* XB; const float* gain; float* SLOT1; unsigned* CNT1; float* RS; PG8_LAS float* red; float* XF; const float* WF; const float* bias; float* LPART; unsigned* CNT2; float* LOGF; PG8_LAS float* lgl;
    __device__ __forceinline__ void operator()(f32x4 (&acc)[2][2][4][2], const Unit& u, int wr, int wc, int fr, int fq) const {
        { const int l_ = fresh_lane(); fr = l_ & 15; fq = l_ >> 4; }
        const int tid = (wr * 4 + wc) * 64 + fq * 16 + fr, rl0 = wr * 64 + fr;
        PG8_LAS float* rowfac = red + 1024; volatile PG8_LAS unsigned* bc = (volatile PG8_LAS unsigned*)(red + 1280);
        const int col0 = u.pn * BM + wc * 64 + 8 * fq;
        lgl[tid] = gain[tid]; lgl[tid + 512] = gain[tid + 512];
#pragma unroll
        for (int ai = 0; ai < 2; ++ai)
#pragma unroll
            for (int m = 0; m < 4; ++m) { float s = 0.f;
#pragma unroll
                for (int bj = 0; bj < 2; ++bj)
#pragma unroll
                    for (int n = 0; n < 2; ++n) { const f32x4 a = acc[ai][bj][m][n]; s += (a[0] * a[0] + a[1] * a[1]) + (a[2] * a[2] + a[3] * a[3]); }
                s = fq_sum(s); if (fq == 0) red[(rl0 + ai * HALF + m * 16) * 4 + wc] = s; }
        asm volatile("s_waitcnt lgkmcnt(0)" ::: "memory"); __builtin_amdgcn_s_barrier(); asm volatile("" ::: "memory");
        if (tid < 128) { const f32x4 q0 = *(const PG8_LAS f32x4*)(red + 8 * tid), q1 = *(const PG8_LAS f32x4*)(red + 8 * tid + 4);
            const float t0 = (q0[0] + q0[1]) + (q0[2] + q0[3]), t1 = (q1[0] + q1[1]) + (q1[2] + q1[3]);
            __hip_atomic_store((unsigned long long*)(SLOT1 + (size_t)(u.pm * 4 + u.pn) * 256 + 2 * tid), (unsigned long long)__float_as_uint(t0) | ((unsigned long long)__float_as_uint(t1) << 32), __ATOMIC_RELAXED, __HIP_MEMORY_SCOPE_AGENT); }
        asm volatile("s_waitcnt vmcnt(0)" ::: "memory"); __builtin_amdgcn_s_barrier(); asm volatile("" ::: "memory");
        u32x4 xw[2][4][2];
#pragma unroll
        for (int ai = 0; ai < 2; ++ai)
#pragma unroll
            for (int m = 0; m < 4; ++m)
#pragma unroll
                for (int bj = 0; bj < 2; ++bj) xw[ai][m][bj] = *(const u32x4*)(XB + ((size_t)(col0 >> 6) * M + (u.pm * BM + rl0 + ai * HALF + m * 16)) * 64 + (col0 & 63) + 32 * bj);
        if (tid == 0) { unsigned* c = CNT1 + u.pm * 16; __hip_atomic_fetch_add(c, 1u, __ATOMIC_RELAXED, __HIP_MEMORY_SCOPE_AGENT); unsigned sp = 0u;
            while (__hip_atomic_load(c, __ATOMIC_RELAXED, __HIP_MEMORY_SCOPE_AGENT) < 4u) { __builtin_amdgcn_s_sleep(1); if (++sp > (1u << 22)) break; }
            __builtin_amdgcn_fence(__ATOMIC_ACQUIRE, "agent"); asm volatile("s_waitcnt vmcnt(0)" ::: "memory"); }
        __builtin_amdgcn_s_barrier(); asm volatile("" ::: "memory");
        if (tid < 256) { float sl_[4];
#pragma unroll
            for (int q = 0; q < 4; ++q) sl_[q] = SLOT1[(size_t)(u.pm * 4 + q) * 256 + tid];
            const float tot = ((sl_[0] + sl_[1]) + sl_[2]) + sl_[3];
            rowfac[tid] = __builtin_amdgcn_rsqf(tot * (1.f / 1024.f) + 1e-6f); }
        asm volatile("s_waitcnt lgkmcnt(0)" ::: "memory"); __builtin_amdgcn_s_barrier(); asm volatile("" ::: "memory");
#pragma unroll
        for (int ai = 0; ai < 2; ++ai)
#pragma unroll
            for (int m = 0; m < 4; ++m) { const int rl = rl0 + ai * HALF + m * 16; const float ry = rowfac[rl]; float s2 = 0.f;
#pragma unroll
                for (int bj = 0; bj < 2; ++bj) { const u32x4 xo = xw[ai][m][bj];
                    const PG8_LAS float* gp = lgl + col0 + bj * 32;
                    f32x4 v0 = acc[ai][bj][m][0] * ry * *(const PG8_LAS f32x4*)gp, v1 = acc[ai][bj][m][1] * ry * *(const PG8_LAS f32x4*)(gp + 4);
                    v0[0] += __uint_as_float(xo.x << 16); v0[1] += __uint_as_float(xo.x & 0xffff0000u); v0[2] += __uint_as_float(xo.y << 16); v0[3] += __uint_as_float(xo.y & 0xffff0000u);
                    v1[0] += __uint_as_float(xo.z << 16); v1[1] += __uint_as_float(xo.z & 0xffff0000u); v1[2] += __uint_as_float(xo.w << 16); v1[3] += __uint_as_float(xo.w & 0xffff0000u);
                    s2 += ((v0[0] * v0[0] + v0[1] * v0[1]) + (v0[2] * v0[2] + v0[3] * v0[3])) + ((v1[0] * v1[0] + v1[1] * v1[1]) + (v1[2] * v1[2] + v1[3] * v1[3]));
                    acc[ai][bj][m][0] = v0; acc[ai][bj][m][1] = v1; }
                if (!XF) { s2 = fq_sum(s2); if (fq == 0) red[rl * 4 + wc] = s2; } }
        if (XF) {
            int rl0b = rl0, col0b = col0; asm volatile("" : "+v"(rl0b), "+v"(col0b));
#pragma unroll
            for (int ai = 0; ai < 2; ++ai)
#pragma unroll
                for (int m = 0; m < 4; ++m) { float* rowp = XF + (size_t)(u.pm * BM + rl0b + ai * HALF + m * 16) * 1024 + col0b;
#pragma unroll
                    for (int bj = 0; bj < 2; ++bj) { *(f32x4*)(rowp + bj * 32) = acc[ai][bj][m][0]; *(f32x4*)(rowp + bj * 32 + 4) = acc[ai][bj][m][1]; } }
            return; }
        f32x4 wfc[2][2], wfn[2][2];
#pragma unroll
        for (int bj = 0; bj < 2; ++bj)
#pragma unroll
            for (int n = 0; n < 2; ++n) wfc[bj][n] = *(const f32x4*)(WF + col0 + bj * 32 + 4 * n);
        asm volatile("s_waitcnt lgkmcnt(0)" ::: "memory"); __builtin_amdgcn_s_barrier(); asm volatile("" ::: "memory");
#pragma unroll
        for (int j = 0; j < 6; ++j) {
            if (j < 5) {
#pragma unroll
                for (int bj = 0; bj < 2; ++bj)
#pragma unroll
                    for (int n = 0; n < 2; ++n) wfn[bj][n] = *(const f32x4*)(WF + (j + 1) * 1024 + col0 + bj * 32 + 4 * n); }
#pragma unroll
            for (int ai = 0; ai < 2; ++ai)
#pragma unroll
                for (int m = 0; m < 4; ++m) { float d = 0.f;
#pragma unroll
                    for (int bj = 0; bj < 2; ++bj)
#pragma unroll
                        for (int n = 0; n < 2; ++n) { const f32x4 a = acc[ai][bj][m][n], w = wfc[bj][n]; d += (a[0] * w[0] + a[1] * w[1]) + (a[2] * w[2] + a[3] * w[3]); }
                    d = fq_sum(d); if (fq == 0) lgl[((rl0 + ai * HALF + m * 16) * 4 + wc) * 6 + j] = d; }
#pragma unroll
            for (int bj = 0; bj < 2; ++bj)
#pragma unroll
                for (int n = 0; n < 2; ++n) wfc[bj][n] = wfn[bj][n]; }
        asm volatile("s_waitcnt lgkmcnt(0)" ::: "memory"); __builtin_amdgcn_s_barrier(); asm volatile("" ::: "memory");
        if (tid < 256) { const f32x4 q = *(const PG8_LAS f32x4*)(red + 4 * tid); const float s2t = (q[0] + q[1]) + (q[2] + q[3]);
            RS[(size_t)(u.pm * BM + tid) * 4 + u.pn] = s2t;
            float* lp = LPART + ((size_t)(u.pm * 4 + u.pn) * 256 + tid) * 8; float pv[8]; pv[0] = s2t; pv[7] = 0.f;
#pragma unroll
            for (int j = 0; j < 6; ++j) { const PG8_LAS float* lg = lgl + (tid * 4) * 6 + j; pv[1 + j] = (lg[0] + lg[6]) + (lg[12] + lg[18]); }
#pragma unroll
            for (int j = 0; j < 4; ++j) __hip_atomic_store((unsigned long long*)lp + j, (unsigned long long)__float_as_uint(pv[2 * j]) | ((unsigned long long)__float_as_uint(pv[2 * j + 1]) << 32), __ATOMIC_RELAXED, __HIP_MEMORY_SCOPE_AGENT); }
        asm volatile("s_waitcnt vmcnt(0)" ::: "memory"); __builtin_amdgcn_s_barrier(); asm volatile("" ::: "memory");
        if (tid == 0) { const unsigned old = __hip_atomic_fetch_add(CNT2 + u.pm * 16, 1u, __ATOMIC_RELAXED, __HIP_MEMORY_SCOPE_AGENT);
            if (old == 3u) { __builtin_amdgcn_fence(__ATOMIC_ACQUIRE, "agent"); asm volatile("s_waitcnt vmcnt(0)" ::: "memory"); }
            *bc = old; }
        asm volatile("s_waitcnt lgkmcnt(0)" ::: "memory"); __builtin_amdgcn_s_barrier(); asm volatile("" ::: "memory");
        if (*bc == 3u && tid < 256) { float t7[7];
#pragma unroll
            for (int j = 0; j < 7; ++j) t7[j] = 0.f;
#pragma unroll
            for (int q = 0; q < 4; ++q) { const f32x4* lp = (const f32x4*)(LPART + ((size_t)(u.pm * 4 + q) * 256 + tid) * 8); const f32x4 p0 = lp[0], p1 = lp[1];
                t7[0] += p0[0]; t7[1] += p0[1]; t7[2] += p0[2]; t7[3] += p0[3]; t7[4] += p1[0]; t7[5] += p1[1]; t7[6] += p1[2]; }
            const float rs = __builtin_amdgcn_rsqf(t7[0] * (1.f / 1024.f) + 1e-6f); float bj_[6], lo_[6];
#pragma unroll
            for (int j = 0; j < 6; ++j) bj_[j] = bias[j];
#pragma unroll
            for (int j = 0; j < 6; ++j) lo_[j] = ::log_sigmoid_f(t7[1 + j] * rs + bj_[j]);
            f32x4* lo4 = (f32x4*)(LOGF + (size_t)(u.pm * BM + tid) * 8); lo4[0] = (f32x4){lo_[0], lo_[1], lo_[2], lo_[3]}; lo4[1] = (f32x4){lo_[4], lo_[5], 0.f, 0.f}; }
        int rl0c = rl0, col0c = col0; asm volatile("" : "+v"(rl0c), "+v"(col0c));
#pragma unroll
        for (int ai = 0; ai < 2; ++ai)
#pragma unroll
            for (int m = 0; m < 4; ++m) { bf16_t* rowp = XB + ((size_t)(col0c >> 6) * M + (u.pm * BM + rl0c + ai * HALF + m * 16)) * 64 + (col0c & 63);
#pragma unroll
                for (int bj = 0; bj < 2; ++bj) { const f32x4 v0 = acc[ai][bj][m][0], v1 = acc[ai][bj][m][1];
                    u32x4 w; w.x = cvt_pk_bf16_v(v0[0], v0[1]); w.y = cvt_pk_bf16_v(v0[2], v0[3]); w.z = cvt_pk_bf16_v(v1[0], v1[1]); w.w = cvt_pk_bf16_v(v1[2], v1[3]);
                    *(u32x4*)(rowp + bj * 32) = w; } }
    }
};
}

typedef float f32x16 __attribute__((ext_vector_type(16)));
typedef short s16x4 __attribute__((ext_vector_type(4)));
typedef unsigned u32x4 __attribute__((ext_vector_type(4)));
typedef float f32x2_t __attribute__((ext_vector_type(2))); typedef __bf16 bf16x2_t __attribute__((ext_vector_type(2)));
__device__ __forceinline__ unsigned cvt_pk_bf16(float lo, float hi) { f32x2_t v = {lo, hi}; bf16x2_t b = __builtin_convertvector(v, bf16x2_t); return __builtin_bit_cast(unsigned, b); }
__device__ __forceinline__ int crow(int r, int hi) { return (r & 3) + 8 * (r >> 2) + 4 * hi; }
__device__ __forceinline__ s16x4 vtr(const LAS unsigned char* p) { return __builtin_bit_cast(s16x4, __builtin_amdgcn_ds_read_tr16_b64_v4i16((LAS s16x4*)p)); }
constexpr float ATT_THR = 40.0f, ATT_MOVE = 8.0f;
__device__ __forceinline__ float half_swap_max(float v) { auto r = __builtin_amdgcn_permlane32_swap(__float_as_uint(v), __float_as_uint(v), false, false); return fmaxf(__uint_as_float(r[0]), __uint_as_float(r[1])); }
__device__ __forceinline__ float half_swap_sum(float v) { auto r = __builtin_amdgcn_permlane32_swap(__float_as_uint(v), __float_as_uint(v), false, false); return __uint_as_float(r[0]) + __uint_as_float(r[1]); }
__device__ __forceinline__ void attn_v3(LAS unsigned char* lds, bf16* P, const float* FCUM, int tid, unsigned* qctr, float bound2, const float* qgain, const float* kgain) {
    constexpr int A2_KA = 0, A2_KB = 9216, A2_VA = 18432, A2_VB = 26624, A2_BUF = 34816, A2_Z = 2 * A2_BUF, A2_Q = A2_Z + 1024;
    const int wid = __builtin_amdgcn_readfirstlane(tid >> 6), tid_in = tid;
    int qsel = (int)(xb_xcc_id() & 7u), qleft = 8, par = 0;
    if (tid == 0) { unsigned v = 192u;
        while (qleft > 0) { v = __hip_atomic_fetch_add(qctr + 16 * qsel, 1u, __ATOMIC_RELAXED, __HIP_MEMORY_SCOPE_AGENT); if (v < 192u) break; qsel = (qsel + 1) & 7; --qleft; }
        *(LAS unsigned*)(lds + A2_Q) = qleft > 0 ? (unsigned)qsel * 192u + v : 0xffffffffu; }
    for (;;) {
        asm volatile("s_waitcnt lgkmcnt(0)" ::: "memory"); __builtin_amdgcn_s_barrier(); asm volatile("" ::: "memory");
        const int u = (int)*(const LAS unsigned*)(lds + A2_Q + 4 * par);
        if (u < 0) break;
        int tid = tid_in; asm volatile("" : "+v"(tid));
        const int lane = tid & 63, r32 = lane & 31, hi = lane >> 5;
        const int sr = tid >> 3, sch = tid & 7;
        const int vb0 = ((lane >> 4) & 1) * 32 + (lane & 3) * 8 + (4 * hi + ((lane & 15) >> 2)) * 64;
        unsigned nv = 192u;
        if (tid == 0 && qleft > 0) nv = __hip_atomic_fetch_add(qctr + 16 * qsel, 1u, __ATOMIC_RELAXED, __HIP_MEMORY_SCOPE_AGENT);
        par ^= 1;
        {
            const int bh = u >> 4, qb = 15 - (u & 15), b = bh / 6, h = bh % 6;
            const size_t rowbase = (size_t)b * T; const int q0 = qb * 256, tq = q0 + wid * 32 + r32;
            bf16x8 qf[4];
            uint2 gwr[2][4];
            { const bf16* gp = (P + CB(PC_BG) + ((size_t)h * M + rowbase) * 64) + tq * 64;
#pragma unroll
              for (int db = 0; db < 2; ++db)
#pragma unroll
                  for (int jg = 0; jg < 4; ++jg) gwr[db][jg] = *(const uint2*)(gp + 32 * db + 8 * jg + 4 * hi); }
            { const bf16* qp = (P + CB(PC_BQ) + ((size_t)h * M + rowbase) * 64) + (tq * 64 + hi * 8);
              float qx[4][8]; float ss = 0.f;
#pragma unroll
              for (int ks = 0; ks < 4; ++ks) { const v4u w = *(const v4u*)(qp + 16 * ks);
                  qx[ks][0] = bf_lo(w.x); qx[ks][1] = bf_hi(w.x); qx[ks][2] = bf_lo(w.y); qx[ks][3] = bf_hi(w.y); qx[ks][4] = bf_lo(w.z); qx[ks][5] = bf_hi(w.z); qx[ks][6] = bf_lo(w.w); qx[ks][7] = bf_hi(w.w);
#pragma unroll
                  for (int e = 0; e < 8; ++e) ss += qx[ks][e] * qx[ks][e]; }
              ss = half_swap_sum(ss);
              const float rs = (0.125f * 1.4426950408889634f) / sqrtf(ss * (1.f / 64.f) + EPS);
#pragma unroll
              for (int ks = 0; ks < 4; ++ks) { const f32x4 g0 = *(const f32x4*)(qgain + 16 * ks + 8 * hi) * *(const f32x4*)(kgain + 16 * ks + 8 * hi), g1 = *(const f32x4*)(qgain + 16 * ks + 8 * hi + 4) * *(const f32x4*)(kgain + 16 * ks + 8 * hi + 4); float y[8];
#pragma unroll
                  for (int e = 0; e < 4; ++e) { y[e] = qx[ks][e] * rs * g0[e]; y[4 + e] = qx[ks][4 + e] * rs * g1[e]; }
                  u32x4 w; w.x = cvt_pk_bf16(y[0], y[1]); w.y = cvt_pk_bf16(y[2], y[3]); w.z = cvt_pk_bf16(y[4], y[5]); w.w = cvt_pk_bf16(y[6], y[7]); qf[ks] = __builtin_bit_cast(bf16x8, w); }
            }
            float m = 0.f, lsum = 0.f; f32x16 o0, o1;
#pragma unroll
            for (int r = 0; r < 16; ++r) { o0[r] = 0.f; o1[r] = 0.f; }
            const int NT = (q0 + 256) / 64, NS = NT / 2;
            const int kvo = sr * 64 + sch * 8; const bf16* kg = (P + CB(PC_BK) + ((size_t)h * M + rowbase) * 64) + kvo; const bf16* vg = (P + CB(PC_BV) + ((size_t)h * M + rowbase) * 64) + kvo;
            const float* fb = FCUM + (size_t)bh * T; const float* fg = fb + (tid & 127);
            const float lim = -ATT_THR - bound2 - fb[q0] * 1.4426950408889634f;
            v4u kA = *(const v4u*)(kg + (size_t)(NT - 1) * 64 * 64), vA = *(const v4u*)(vg + (size_t)(NT - 1) * 64 * 64), kB = *(const v4u*)(kg + (size_t)(NT - 2) * 64 * 64), vB = *(const v4u*)(vg + (size_t)(NT - 2) * 64 * 64);
            float freg = tid < 128 ? fg[(NT - 2) * 64] : 0.f;
#pragma unroll 1
            for (int it = 0; it < NS; ++it) {
                const int jA = NT - 1 - 2 * it, jB = jA - 1;
                { LAS unsigned char* buf = lds + (it & 1) * A2_BUF;
#pragma unroll
                  for (int tl = 0; tl < 2; ++tl) { const v4u kr = tl ? kB : kA;
                    float kx[8] = {bf_lo(kr.x), bf_hi(kr.x), bf_lo(kr.y), bf_hi(kr.y), bf_lo(kr.z), bf_hi(kr.z), bf_lo(kr.w), bf_hi(kr.w)}; float ss = 0.f;
#pragma unroll
                    for (int e = 0; e < 8; ++e) ss += kx[e] * kx[e];
                    ss += dppf<0xB1>(ss); ss += dppf<0x4E>(ss); ss += dppf<0x141>(ss);
                    const float rs = __builtin_amdgcn_rsqf(ss * (1.f / 64.f) + EPS);
#pragma unroll
                    for (int e = 0; e < 8; ++e) kx[e] = kx[e] * rs;
                    u32x4 w; w.x = cvt_pk_bf16(kx[0], kx[1]); w.y = cvt_pk_bf16(kx[2], kx[3]); w.z = cvt_pk_bf16(kx[4], kx[5]); w.w = cvt_pk_bf16(kx[6], kx[7]);
                    *(LAS u32x4*)(buf + (tl ? A2_KB : A2_KA) + sch * 1024 + sr * 16) = w; }
                  *(LAS v4u*)(buf + A2_VA + (sch >> 2) * 4096 + sr * 64 + (sch & 3) * 16) = vA;
                  *(LAS v4u*)(buf + A2_VB + (sch >> 2) * 4096 + sr * 64 + (sch & 3) * 16) = vB;
                  if (tid < 128) *(LAS float*)(buf + (tid < 64 ? A2_KB : A2_KA) + 8 * 1024 + (tid & 63) * 4) = -freg * 1.4426950408889634f; }
                const int ja2 = jA - 2 > 0 ? jA - 2 : 0, jb2 = jB - 2 > 0 ? jB - 2 : 0, jb1 = jB - 1 > 0 ? jB - 1 : 0;
                kA = *(const v4u*)(kg + (size_t)ja2 * 64 * 64); vA = *(const v4u*)(vg + (size_t)ja2 * 64 * 64); kB = *(const v4u*)(kg + (size_t)jb2 * 64 * 64); vB = *(const v4u*)(vg + (size_t)jb2 * 64 * 64);
                if (tid < 128) freg = fg[jb2 * 64];
                const float fchk = fb[jb1 * 64 + 63];
                asm volatile("s_waitcnt lgkmcnt(0)" ::: "memory"); __builtin_amdgcn_s_barrier(); asm volatile("" ::: "memory");
                if (jB * 64 <= q0 + wid * 32 + 31) {
                    const LAS unsigned char* buf = lds + (it & 1) * A2_BUF;
                    f32x16 s[4];
                    bf16x8 ka[3][2];
#define A2_KLOAD(g_, d_) do { const LAS unsigned char* kp_ = buf + (((g_) & 1) ? A2_KA : A2_KB) + (2 * ((g_) >> 1) + hi) * 1024 + r32 * 16; d_[0] = *(const LAS bf16x8*)kp_; d_[1] = *(const LAS bf16x8*)(kp_ + 512); } while (0)
                    A2_KLOAD(0, ka[0]); A2_KLOAD(1, ka[1]);
#pragma unroll
                    for (int c = 0; c < 4; ++c) { const LAS unsigned char* bp = buf + (c < 2 ? A2_KB : A2_KA) + 8 * 1024 + (32 * (c & 1) + 4 * hi) * 4;
#pragma unroll
                        for (int g = 0; g < 4; ++g) { const f32x4 b4 = *(const LAS f32x4*)(bp + 32 * g);
#pragma unroll
                            for (int e = 0; e < 4; ++e) s[c][4 * g + e] = b4[e]; } }
                    __builtin_amdgcn_sched_barrier(0);
#pragma unroll
                    for (int c = 0; c < 4; ++c)
#pragma unroll
                        for (int r = 0; r < 16; ++r) s[c][r] -= m;
                    __builtin_amdgcn_sched_barrier(0);
#pragma unroll
                    for (int g = 0; g < 8; ++g) { const int ks = g >> 1, tl = g & 1;
                        if (g + 2 < 8) A2_KLOAD(g + 2, ka[(g + 2) % 3]);
                        __builtin_amdgcn_sched_barrier(0);
                        s[2 * tl] = __builtin_amdgcn_mfma_f32_32x32x16_bf16(ka[g % 3][0], qf[ks], s[2 * tl], 0, 0, 0);
                        s[2 * tl + 1] = __builtin_amdgcn_mfma_f32_32x32x16_bf16(ka[g % 3][1], qf[ks], s[2 * tl + 1], 0, 0, 0);
                        __builtin_amdgcn_sched_barrier(0); }
#undef A2_KLOAD
                    if (it < 2) {
#pragma unroll
                        for (int c = 0; c < 4; ++c)
#pragma unroll
                            for (int r = 0; r < 16; ++r) { const int kv = (c < 2 ? jB : jA) * 64 + 32 * (c & 1) + crow(r, hi); if (kv > tq) s[c][r] = -1e30f; } }
                    float mxa = fmaxf(s[0][0], s[1][0]), mxb = fmaxf(s[2][0], s[3][0]);
#pragma unroll
                    for (int r = 1; r < 16; ++r) { mxa = fmaxf(fmaxf(mxa, s[0][r]), s[1][r]); mxb = fmaxf(fmaxf(mxb, s[2][r]), s[3][r]); }
                    const float mx = half_swap_max(fmaxf(mxa, mxb));
                    float ps = 0.f;
                    if (it == 0 || __builtin_amdgcn_ballot_w64(mx > ATT_MOVE) != 0ull) {
                        const float d = (it == 0) ? mx : fmaxf(mx, 0.f), alpha = __builtin_amdgcn_exp2f(-d); m += d;
#pragma unroll
                        for (int c = 0; c < 4; ++c)
#pragma unroll
                            for (int r = 0; r < 16; ++r) { s[c][r] = __builtin_amdgcn_exp2f(s[c][r] - d); ps += s[c][r]; }
                        lsum = lsum * alpha + ps;
#pragma unroll
                        for (int r = 0; r < 16; ++r) { o0[r] *= alpha; o1[r] *= alpha; }
                    } else {
#pragma unroll
                        for (int c = 0; c < 4; ++c)
#pragma unroll
                            for (int r = 0; r < 16; ++r) { s[c][r] = __builtin_amdgcn_exp2f(s[c][r]); ps += s[c][r]; }
                        lsum += ps;
                    }
                    bf16x8 vfa[3], vfb[3];
#define A2_VLOAD(g_, i_) do { const LAS unsigned char* vp_ = buf + (((g_) >> 1) < 2 ? A2_VB : A2_VA) + vb0 + (((g_) >> 1) & 1) * 2048 + ((g_) & 1) * 1024; \
                        const s16x4 al_ = vtr(vp_), ah_ = vtr(vp_ + 512), bl_ = vtr(vp_ + 4096), bh_ = vtr(vp_ + 4096 + 512); \
                        vfa[i_] = (bf16x8){al_[0], al_[1], al_[2], al_[3], ah_[0], ah_[1], ah_[2], ah_[3]}; vfb[i_] = (bf16x8){bl_[0], bl_[1], bl_[2], bl_[3], bh_[0], bh_[1], bh_[2], bh_[3]}; } while (0)
                    A2_VLOAD(0, 0); A2_VLOAD(1, 1);
                    __builtin_amdgcn_sched_barrier(0);
#pragma unroll
                    for (int g = 0; g < 8; ++g) { const int c = g >> 1, h2 = g & 1;
                        if (g + 2 < 8) A2_VLOAD(g + 2, (g + 2) % 3);
                        u32x4 w; w.x = cvt_pk_bf16(s[c][8 * h2 + 0], s[c][8 * h2 + 1]); w.y = cvt_pk_bf16(s[c][8 * h2 + 2], s[c][8 * h2 + 3]); w.z = cvt_pk_bf16(s[c][8 * h2 + 4], s[c][8 * h2 + 5]); w.w = cvt_pk_bf16(s[c][8 * h2 + 6], s[c][8 * h2 + 7]);
                        const bf16x8 pa = __builtin_bit_cast(bf16x8, w);
                        __builtin_amdgcn_sched_barrier(0);
                        o0 = __builtin_amdgcn_mfma_f32_32x32x16_bf16(vfa[g % 3], pa, o0, 0, 0, 0);
                        o1 = __builtin_amdgcn_mfma_f32_32x32x16_bf16(vfb[g % 3], pa, o1, 0, 0, 0);
                        __builtin_amdgcn_sched_barrier(0); }
#undef A2_VLOAD
                }
                if (jB > 0 && jB - 1 < NT - 4 && -fchk * 1.4426950408889634f < lim) break;
            }
            lsum = half_swap_sum(lsum);
            const float inv = 1.0f / lsum;
            bf16* op = (P + CB(PC_BQ) + ((size_t)h * M + rowbase) * 64) + tq * 64;
#pragma unroll
            for (int db = 0; db < 2; ++db)
#pragma unroll
                for (int jg = 0; jg < 4; ++jg) { const int d = 32 * db + 8 * jg + 4 * hi; const uint2 gw2 = gwr[db][jg];
                    const float g[4] = {bf_lo(gw2.x), bf_hi(gw2.x), bf_lo(gw2.y), bf_hi(gw2.y)}; float ov[4];
#pragma unroll
                    for (int e = 0; e < 4; ++e) ov[e] = (db ? o1[4 * jg + e] : o0[4 * jg + e]) * inv * __builtin_amdgcn_rcpf(1.0f + __builtin_amdgcn_exp2f(-g[e] * 1.4426950408889634f));
                    uint2 ow; ow.x = pk2(ov[0], ov[1]); ow.y = pk2(ov[2], ov[3]); *(uint2*)(op + d) = ow; }
        }
        if (tid == 0) { unsigned v = nv;
            while (v >= 192u && qleft > 0) { qsel = (qsel + 1) & 7; if (--qleft <= 0) break; v = __hip_atomic_fetch_add(qctr + 16 * qsel, 1u, __ATOMIC_RELAXED, __HIP_MEMORY_SCOPE_AGENT); }
            *(LAS unsigned*)(lds + A2_Q + 4 * par) = (qleft > 0 && v < 192u) ? (unsigned)qsel * 192u + v : 0xffffffffu; }
    }
}

constexpr size_t WS_U = WS_H;
constexpr size_t WS_ST = WS_H + 160 * MiB;
constexpr size_t WS_DK = WS_H + 240 * MiB;
constexpr int N_HG_UNITS = 96 * 64, N_RT_UNITS = 64 * 64;
__device__ __forceinline__ void stage_tile(LAS unsigned char* dst, const bf16* src, int lane) {
#pragma unroll
    for (int i = 0; i < 8; ++i) { const int r = i * 8 + (lane >> 3), ch = lane & 7; const v4u w = *(const v4u*)(src + (size_t)r * 64 + ch * 8);
        *(LAS v4u*)(dst + (ch >> 2) * 4096 + r * 64 + (ch & 3) * 16) = w; }
}
__device__ __forceinline__ bf16x8 ltri_op(int tb, int ts, int t_l, int hi) {
    const int t = 32 * tb + t_l; bf16x8 o;
#pragma unroll
    for (int j = 0; j < 8; ++j) { const int tp = 16 * ts + 8 * (j >> 2) + 4 * hi + (j & 3); o[j] = (tp <= t) ? (short)0x3f80 : (short)0; }
    return o;
}
__device__ __forceinline__ bf16x8 pack8(const float* x) { u32x4 w; w.x = cvt_pk_bf16(x[0], x[1]); w.y = cvt_pk_bf16(x[2], x[3]); w.z = cvt_pk_bf16(x[4], x[5]); w.w = cvt_pk_bf16(x[6], x[7]); return __builtin_bit_cast(bf16x8, w); }
__device__ __forceinline__ bf16x8 vfrag(const LAS unsigned char* p) { const s16x4 lo = vtr(p), hi4 = vtr(p + 512); return (bf16x8){lo[0], lo[1], lo[2], lo[3], hi4[0], hi4[1], hi4[2], hi4[3]}; }
__device__ __forceinline__ float s16f(short s) { return __uint_as_float(((unsigned)(unsigned short)s) << 16); }
#define MFMA32(a, b, c) __builtin_amdgcn_mfma_f32_32x32x16_bf16((a), (b), (c), 0, 0, 0)
__device__ __forceinline__ void hgrn_gate(float z, float lb, float& lf2, float& kk) {
    z = fminf(fmaxf(z, -30.f), 30.f);
    const float e = __builtin_amdgcn_exp2f(-z * 1.4426950408889634f), sig = __builtin_amdgcn_rcpf(1.0f + e);
    const float f = lb + (1.0f - lb) * sig; lf2 = __builtin_amdgcn_logf(fmaxf(f, 1e-12f)); kk = (1.0f - lb) * (e * sig);
}

struct TilePF { v4u a[8], b[8]; };
__device__ __forceinline__ void tile_fetch(TilePF& r, const bf16* sa, const bf16* sb, int lane) {
#pragma unroll
    for (int i = 0; i < 8; ++i) { const int rr = i * 8 + (lane >> 3), ch = lane & 7; r.a[i] = *(const v4u*)(sa + (size_t)rr * 64 + ch * 8); r.b[i] = *(const v4u*)(sb + (size_t)rr * 64 + ch * 8); }
}
__device__ __forceinline__ void tile_put(LAS unsigned char* da, LAS unsigned char* db, const TilePF& r, int lane) {
#pragma unroll
    for (int i = 0; i < 8; ++i) { const int rr = i * 8 + (lane >> 3), ch = lane & 7; const int o = (ch >> 2) * 4096 + rr * 64 + (ch & 3) * 16; *(LAS v4u*)(da + o) = r.a[i]; *(LAS v4u*)(db + o) = r.b[i]; }
}
__device__ __forceinline__ void tile_fetch_b(TilePF& r, const bf16* sb, int lane) {
#pragma unroll
    for (int i = 0; i < 8; ++i) { const int rr = i * 8 + (lane >> 3), ch = lane & 7; r.b[i] = *(const v4u*)(sb + (size_t)rr * 64 + ch * 8); }
}
__device__ __forceinline__ void tile_put_b(LAS unsigned char* db, const TilePF& r, int lane) {
#pragma unroll
    for (int i = 0; i < 8; ++i) { const int rr = i * 8 + (lane >> 3), ch = lane & 7; *(LAS v4u*)(db + (ch >> 2) * 4096 + rr * 64 + (ch & 3) * 16) = r.b[i]; }
}
__device__ __forceinline__ const bf16* hgrn_tile(const bf16* P, int unit) { const int chain = unit >> 6, n = unit & 63, b = chain / 6, h = chain % 6; return P + ((size_t)h * M + (size_t)b * T + n * 64) * 64; }
template <bool WT  >
__device__ __forceinline__ void rec_pass1_hgrn(LAS unsigned char* wl, const bf16* P, const float* LBl, bf16* U, float* DK, int unit, int lane, TilePF& pf, bool has_next) {
    const int c_l = lane & 31, hi = lane >> 5, chain = unit >> 6, h = chain % 6;
    const bf16* tile = hgrn_tile(P, unit);
    const float lb0_ = LBl[h * 64 + c_l], lb1_ = LBl[h * 64 + 32 + c_l];
    tile_put(wl, wl + 8192, pf, lane);
    { const size_t nx = has_next ? (size_t)NWAVES * 4096 : 0; tile_fetch(pf, tile + CB(PC_AF) + nx, tile + CB(PC_AI) + nx, lane); }
    asm volatile("s_waitcnt lgkmcnt(0)" ::: "memory");
    const int vb0 = ((lane >> 4) & 1) * 32 + (lane & 3) * 8 + (4 * hi + ((lane & 15) >> 2)) * 64;
    bf16* Uo = U + (size_t)unit * 4096;
#pragma unroll 1
    for (int fb = 0; fb < 2; ++fb) {
        const float lb = fb ? lb1_ : lb0_;
        float kk[4][8]; bf16x8 lfh[4], lfl[4]; s16x4 zr[4][2];
#pragma unroll
        for (int ts = 0; ts < 4; ++ts)
#pragma unroll
            for (int jj = 0; jj < 2; ++jj) zr[ts][jj] = vtr(wl + fb * 4096 + (16 * ts + 8 * jj) * 64 + vb0);
        __builtin_amdgcn_sched_barrier(0);
#pragma unroll
        for (int ts = 0; ts < 4; ++ts) { float lf[8], lo[8];
#pragma unroll
            for (int jj = 0; jj < 2; ++jj) { const s16x4 z4 = zr[ts][jj];
#pragma unroll
                for (int e = 0; e < 4; ++e) hgrn_gate(s16f(z4[e]), lb, lf[4 * jj + e], kk[ts][4 * jj + e]); }
            lfh[ts] = pack8(lf);
#pragma unroll
            for (int j = 0; j < 8; ++j) lo[j] = lf[j] - s16f(lfh[ts][j]);
            lfl[ts] = pack8(lo); }
        f32x16 cum[2];
#pragma unroll
        for (int tb = 0; tb < 2; ++tb) {
#pragma unroll
            for (int r = 0; r < 16; ++r) cum[tb][r] = 0.f;
#pragma unroll
            for (int ts = 0; ts < 2 * tb + 2; ++ts) { const bf16x8 L = ltri_op(tb, ts, c_l, hi); cum[tb] = MFMA32(L, lfh[ts], cum[tb]); cum[tb] = MFMA32(L, lfl[ts], cum[tb]); } }
        const float c63 = shfl_i(cum[1][15], 32 + c_l);
        if (hi == 0) { float* dkp = DK + (size_t)unit * 64 + 32 * fb + c_l; const float dkv = __builtin_amdgcn_exp2f(c63); if (WT) __hip_atomic_store(dkp, dkv, __ATOMIC_RELAXED, __HIP_MEMORY_SCOPE_AGENT); else *dkp = dkv; }
        bf16x8 kh[4];
#pragma unroll
        for (int ts = 0; ts < 4; ++ts) { float x[8];
#pragma unroll
            for (int j = 0; j < 8; ++j) x[j] = kk[ts][j] * __builtin_amdgcn_exp2f(c63 - cum[ts >> 1][8 * (ts & 1) + j]);
            kh[ts] = pack8(x); }
#pragma unroll
        for (int vb = 0; vb < 2; ++vb) { f32x16 acc;
#pragma unroll
            for (int r = 0; r < 16; ++r) acc[r] = 0.f;
#pragma unroll
            for (int ts = 0; ts < 4; ++ts) acc = MFMA32(vfrag(wl + 8192 + vb * 4096 + ts * 1024 + vb0), kh[ts], acc);
#pragma unroll
            for (int r = 0; r < 16; ++r) { bf16* up_ = Uo + (32 * vb + crow(r, hi)) * 64 + 32 * fb + c_l; const bf16 uv_ = (bf16)f2bf(acc[r]); if (WT) __hip_atomic_store(up_, uv_, __ATOMIC_RELAXED, __HIP_MEMORY_SCOPE_AGENT); else *up_ = uv_; } }
    }
}
__device__ __forceinline__ const bf16* ret_tile(const bf16* P, int unit) { const int chain = unit >> 6, n = unit & 63, b = chain / 4, h = chain % 4; return P + ((size_t)h * M + (size_t)b * T + n * 64) * 64; }
__device__ __forceinline__ void rec_pass1_ret(LAS unsigned char* wl, const bf16* P, bf16* U, int unit, int lane, TilePF& pf, bool has_next) {
    const int c_l = lane & 31, hi = lane >> 5, chain = unit >> 6, h = chain % 4;
    const bf16* tile = ret_tile(P, unit);
    tile_put(wl, wl + 8192, pf, lane);
    { const size_t nx = has_next ? (size_t)NWAVES * 4096 : 0; tile_fetch(pf, tile + CB(PC_CK) + nx, tile + CB(PC_CV) + nx, lane); }
    asm volatile("s_waitcnt lgkmcnt(0)" ::: "memory");
    const int vb0 = ((lane >> 4) & 1) * 32 + (lane & 3) * 8 + (4 * hi + ((lane & 15) >> 2)) * 64;
    const float lg2 = __builtin_amdgcn_logf(1.0f - __builtin_amdgcn_exp2f(-5.0f - (float)h));
    bf16* Uo = U + (size_t)(N_HG_UNITS + unit) * 4096;
    bf16x8 kh[2][4];
#pragma unroll
    for (int ts = 0; ts < 4; ++ts) { float x0[8], x1[8];
#pragma unroll
        for (int jj = 0; jj < 2; ++jj) { const s16x4 a4 = vtr(wl + (16 * ts + 8 * jj) * 64 + vb0), b4 = vtr(wl + 4096 + (16 * ts + 8 * jj) * 64 + vb0);
#pragma unroll
            for (int e = 0; e < 4; ++e) { const int t = 16 * ts + 8 * jj + 4 * hi + e; const float w = __builtin_amdgcn_exp2f(lg2 * (float)(63 - t));
                x0[4 * jj + e] = s16f(a4[e]) * w; x1[4 * jj + e] = s16f(b4[e]) * w; } }
        kh[0][ts] = pack8(x0); kh[1][ts] = pack8(x1); }
#pragma unroll
    for (int vb = 0; vb < 2; ++vb) { bf16x8 vf[4];
#pragma unroll
        for (int ts = 0; ts < 4; ++ts) vf[ts] = vfrag(wl + 8192 + vb * 4096 + ts * 1024 + vb0);
#pragma unroll
        for (int fb = 0; fb < 2; ++fb) { f32x16 acc;
#pragma unroll
            for (int r = 0; r < 16; ++r) acc[r] = 0.f;
#pragma unroll
            for (int ts = 0; ts < 4; ++ts) acc = MFMA32(vf[ts], kh[fb][ts], acc);
#pragma unroll
            for (int r = 0; r < 16; ++r) Uo[(32 * vb + crow(r, hi)) * 64 + 32 * fb + c_l] = (bf16)f2bf(acc[r]); } }
}
__device__ __forceinline__ void rec_pass2_chain(const bf16* U, const float* DK, bf16* ST, int chain, int tid) {
    constexpr int NE = 8;
    const int k = tid & 63, kp = (k & ~12) | ((k & 8) >> 1) | ((k & 4) << 1); const bool hg = chain < 96;
    const bf16* up = U + (size_t)chain * 64 * 4096 + tid; bf16* sp = ST + (size_t)chain * 64 * 4096 + (tid & ~63) + kp;
    const float* dp = DK + (size_t)(hg ? chain : 0) * 64 * 64 + k; int h = (chain - 96) & 3; asm volatile("" : "+s"(h));
    const float g64 = __builtin_amdgcn_exp2f(64.0f * __builtin_amdgcn_logf(1.0f - __builtin_amdgcn_exp2f(-5.0f - (float)h)));
    float S[NE];
#pragma unroll
    for (int i = 0; i < NE; ++i) S[i] = 0.f;
    bf16 un[8][NE]; float dn[8];
#pragma unroll
    for (int j = 0; j < 8; ++j) { dn[j] = hg ? dp[j * 64] : g64;
#pragma unroll
        for (int i = 0; i < NE; ++i) un[j][i] = up[(size_t)j * 4096 + 512 * i]; }
#pragma unroll 1
    for (int nb = 0; nb < 64; nb += 8) { bf16 uc[8][NE]; float dc[8];
#pragma unroll
        for (int j = 0; j < 8; ++j) { dc[j] = dn[j];
#pragma unroll
            for (int i = 0; i < NE; ++i) uc[j][i] = un[j][i]; }
        if (nb + 8 < 64) {
#pragma unroll
            for (int j = 0; j < 8; ++j) { dn[j] = hg ? dp[(nb + 8 + j) * 64] : g64;
#pragma unroll
                for (int i = 0; i < NE; ++i) un[j][i] = up[(size_t)(nb + 8 + j) * 4096 + 512 * i]; } }
        asm volatile("" ::: "memory");
#pragma unroll
        for (int j = 0; j < 8; ++j)
#pragma unroll
            for (int i = 0; i < NE; ++i) { sp[(size_t)(nb + j) * 4096 + 512 * i] = (bf16)f2bf(S[i]); S[i] = dc[j] * S[i] + bf1(uc[j][i]); } }
}
__device__ __forceinline__ void rec_pass3_tail(const LAS unsigned char* vt, const bf16x8 (&qt)[2][2][2], const bf16x8 (&kt)[2][2][2], const bf16x8 (&qh)[2][2][2], const bf16* STu,
                                               const float* gain, const bf16* grow  , bf16* orow, int lane, TilePF* pf = nullptr, const bf16* nxa = nullptr, const bf16* nxb = nullptr) {
    asm volatile("" : "+v"(lane));
    const int t_l = lane & 31, hi = lane >> 5;
    const int vb0 = ((lane >> 4) & 1) * 32 + (lane & 3) * 8 + (4 * hi + ((lane & 15) >> 2)) * 64;
    bf16x8 sfr[2][2][2];
#pragma unroll
    for (int vb = 0; vb < 2; ++vb)
#pragma unroll
        for (int fb = 0; fb < 2; ++fb)
#pragma unroll
            for (int ks = 0; ks < 2; ++ks) sfr[vb][fb][ks] = *(const bf16x8*)(STu + (32 * vb + t_l) * 64 + 32 * fb + 16 * ks + 8 * hi);
    __builtin_amdgcn_sched_barrier(0);
    bf16x8 pt[3][2];
#pragma unroll
    for (int blk = 0; blk < 3; ++blk) { const int sb = blk == 2 ? 1 : 0, tb = blk == 0 ? 0 : 1; f32x16 sc;
#pragma unroll
        for (int r = 0; r < 16; ++r) sc[r] = 0.f;
#pragma unroll
        for (int fb = 0; fb < 2; ++fb)
#pragma unroll
            for (int ks = 0; ks < 2; ++ks) sc = MFMA32(kt[sb][fb][ks], qt[tb][fb][ks], sc);
        if (sb == tb) {
#pragma unroll
            for (int r = 0; r < 16; ++r) if (crow(r, hi) > t_l) sc[r] = 0.f; }
#pragma unroll
        for (int s16 = 0; s16 < 2; ++s16) { float x[8];
#pragma unroll
            for (int j = 0; j < 8; ++j) x[j] = sc[8 * s16 + j];
            pt[blk][s16] = pack8(x); } }
    uint2 gwr[2][2][4];
#pragma unroll
    for (int tb = 0; tb < 2; ++tb)
#pragma unroll
        for (int vb = 0; vb < 2; ++vb)
#pragma unroll
            for (int g4 = 0; g4 < 4; ++g4) gwr[tb][vb][g4] = *(const uint2*)(grow + (size_t)tb * 32 * 64 + 32 * vb + 8 * g4 + 4 * hi);
    __builtin_amdgcn_sched_barrier(0);
    f32x16 o[2][2];
#pragma unroll
    for (int vb = 0; vb < 2; ++vb) {
#pragma unroll
        for (int tb = 0; tb < 2; ++tb)
#pragma unroll
            for (int r = 0; r < 16; ++r) o[vb][tb][r] = 0.f;
#pragma unroll
        for (int sb = 0; sb < 2; ++sb)
#pragma unroll
            for (int s16 = 0; s16 < 2; ++s16) { const bf16x8 vf = vfrag(vt + vb * 4096 + (32 * sb + 16 * s16) * 64 + vb0);
                if (sb == 0) { o[vb][0] = MFMA32(vf, pt[0][s16], o[vb][0]); o[vb][1] = MFMA32(vf, pt[1][s16], o[vb][1]); }
                else o[vb][1] = MFMA32(vf, pt[2][s16], o[vb][1]); }
#pragma unroll
        for (int fb = 0; fb < 2; ++fb)
#pragma unroll
            for (int ks = 0; ks < 2; ++ks) { const bf16x8 sf = sfr[vb][fb][ks];
                o[vb][0] = MFMA32(sf, qh[0][fb][ks], o[vb][0]); o[vb][1] = MFMA32(sf, qh[1][fb][ks], o[vb][1]); }
    }
    f32x4 gnr[2][4];
#pragma unroll
    for (int vb = 0; vb < 2; ++vb)
#pragma unroll
        for (int g4 = 0; g4 < 4; ++g4) gnr[vb][g4] = *(const f32x4*)(gain + 32 * vb + 8 * g4 + 4 * hi);
    if (pf) { if (nxa) tile_fetch(*pf, nxa, nxb, lane); else tile_fetch_b(*pf, nxb, lane); }
    __builtin_amdgcn_sched_barrier(0);
#pragma unroll
    for (int tb = 0; tb < 2; ++tb) { float ss = 0.f;
#pragma unroll
        for (int vb = 0; vb < 2; ++vb)
#pragma unroll
            for (int r = 0; r < 16; ++r) ss += o[vb][tb][r] * o[vb][tb][r];
        ss += shfl_i(ss, lane ^ 32);
        const float rs = 1.0f / sqrtf(ss * (1.f / 64.f) + EPS);
#pragma unroll
        for (int vb = 0; vb < 2; ++vb)
#pragma unroll
            for (int g4 = 0; g4 < 4; ++g4) { const int c = 32 * vb + 8 * g4 + 4 * hi; const uint2 gw2 = gwr[tb][vb][g4]; const f32x4 gn = gnr[vb][g4];
                const float g[4] = {bf_lo(gw2.x), bf_hi(gw2.x), bf_lo(gw2.y), bf_hi(gw2.y)}; float y[4];
#pragma unroll
                for (int e = 0; e < 4; ++e) y[e] = o[vb][tb][4 * g4 + e] * rs * gn[e] * (g[e] * __builtin_amdgcn_rcpf(1.0f + __builtin_amdgcn_exp2f(-g[e] * 1.4426950408889634f)));
                uint2 ow; ow.x = pk2(y[0], y[1]); ow.y = pk2(y[2], y[3]); *(uint2*)(orow + (size_t)tb * 32 * 64 + c) = ow; } }
}
__device__ __forceinline__ void rec_pass3_hgrn(LAS unsigned char* wl, bf16* P, const float* LBl, const float* gainl, const bf16* ST, int unit, int lane, TilePF& pf, bool has_next) {
    const int t_l = lane & 31, hi = lane >> 5, chain = unit >> 6, n = unit & 63, b = chain / 6, h = chain % 6;
    bf16* tile = P + ((size_t)h * M + (size_t)b * T + n * 64) * 64;
    const float lbv_[2] = {LBl[h * 64 + t_l], LBl[h * 64 + 32 + t_l]};
    tile_put(wl, wl + 8192, pf, lane);
    asm volatile("s_waitcnt lgkmcnt(0)" ::: "memory");
    const int vb0 = ((lane >> 4) & 1) * 32 + (lane & 3) * 8 + (4 * hi + ((lane & 15) >> 2)) * 64;
    uint2 qwa[2][2][4];
#pragma unroll
    for (int fb = 0; fb < 2; ++fb)
#pragma unroll
        for (int tb = 0; tb < 2; ++tb)
#pragma unroll
            for (int g = 0; g < 4; ++g) qwa[fb][tb][g] = *(const uint2*)(tile + CB(PC_AQ) + (size_t)(32 * tb + t_l) * 64 + 32 * fb + 4 * hi + 8 * g);
    __builtin_amdgcn_sched_barrier(0);
    bf16x8 qt[2][2][2], kt[2][2][2], qh[2][2][2];
#pragma unroll
    for (int fb = 0; fb < 2; ++fb) {
        const float lb_l1 = lbv_[fb];
        f32x16 cumT[2];
        { const float lb = lb_l1;
          bf16x8 lfh[4], lfl[4]; s16x4 zr[4][2];
#pragma unroll
          for (int ts = 0; ts < 4; ++ts)
#pragma unroll
              for (int jj = 0; jj < 2; ++jj) zr[ts][jj] = vtr(wl + fb * 4096 + (16 * ts + 8 * jj) * 64 + vb0);
          __builtin_amdgcn_sched_barrier(0);
#pragma unroll
          for (int ts = 0; ts < 4; ++ts) { float lf[8], lo[8];
#pragma unroll
              for (int jj = 0; jj < 2; ++jj) { const s16x4 z4 = zr[ts][jj];
#pragma unroll
                  for (int e = 0; e < 4; ++e) { float kkd; hgrn_gate(s16f(z4[e]), lb, lf[4 * jj + e], kkd);
                      *(LAS unsigned short*)(wl + fb * 4096 + (16 * ts + 8 * jj + 4 * hi + e) * 64 + t_l * 2) = (unsigned short)f2bf(kkd); } }
              lfh[ts] = pack8(lf);
#pragma unroll
              for (int j = 0; j < 8; ++j) lo[j] = lf[j] - s16f(lfh[ts][j]);
              lfl[ts] = pack8(lo); }
#pragma unroll
          for (int tb = 0; tb < 2; ++tb) {
#pragma unroll
              for (int r = 0; r < 16; ++r) cumT[tb][r] = 0.f;
#pragma unroll
              for (int ts = 0; ts < 2 * tb + 2; ++ts) { const bf16x8 L = ltri_op(tb, ts, t_l, hi); cumT[tb] = MFMA32(lfh[ts], L, cumT[tb]); cumT[tb] = MFMA32(lfl[ts], L, cumT[tb]); } } }
        float cmv[16];
#pragma unroll
        for (int r = 0; r < 16; ++r) { const int ci = (int)__float_as_uint(cumT[0][r]); const float s31 = __uint_as_float((unsigned)__builtin_amdgcn_readlane(ci, 31)), s63 = __uint_as_float((unsigned)__builtin_amdgcn_readlane(ci, 63)); cmv[r] = hi ? s63 : s31; }
#pragma unroll
        for (int tb = 0; tb < 2; ++tb) {
#pragma unroll
            for (int ks = 0; ks < 2; ++ks) { float xq[8], xk[8], xh[8];
#pragma unroll
                for (int gg = 0; gg < 2; ++gg) { const int g = 2 * ks + gg;
                    const uint2 qw = qwa[fb][tb][g]; const v2u kw = *(const LAS v2u*)(wl + fb * 4096 + (32 * tb + t_l) * 64 + (8 * g + 4 * hi) * 2);
                    const float qv[4] = {bf_lo(qw.x), bf_hi(qw.x), bf_lo(qw.y), bf_hi(qw.y)}, kv[4] = {bf_lo(kw.x), bf_hi(kw.x), bf_lo(kw.y), bf_hi(kw.y)};
#pragma unroll
                    for (int e = 0; e < 4; ++e) { const int r = 4 * g + e, x = 4 * gg + e; const float kk = kv[e];
                        const float cm = cmv[r], c = cumT[tb][r];
                        xq[x] = qv[e] * __builtin_amdgcn_exp2f(c - cm); xk[x] = kk * __builtin_amdgcn_exp2f(cm - c); xh[x] = qv[e] * __builtin_amdgcn_exp2f(c); } }
                qt[tb][fb][ks] = pack8(xq); kt[tb][fb][ks] = pack8(xk); qh[tb][fb][ks] = pack8(xh);
                asm volatile("" : "+v"(qt[tb][fb][ks]), "+v"(kt[tb][fb][ks]), "+v"(qh[tb][fb][ks])); }
        }
    }
    rec_pass3_tail(wl + 8192, qt, kt, qh, ST + (size_t)unit * 4096, gainl + h * 64, tile + CB(PC_AG) + (size_t)t_l * 64, tile + CB(PC_AQ) + (size_t)t_l * 64, lane, &pf, tile + CB(PC_AF) + (has_next ? (size_t)NWAVES * 4096 : 0), tile + CB(PC_AI) + (has_next ? (size_t)NWAVES * 4096 : 0));
}
__device__ __forceinline__ void rec_pass3_ret(LAS unsigned char* wl, bf16* P, const float* gainl, const bf16* ST, int unit, int lane, TilePF& pf, bool has_next) {
    const int t_l = lane & 31, hi = lane >> 5, chain = unit >> 6, n = unit & 63, b = chain / 4, h = chain % 4;
    bf16* tile = P + ((size_t)h * M + (size_t)b * T + n * 64) * 64;
    tile_put_b(wl + 8192, pf, lane);
    asm volatile("s_waitcnt lgkmcnt(0)" ::: "memory");
    const float lg2 = __builtin_amdgcn_logf(1.0f - __builtin_amdgcn_exp2f(-5.0f - (float)h));
    bf16x8 qt[2][2][2], kt[2][2][2], qh[2][2][2];
#pragma unroll
    for (int tb = 0; tb < 2; ++tb) {
        const int t = 32 * tb + t_l; const bf16* rowp = tile + (size_t)t * 64 + 4 * hi;
        uint2 qwr[2][4], kwr[2][4];
#pragma unroll
        for (int fb = 0; fb < 2; ++fb)
#pragma unroll
            for (int g = 0; g < 4; ++g) { qwr[fb][g] = *(const uint2*)(rowp + CB(PC_CQ) + 32 * fb + 8 * g); kwr[fb][g] = *(const uint2*)(rowp + CB(PC_CK) + 32 * fb + 8 * g); }
        __builtin_amdgcn_sched_barrier(0);
        const float wq = __builtin_amdgcn_exp2f(lg2 * (float)(t - 31)), wk = __builtin_amdgcn_exp2f(lg2 * (float)(31 - t)), wh = __builtin_amdgcn_exp2f(lg2 * (float)(t + 1));
#pragma unroll
        for (int fb = 0; fb < 2; ++fb)
#pragma unroll
            for (int ks = 0; ks < 2; ++ks) { float xq[8], xk[8], xh[8];
#pragma unroll
                for (int gg = 0; gg < 2; ++gg) { const int g = 2 * ks + gg;
                    const uint2 qw = qwr[fb][g], kw = kwr[fb][g];
                    const float qv[4] = {bf_lo(qw.x), bf_hi(qw.x), bf_lo(qw.y), bf_hi(qw.y)}, kv[4] = {bf_lo(kw.x), bf_hi(kw.x), bf_lo(kw.y), bf_hi(kw.y)};
#pragma unroll
                    for (int e = 0; e < 4; ++e) { const int x = 4 * gg + e; xq[x] = qv[e] * wq; xk[x] = kv[e] * wk; xh[x] = qv[e] * wh; } }
                qt[tb][fb][ks] = pack8(xq); kt[tb][fb][ks] = pack8(xk); qh[tb][fb][ks] = pack8(xh); }
    }
    rec_pass3_tail(wl + 8192, qt, kt, qh, ST + (size_t)(N_HG_UNITS + unit) * 4096, gainl + h * 64, tile + CB(PC_CG) + (size_t)t_l * 64, tile + CB(PC_CQ) + (size_t)t_l * 64, lane, &pf, nullptr, tile + CB(PC_CV) + (has_next ? (size_t)NWAVES * 4096 : 0));
}

struct Args { const float* in[17]; float* out; unsigned char* ws; };
enum { I_X = 0, I_WIN, I_BFOX, I_QG, I_KG, I_HLB, I_HOG, I_ROG, I_WOUT, I_GMPRE, I_GMPOST, I_WUP, I_CW, I_CB, I_WDN, I_GFPRE, I_GFPOST };
typedef const __attribute__((address_space(4))) Args* CArgs;
__device__ __forceinline__ int lane_id() { return pg8::fresh_lane(); }
__device__ __forceinline__ int opaque_tid(int wave_s) { int t = wave_s * 64 + lane_id(); asm volatile("" : "+v"(t)); return t; }
__device__ __forceinline__ CArgs opaque_args() { CArgs p = (CArgs)__builtin_amdgcn_kernarg_segment_ptr(); asm volatile("" : "+s"(p)); return p; }
#define PH_BEGIN const int tid = opaque_tid(wave_s), lane = tid & 63, wave = __builtin_amdgcn_readfirstlane(tid >> 6); const int G = gridDim.x, gw = blockIdx.x * NWAVES + wave, NGW = G * NWAVES; \
    CArgs ap = opaque_args(); unsigned char* ws = ap->ws; (void)lane; (void)gw; (void)NGW; (void)ws;

#define GRID_BAR() do { XcdBarrier b_; b_.bar = (unsigned*)((gu32*)(opaque_args()->ws + WS_CTL) + CW_BAR); b_.x = xb_xcc_id(); b_.st = (volatile LAS unsigned*)(lds + MISC_OFF) + 8; xcd_barrier(b_, opaque_tid(wave_s) == 0); } while (0)
__global__ void __launch_bounds__(NWAVES * 64, 2) fwd(Args args_unused) {
    extern __shared__ __attribute__((aligned(16))) unsigned char lds_raw[];
    LAS unsigned char* lds = (LAS unsigned char*)lds_raw;
    const int wave_s = __builtin_amdgcn_readfirstlane((int)threadIdx.x >> 6);
    { volatile LAS unsigned* MISC = (volatile LAS unsigned*)(lds + MISC_OFF);
      CArgs ap0 = opaque_args();
      for (int u = threadIdx.x; u < (LDS_BYTES - LDSCTL_OFF) / 4; u += NWAVES * 64) ((LAS unsigned*)(lds + LDSCTL_OFF))[u] = 0u;
      __syncthreads();
      (void)xcd_barrier_post((unsigned*)((gu32*)(ap0->ws + WS_CTL) + CW_BAR), MISC + 8); }

    { PH_BEGIN
        bf16* WinT = (bf16*)(ws + WS_WIN); bf16* WoutT = (bf16*)(ws + WS_WOUT); bf16* WupT = (bf16*)(ws + WS_WUP); bf16* WdnT = (bf16*)(ws + WS_WDN);
        float* WF = (float*)(ws + WS_WF); float* COS = (float*)(ws + WS_COS); float* SIN = (float*)(ws + WS_SIN); float* LB = (float*)(ws + WS_LB);
        LAS float* scr = (LAS float*)(lds + wave * 16384);
        constexpr int I_IN = 16 * 128, I_OUT = 16 * 32, I_UP = 16 * 176, I_DN = 44 * 32, I_L = I_IN + I_OUT + I_UP + I_DN;
        for (int it = gw; it < DEPTH * I_L; it += NGW) {
            const int l = it / I_L; int r = it % I_L;
            if (r < I_IN) { const int kb = r / 128, nb = r % 128; const int pc = 32 * nb; const bool rot = (pc >= PC_CQ && pc < PC_CQ + 256) || (pc >= PC_CK && pc < PC_CK + 256);
                const int scol = rot ? pcol_to_orig(pc & ~63) + ((pc & 63) >> 1) : pcol_to_orig(pc);
                tr_item(ap->in[I_WIN] + (size_t)l * D * IN_COLS, IN_COLS, scol, 64 * kb, WinT + (size_t)l * NP * D, NP, pc, scr, lane, ap->in[I_GMPRE] + l * D, rot, true); continue; } r -= I_IN;
            if (r < I_OUT) { const int kb = r / 32, nb = r % 32; tr_item(ap->in[I_WOUT] + (size_t)l * D * D, D, 32 * nb, 64 * kb, WoutT + (size_t)l * D * D, D, 32 * nb, scr, lane, nullptr, false, true); continue; } r -= I_OUT;
            if (r < I_UP) { const int kb = r / 176, nb = r % 176; const int np = 32 * nb, srcc = ((np >> 7) & 1) * D_FF + 128 * (np >> 8) + (np & 127); tr_item(ap->in[I_WUP] + (size_t)l * D * NUP, NUP, srcc, 64 * kb, WupT + (size_t)l * NUP * D, NUP, np, scr, lane, ap->in[I_GFPRE] + l * D); continue; } r -= I_UP;
            { const int kb = r / 32, nb = r % 32; tr_item(ap->in[I_WDN] + (size_t)l * D_FF * D, D, 32 * nb, 64 * kb, WdnT + (size_t)l * D * D_FF, D, 32 * nb, scr, lane, nullptr, false, true); }
        }
        const int gt = blockIdx.x * (NWAVES * 64) + tid, NGT = G * NWAVES * 64;
        for (int i = gt; i < DEPTH * 8 * 1024; i += NGT) { const int l = i / 8192, j = (i / 1024) & 7, k = i & 1023; WF[i] = j < 6 ? ap->in[I_WIN][((size_t)l * D + k) * IN_COLS + OC_BF + j] * ap->in[I_GMPRE][l * D + k] : 0.f; }
        for (int i = gt; i < 384; i += NGT) { float v[DEPTH], mx = -1e30f;
#pragma unroll
            for (int l = 0; l < DEPTH; ++l) { v[l] = ap->in[I_HLB][l * 384 + i]; mx = fmaxf(mx, v[l]); }
            float sum = 0.f;
#pragma unroll
            for (int l = 0; l < DEPTH; ++l) { v[l] = expf(v[l] - mx); sum += v[l]; }
            float run = 0.f; const float p0 = v[0] / sum;
#pragma unroll
            for (int l = 0; l < DEPTH; ++l) { run += v[l] / sum; LB[l * 384 + i] = run - p0; } }
        for (int i = gt; i < T * 32; i += NGT) { const int t = i >> 5, f = i & 31;
            const float invf = 1.0f / (float)exp2((double)f * (13.287712379549449 / 32.0));
            const float ang = (float)t * invf; const double rev = (double)ang * 0.15915494309189535; const float fr = (float)(rev - floor(rev));
            COS[i] = __builtin_amdgcn_cosf(fr); SIN[i] = __builtin_amdgcn_sinf(fr); }
        __syncthreads();
        { LAS float* wf0 = (LAS float*)lds;
          for (int i = tid; i < 6 * 1024; i += NWAVES * 64) { const int j = i >> 10, k = i & 1023; wf0[i] = ap->in[I_WIN][(size_t)k * IN_COLS + OC_BF + j] * ap->in[I_GMPRE][k]; } }
        __syncthreads();
        { f32x4 nx[4][4];
#pragma unroll
          for (int r = 0; r < 4; ++r)
#pragma unroll
              for (int j = 0; j < 4; ++j) nx[r][j] = *(const f32x4*)(ap->in[I_X] + (size_t)(4 * gw + r) * D + 4 * lane + 256 * j);
          for (int m = 4 * gw; m < M; m += 4 * NGW) { f32x4 cur[4][4];
#pragma unroll
              for (int r = 0; r < 4; ++r)
#pragma unroll
                  for (int j = 0; j < 4; ++j) cur[r][j] = nx[r][j];
              const int mn = (m + 4 * NGW < M) ? m + 4 * NGW : m;
#pragma unroll
              for (int r = 0; r < 4; ++r)
#pragma unroll
                  for (int j = 0; j < 4; ++j) nx[r][j] = *(const f32x4*)(ap->in[I_X] + (size_t)(mn + r) * D + 4 * lane + 256 * j);
              asm volatile("" ::: "memory");
              row_updateNx<4>(lane, (size_t)m, (size_t)1, ap->in[I_X], nullptr, nullptr, nullptr, (bf16*)(ws + WS_XB), nullptr, (float*)(ws + WS_RS), (const float*)lds_raw, ap->in[I_BFOX], (float*)(ws + WS_LOGF), cur); } }
    }
    GRID_BAR();

#pragma unroll 1
    for (int l = 0; l < DEPTH; ++l) {
        { PH_BEGIN
          if (gw < 96) {
            const float* LOGF = (const float*)(ws + WS_LOGF); float* FCUM = (float*)(ws + WS_FCUM);
            const int b = gw / 6, h = gw % 6; const float* lf = LOGF + ((size_t)b * T + lane) * 8 + h; float* Fo = FCUM + (size_t)gw * T + lane; float carry = 0.f;
#pragma unroll 4
            for (int i = 0; i < 64; ++i) { float v = lf[(size_t)i * 512];
                v += dppf<0x111>(v); v += dppf<0x112>(v); v += dppf<0x114>(v); v += dppf<0x118>(v);
                v += __uint_as_float((unsigned)__builtin_amdgcn_update_dpp(0, (int)__float_as_uint(v), 0x142, 0xA, 0xF, false));
                v += __uint_as_float((unsigned)__builtin_amdgcn_update_dpp(0, (int)__float_as_uint(v), 0x143, 0xC, 0xF, false));
                v += carry; Fo[i * 64] = v; carry = __uint_as_float((unsigned)__builtin_amdgcn_readlane((int)__float_as_uint(v), 63)); } }
          pg8::Gemm g{(const bf16*)(ws + WS_XB), (const bf16*)(ws + WS_WIN) + (size_t)l * NP * D, M, NP, D, 64, 64, (size_t)M * 64 * 2, (size_t)NP * 64 * 2}; pg8::StaticOrder S; S.init(M, NP, G, (int)blockIdx.x);
          pg8::EpiBf16RS E{(bf16*)(ws + WS_P), M, (const float*)(ws + WS_RS), (const float*)(ws + WS_COS), (const float*)(ws + WS_SIN), PC_CQ / 256, PC_CK / 256, lds + HALO_OFF};
          pg8::gemm_phase<pg8::EpiBf16RS, pg8::StaticOrder, true, true>(lds, g, S, E, tid); }
        GRID_BAR();
        { PH_BEGIN
          bf16* P = (bf16*)(ws + WS_P); LAS unsigned char* wl = lds + wave * 16384;
          const bool helpers = (G >= 256);
          gu32* hflag = (gu32*)(ws + WS_CTL) + CW_FLAGS + (l * 96) * 16;
          if (blockIdx.x < 160) {
              const int chain = blockIdx.x;
              if (chain < 96) { const int nend = helpers ? 32 : 64; TilePF pf; { const bf16* t0 = hgrn_tile(P, chain * 64 + wave); tile_fetch(pf, t0 + CB(PC_AF), t0 + CB(PC_AI), lane); }
                  for (int n = wave; n < nend; n += NWAVES) rec_pass1_hgrn<false>(wl, P, (const float*)(ws + WS_LB) + l * 384, (bf16*)(ws + WS_U), (float*)(ws + WS_DK), chain * 64 + n, lane, pf, n + NWAVES < nend); }
              else { TilePF pf; { const bf16* t0 = ret_tile(P, (chain - 96) * 64 + wave); tile_fetch(pf, t0 + CB(PC_CK), t0 + CB(PC_CV), lane); }
                  for (int n = wave; n < 64; n += NWAVES) rec_pass1_ret(wl, P, (bf16*)(ws + WS_U), (chain - 96) * 64 + n, lane, pf, n + NWAVES < 64); }
              asm volatile("s_waitcnt vmcnt(0)" ::: "memory"); __syncthreads();
              if (chain < 96 && helpers) {
                  if (tid == 0) { unsigned sp = 0u; while (__hip_atomic_load(hflag + chain * 16, RLX_AGENT) == 0u) { __builtin_amdgcn_s_sleep(2); if (++sp > (1u << 22)) break; }
                      __builtin_amdgcn_fence(__ATOMIC_ACQUIRE, "agent"); asm volatile("s_waitcnt vmcnt(0)" ::: "memory"); }
                  __syncthreads(); }
              rec_pass2_chain((const bf16*)(ws + WS_U), (const float*)(ws + WS_DK), (bf16*)(ws + WS_ST), chain, tid);
              asm volatile("s_waitcnt vmcnt(0)" ::: "memory"); __syncthreads();
              if (chain < 96) { TilePF pf; { const bf16* t0 = hgrn_tile(P, chain * 64 + wave); tile_fetch(pf, t0 + CB(PC_AF), t0 + CB(PC_AI), lane); }
                  for (int n = wave; n < 64; n += NWAVES) rec_pass3_hgrn(wl, P, (const float*)(ws + WS_LB) + l * 384, ap->in[I_HOG] + l * 384, (const bf16*)(ws + WS_ST), chain * 64 + n, lane, pf, n + NWAVES < 64); }
              else { TilePF pf; tile_fetch_b(pf, ret_tile(P, (chain - 96) * 64 + wave) + CB(PC_CV), lane);
                  for (int n = wave; n < 64; n += NWAVES) rec_pass3_ret(wl, P, ap->in[I_ROG] + l * 256, (const bf16*)(ws + WS_ST), (chain - 96) * 64 + n, lane, pf, n + NWAVES < 64); }
              __syncthreads();
          } else if (helpers && blockIdx.x < 256) {
              const int chain = blockIdx.x - 160;
              TilePF pf; { const bf16* t0 = hgrn_tile(P, chain * 64 + 32 + wave); tile_fetch(pf, t0 + CB(PC_AF), t0 + CB(PC_AI), lane); }
              for (int n = 32 + wave; n < 64; n += NWAVES) rec_pass1_hgrn<true>(wl, P, (const float*)(ws + WS_LB) + l * 384, (bf16*)(ws + WS_U), (float*)(ws + WS_DK), chain * 64 + n, lane, pf, n + NWAVES < 64);
              asm volatile("s_waitcnt vmcnt(0)" ::: "memory"); __syncthreads();
              if (tid == 0) __hip_atomic_store(hflag + chain * 16, 1u, RLX_AGENT);
              __syncthreads();
          }
          float gq = 0.f, gk = 0.f;
          for (int i = 0; i < 64; ++i) { gq = fmaxf(gq, fabsf(ap->in[I_QG][l * 64 + i])); gk = fmaxf(gk, fabsf(ap->in[I_KG][l * 64 + i])); }
          const float bound2 = 2.0f * (8.0f * gq * 0.125f * 1.4426950408889634f * 1.004f) * (8.0f * gk * 1.004f);
          attn_v3(lds, P, (const float*)(ws + WS_FCUM), tid, (unsigned*)((gu32*)(ws + WS_CTL) + CW_QUEUE + 128 * l), bound2, ap->in[I_QG] + l * 64, ap->in[I_KG] + l * 64); }
        GRID_BAR();
        { PH_BEGIN
          pg8::Gemm g{(const bf16*)(ws + WS_P), (const bf16*)(ws + WS_WOUT) + (size_t)l * D * D, M, D, D, 64, 64, (size_t)M * 64 * 2, (size_t)D * 64 * 2}; pg8::StaticOrder S; S.init(M, D, G, (int)blockIdx.x);
          { LAS float* gl = (LAS float*)(lds + GAIN_OFF); const float* gsrc = ap->in[I_GMPOST] + l * D; gl[tid] = gsrc[tid]; gl[tid + 512] = gsrc[tid + 512]; }
          pg8::EpiNormRes E{(bf16*)(ws + WS_XB), (const LAS float*)(lds + GAIN_OFF), (float*)(ws + WS_SLOT1), (unsigned*)((gu32*)(ws + WS_CTL) + CW_CNT + (l * 4 + 0) * 4096),
                            (float*)(ws + WS_RS), (LAS float*)(lds + HALO_OFF)};
          pg8::gemm_phase<pg8::EpiNormRes, pg8::StaticOrder, true, true>(lds, g, S, E, tid); }
        GRID_BAR();
        { PH_BEGIN
          pg8::Gemm g{(const bf16*)(ws + WS_XB), (const bf16*)(ws + WS_WUP) + (size_t)l * NUP * D, M, NUP, D, 64, 64, (size_t)M * 64 * 2, (size_t)NUP * 64 * 2}; pg8::StaticOrder S; S.init(M, NUP, G, (int)blockIdx.x);
          pg8::EpiConvAct E{(bf16*)(ws + WS_ACT), ap->in[I_CW] + (size_t)l * 3 * NUP, ap->in[I_CB] + (size_t)l * NUP, (float*)(ws + WS_EDGEL), (float*)(ws + WS_EDGEP), lds + HALO_OFF, D_FF, (const float*)(ws + WS_RS), (size_t)M * 64, lds + RING_BYTES + 10240};
          pg8::gemm_phase<pg8::EpiConvAct, pg8::StaticOrder, true, true>(lds, g, S, E, tid); }
        GRID_BAR();
        { PH_BEGIN
          pg8::Gemm g{(const bf16*)(ws + WS_ACT), (const bf16*)(ws + WS_WDN) + (size_t)l * D * D_FF, M, D, D_FF, 64, 64, (size_t)M * 64 * 2, (size_t)D * 64 * 2}; pg8::StaticOrder S; S.init(M, D, G, (int)blockIdx.x);
          { const float* EL = (const float*)(ws + WS_EDGEL); const float* EP = (const float*)(ws + WS_EDGEP); bf16* ACT = (bf16*)(ws + WS_ACT);
            const float* cw = ap->in[I_CW] + (size_t)l * 3 * NUP; pg8::Unit fu;
            for (int ui = 0; S.next(ui, fu); ++ui) { const int pm = fu.pm; if ((pm & 15) == 0) continue;
              for (int ch = tid; ch < D_FF; ch += NWAVES * 64) {
                const int ng = 256 * (ch >> 7) + (ch & 127), nv = ng + 128;
                const float w0g = cw[ch], w1g = cw[NUP + ch], w0v = cw[D_FF + ch], w1v = cw[NUP + D_FF + ch];
                const float lg0 = EL[(size_t)((pm - 1) * 2 + 0) * NUP + ng], lg1 = EL[(size_t)((pm - 1) * 2 + 1) * NUP + ng], lv0 = EL[(size_t)((pm - 1) * 2 + 0) * NUP + nv], lv1 = EL[(size_t)((pm - 1) * 2 + 1) * NUP + nv];
                const float g0 = EP[(size_t)(pm * 2 + 0) * NUP + ng] + w0g * lg0 + w1g * lg1, v0 = EP[(size_t)(pm * 2 + 0) * NUP + nv] + w0v * lv0 + w1v * lv1;
                const float g1 = EP[(size_t)(pm * 2 + 1) * NUP + ng] + w0g * lg1, v1 = EP[(size_t)(pm * 2 + 1) * NUP + nv] + w0v * lv1;
                ACT[((size_t)(ch >> 6) * M + (pm * 256 + 0)) * 64 + (ch & 63)] = (bf16)f2bf(g0 / (1.0f + __expf(-g0)) * v0);
                ACT[((size_t)(ch >> 6) * M + (pm * 256 + 1)) * 64 + (ch & 63)] = (bf16)f2bf(g1 / (1.0f + __expf(-g1)) * v1); } }
            asm volatile("s_waitcnt vmcnt(0)" ::: "memory"); __syncthreads(); }
          const bool last = (l == DEPTH - 1);
          pg8::EpiNormResFFN E{(bf16*)(ws + WS_XB), ap->in[I_GFPOST] + l * D, (float*)(ws + WS_SLOT1), (unsigned*)((gu32*)(ws + WS_CTL) + CW_CNT + (l * 4 + 2) * 4096), (float*)(ws + WS_RS), (LAS float*)(lds + HALO_OFF),
                               last ? ap->out : nullptr, (const float*)(ws + WS_WF) + (l + 1) * 8192, ap->in[I_BFOX] + (l + 1) * 6, (float*)(ws + WS_LPART), (unsigned*)((gu32*)(ws + WS_CTL) + CW_CNT + (l * 4 + 3) * 4096),
                               (float*)(ws + WS_LOGF), (LAS float*)(lds + LGL_OFF)};
          pg8::gemm_phase<pg8::EpiNormResFFN, pg8::StaticOrder, true, true>(lds, g, S, E, tid); }
        if (l < DEPTH - 1) GRID_BAR();
    }
}

extern "C" void kernel_launch(void* const* d_in, const int* in_sizes, int n_in, void* d_out, int out_size, void* d_ws, size_t ws_size, hipStream_t stream) {
    static int grid = 0;
    if (grid == 0) {
        if (n_in != 17 || in_sizes[0] != M * D || out_size != M * D || ws_size < WS_END) { fprintf(stderr, "kernel_launch: unexpected shapes (n_in %d, in0 %d, out %d, ws %zu)\n", n_in, n_in > 0 ? in_sizes[0] : -1, out_size, ws_size); grid = -1; return; }
        int dev = 0, cus = 0;
        if (hipGetDevice(&dev) != hipSuccess || hipDeviceGetAttribute(&cus, hipDeviceAttributeMultiprocessorCount, dev) != hipSuccess) { grid = -1; return; }
        if (hipFuncSetAttribute((const void*)fwd, hipFuncAttributeMaxDynamicSharedMemorySize, LDS_BYTES) != hipSuccess) { grid = -1; return; }
        (void)hipGetLastError();
        grid = cus;
    }
    if (grid < 0) return;
    if (hipMemsetAsync((char*)d_ws + WS_CTL, 0, CTL_ZERO_BYTES, stream) != hipSuccess) return;
    Args a{};
    for (int i = 0; i < 17; ++i) a.in[i] = (const float*)d_in[i];
    a.out = (float*)d_out; a.ws = (unsigned char*)d_ws;
    hipLaunchKernelGGL(fwd, dim3(grid), dim3(NWAVES * 64), LDS_BYTES, stream, a);
}
```

```cpp
#include <hip/hip_runtime.h>
#include <cstdio>
#include <cstdint>
#include <cmath>
__device__ __forceinline__ float shfl_i(float v, int src) { return __uint_as_float((unsigned)__builtin_amdgcn_ds_bpermute(src << 2, (int)__float_as_uint(v))); }
template <int CTRL> __device__ __forceinline__ float dppf(float v) { return __uint_as_float((unsigned)__builtin_amdgcn_update_dpp(0, (int)__float_as_uint(v), CTRL, 0xf, 0xf, true)); }
namespace pg8 {
#define PG8_LAS __attribute__((address_space(3)))
__device__ __forceinline__ int fresh_lane() { int l; asm volatile("v_mbcnt_lo_u32_b32 %0, -1, 0\n\tv_mbcnt_hi_u32_b32 %0, -1, %0\n\ts_nop 1" : "=v"(l)); return l; }
typedef unsigned short bf16_t;
typedef short bf16x8 __attribute__((ext_vector_type(8)));
typedef float f32x4 __attribute__((ext_vector_type(4)));
typedef unsigned u32x4 __attribute__((ext_vector_type(4)));
constexpr int BM = 256, BK = 64, HALF = 128, HTB = HALF * BK * 2  , STAGE_BYTES = 8 * HTB, NXCD = 8, WGM = 8;

__host__ __device__ __forceinline__ int lds_byte(int r, int c) { const int st = (r >> 4) * 2 + (c >> 5), rr = r & 15, cc = c & 31, ob = rr * 64 + cc * 2; return st * 1024 + (ob ^ (((ob >> 9) & 1) << 5)); }
__host__ __device__ __forceinline__ void stage_rc(int b, int& R, int& C) { const int st = b / 1024, sb = b % 1024, swz = sb ^ (((sb >> 9) & 1) << 5); R = (st >> 1) * 16 + swz / 64; C = (st & 1) * 32 + (swz % 64) / 2; }
__host__ __device__ __forceinline__ int perm32(int rho) { const int n = rho >> 4, i = rho & 15; return 8 * (i >> 2) + 4 * n + (i & 3); }

struct Unit { int pm, pn; };
struct Gemm { const bf16_t* A; const bf16_t* Bt; int M, N, K, lda, ldb; size_t kstrA, kstrB; };

struct StaticOrder {
    int nM, nN, nwg, G, c;
    __host__ __device__ void init(int M, int N, int G_, int c_) { nM = M / BM; nN = N / BM; nwg = nM * nN; G = G_; c = c_; }
    __host__ __device__ bool next(int i, Unit& u) const {
        const long L = (long)i * G + c; if (L >= nwg) return false;
        int wgid = (int)L; { const int q = nwg / NXCD, r = nwg % NXCD, xcd = wgid % NXCD, off = wgid / NXCD; wgid = (xcd < r ? xcd * (q + 1) : r * (q + 1) + (xcd - r) * q) + off; }
        const int nig = WGM * nN, gid = wgid / nig, fm = gid * WGM, gsz = (nM - fm) < WGM ? (nM - fm) : WGM;
        u.pm = fm + ((wgid % nig) % gsz); u.pn = (wgid % nig) / gsz; return true;
    }
    __device__ __forceinline__ void a_ready(const Unit&) const {}
    __device__ __forceinline__ void done(const Unit&) const {}
};


__device__ __forceinline__ unsigned cvt_pk_bf16(float lo, float hi) { unsigned r; asm volatile("v_cvt_pk_bf16_f32 %0, %1, %2" : "=v"(r) : "v"(lo), "v"(hi)); return r; }
typedef float f32x2 __attribute__((ext_vector_type(2)));

template <int ACT  > struct EpiBf16 {
    static constexpr bool PERM = true, AFTER_DRAIN = false, PREFETCH = false; static_assert(ACT == 0, "EpiBf16: ACT is 0");
    bf16_t* O; int ldc; const float* bias; int split_cols; size_t split_stride; float scale0;
    __device__ __forceinline__ void operator()(const f32x4 (&acc)[2][2][4][2], const Unit& u, int wr, int wc, int fr, int fq) const {
        const int row0 = u.pm * BM + wr * 64 + fr; int colt = u.pn * BM; bf16_t* base = O;
        float sc = 1.f; if (split_cols) { const int t = colt / split_cols; base += (size_t)t * split_stride; colt -= t * split_cols; if (t == 0) sc = scale0; }
        const int col0 = colt + wc * 32 + 8 * fq, bcol0 = u.pn * BM + wc * 32 + 8 * fq;
        f32x4 bv[2][2];
#pragma unroll
        for (int bj = 0; bj < 2; ++bj)
#pragma unroll
            for (int n = 0; n < 2; ++n) bv[bj][n] = bias ? *(const f32x4*)(bias + bcol0 + bj * HALF + 4 * n) : (f32x4){0.f, 0.f, 0.f, 0.f};
#pragma unroll
        for (int ai = 0; ai < 2; ++ai)
#pragma unroll
            for (int m = 0; m < 4; ++m) { bf16_t* rowp = base + (size_t)(row0 + ai * HALF + m * 16) * ldc + col0;
#pragma unroll
                for (int bj = 0; bj < 2; ++bj) { f32x4 v0 = acc[ai][bj][m][0] + bv[bj][0], v1 = acc[ai][bj][m][1] + bv[bj][1];

                    v0 = v0 * sc; v1 = v1 * sc; u32x4 w; w.x = cvt_pk_bf16(v0[0], v0[1]); w.y = cvt_pk_bf16(v0[2], v0[3]); w.z = cvt_pk_bf16(v1[0], v1[1]); w.w = cvt_pk_bf16(v1[2], v1[3]);
                    *(u32x4*)(rowp + bj * HALF) = w; } }
    }
};


struct EpiBf16RS {
    static constexpr bool PERM = true, AFTER_DRAIN = false, PREFETCH = true;
    bf16_t* O; int ldc; const float* rs; const float* cosT; const float* sinT; int pn_q, pn_k; PG8_LAS unsigned char* rbuf;
    __device__ __forceinline__ void prefetch(const Unit& u, int par, int wid, int lane) const {
        if (wid < 4) __builtin_amdgcn_global_load_lds((const unsigned*)(rs + ((size_t)u.pm * BM + wid * 64 + lane) * 4), (PG8_LAS unsigned*)(rbuf + par * 4096 + wid * 1024), 16, 0, 0); }
    __device__ __forceinline__ void operator()(const f32x4 (&acc)[2][2][4][2], const Unit& u, int wr, int wc, int fr, int fq, int par) const {
        const int row0 = u.pm * BM + wr * 64 + fr, col0 = u.pn * BM + wc * 64 + 8 * fq;
        const bool rot = (u.pn == pn_q) || (u.pn == pn_k); const float ksc = (u.pn == pn_k) ? 0.125f : 1.0f; const int p0 = 4 * fq;
        float scv[2][4];
#pragma unroll
        for (int ai = 0; ai < 2; ++ai)
#pragma unroll
            for (int m = 0; m < 4; ++m) { const f32x4 q4 = *(const PG8_LAS f32x4*)(rbuf + par * 4096 + (wr * 64 + fr + ai * HALF + m * 16) * 16); scv[ai][m] = __builtin_amdgcn_rsqf(((q4[0] + q4[1]) + (q4[2] + q4[3])) * (1.f / 1024.f) + 1e-6f); }
        bf16_t* rowb = O + ((size_t)(col0 >> 6) * (size_t)ldc + row0) * 64 + (col0 & 63);
        if (!rot) {
#pragma unroll
            for (int ai = 0; ai < 2; ++ai)
#pragma unroll
                for (int m = 0; m < 4; ++m) { const float sc = scv[ai][m]; bf16_t* rowp = rowb + (ai * HALF + m * 16) * 64;
#pragma unroll
                    for (int bj = 0; bj < 2; ++bj) { const f32x4 v0 = acc[ai][bj][m][0] * sc, v1 = acc[ai][bj][m][1] * sc;
                        u32x4 w; w.x = cvt_pk_bf16(v0[0], v0[1]); w.y = cvt_pk_bf16(v0[2], v0[3]); w.z = cvt_pk_bf16(v1[0], v1[1]); w.w = cvt_pk_bf16(v1[2], v1[3]);
                        *(u32x4*)(rowp + bj * 32) = w; } }
        } else {
            f32x4 cn[2], sn[2];
#pragma unroll
            for (int bj = 0; bj < 2; ++bj) { const int t = row0 & 4095; cn[bj] = *(const f32x4*)(cosT + t * 32 + p0 + 16 * bj); sn[bj] = *(const f32x4*)(sinT + t * 32 + p0 + 16 * bj); }
#pragma unroll
            for (int i = 0; i < 8; ++i) { const int ai = i >> 2, m = i & 3; const float sc = scv[ai][m]; bf16_t* rowp = rowb + (ai * HALF + m * 16) * 64;
                f32x4 c4b[2], s4b[2];
#pragma unroll
                for (int bj = 0; bj < 2; ++bj) { c4b[bj] = cn[bj] * ksc; s4b[bj] = sn[bj] * ksc; }
                if (i < 7) { const int t = (row0 + ((i + 1) >> 2) * HALF + ((i + 1) & 3) * 16) & 4095;
#pragma unroll
                    for (int bj = 0; bj < 2; ++bj) { cn[bj] = *(const f32x4*)(cosT + t * 32 + p0 + 16 * bj); sn[bj] = *(const f32x4*)(sinT + t * 32 + p0 + 16 * bj); } }
                asm volatile("" ::: "memory");
#pragma unroll
                for (int bj = 0; bj < 2; ++bj) { f32x4 v0 = acc[ai][bj][m][0] * sc, v1 = acc[ai][bj][m][1] * sc; const f32x4 c4 = c4b[bj], s4 = s4b[bj];
                    const f32x4 a0 = v0, a1 = v1;
                    v0[0] = a0[0] * c4[0] - a0[1] * s4[0]; v0[1] = a0[0] * s4[0] + a0[1] * c4[0]; v0[2] = a0[2] * c4[1] - a0[3] * s4[1]; v0[3] = a0[2] * s4[1] + a0[3] * c4[1];
                    v1[0] = a1[0] * c4[2] - a1[1] * s4[2]; v1[1] = a1[0] * s4[2] + a1[1] * c4[2]; v1[2] = a1[2] * c4[3] - a1[3] * s4[3]; v1[3] = a1[2] * s4[3] + a1[3] * c4[3];
                    u32x4 w; w.x = cvt_pk_bf16(v0[0], v0[1]); w.y = cvt_pk_bf16(v0[2], v0[3]); w.z = cvt_pk_bf16(v1[0], v1[1]); w.w = cvt_pk_bf16(v1[2], v1[3]);
                    *(u32x4*)(rowp + bj * 32) = w; } }
        }
    }
};

typedef float f32x2e __attribute__((ext_vector_type(2))); typedef __bf16 bf16x2e __attribute__((ext_vector_type(2)));
__device__ __forceinline__ unsigned cvt_pk_bf16_v(float lo, float hi) { f32x2e v = {lo, hi}; bf16x2e b = __builtin_convertvector(v, bf16x2e); return __builtin_bit_cast(unsigned, b); }
struct EpiConvAct {
    static constexpr bool PERM = true, AFTER_DRAIN = false, PREFETCH = true;
    bf16_t* ACT; const float* cw; const float* cb; float* EDGEL; float* EDGEP; PG8_LAS unsigned char* halo; int dff; const float* rs; size_t blk; PG8_LAS unsigned char* wbuf;
    __device__ __forceinline__ void prefetch(const Unit& u, int par, int wid, int lane) const {
        if (wid < 4) { const int sg = 2 * wid + (lane >> 5); const float* src = (sg < 6 ? cw + (size_t)(sg >> 1) * (2 * dff) : cb) + (sg & 1) * dff + 128 * u.pn + (lane & 31) * 4;
            __builtin_amdgcn_global_load_lds((const unsigned*)src, (PG8_LAS unsigned*)(wbuf + par * 8192 + wid * 1024), 16, 0, 0); }
        else { const float* src = rs + ((size_t)u.pm * BM + (wid - 4) * 64 + lane) * 4;
            __builtin_amdgcn_global_load_lds((const unsigned*)src, (PG8_LAS unsigned*)(wbuf + par * 8192 + 4096 + (wid - 4) * 1024), 16, 0, 0); } }
    __device__ __forceinline__ void operator()(const f32x4 (&acc)[2][2][4][2], const Unit& u, int wr, int wc, int fr, int fq, int par) const {
        { const int l_ = fresh_lane(); fr = l_ & 15; fq = l_ >> 4; }
        const int wave = wr * 4 + wc, lane = fq * 16 + fr, nup = 2 * dff;
        const int ch0 = 128 * u.pn + 32 * wc + 8 * fq;
        float rsv[2][4];
#pragma unroll
        for (int ai = 0; ai < 2; ++ai)
#pragma unroll
            for (int m = 0; m < 4; ++m) { const f32x4 q4 = *(const PG8_LAS f32x4*)(wbuf + par * 8192 + 4096 + (ai * HALF + wr * 64 + m * 16 + fr) * 16); rsv[ai][m] = __builtin_amdgcn_rsqf(((q4[0] + q4[1]) + (q4[2] + q4[3])) * (1.f / 1024.f) + 1e-6f); }
#pragma unroll
        for (int ai = 0; ai < 2; ++ai) if (fr >= 14) {
#pragma unroll
            for (int bj = 0; bj < 2; ++bj)
#pragma unroll
                for (int n = 0; n < 2; ++n) *(PG8_LAS f32x4*)(halo + ((((wave * 2 + ai) * 2 + (fr - 14)) * 4 + fq) * 64) + (bj * 2 + n) * 16) = acc[ai][bj][3][n] * rsv[ai][3]; }
        if (wr == 1 && fr >= 14) {
#pragma unroll
            for (int bj = 0; bj < 2; ++bj)
#pragma unroll
                for (int n = 0; n < 2; ++n) *(f32x4*)(EDGEL + ((size_t)(u.pm * 2 + (fr - 14))) * nup + 256 * u.pn + 128 * bj + 32 * wc + 8 * fq + 4 * n) = acc[1][bj][3][n] * rsv[1][3]; }
        asm volatile("s_waitcnt lgkmcnt(0)" ::: "memory"); __builtin_amdgcn_s_barrier(); asm volatile("" ::: "memory");
        const size_t acb = (size_t)(ch0 >> 6) * blk + (ch0 & 63);
        typedef unsigned u32x2 __attribute__((ext_vector_type(2)));
        u32x2 pend[2][4];
#pragma unroll
        for (int n = 0; n < 2; ++n) {
            f32x4 w[3][2], bb[2];
#pragma unroll
            for (int bj = 0; bj < 2; ++bj) { const PG8_LAS float* wl_ = (const PG8_LAS float*)(wbuf + par * 8192) + bj * 128 + 32 * wc + 8 * fq + 4 * n; bb[bj] = *(const PG8_LAS f32x4*)(wl_ + 6 * 128);
#pragma unroll
                for (int j = 0; j < 3; ++j) w[j][bj] = *(const PG8_LAS f32x4*)(wl_ + j * 256); }
#pragma unroll
            for (int ai = 0; ai < 2; ++ai) {
                const bool none = (ai == 0 && wr == 0); const int pw = wr == 1 ? wave - 4 : wave + 4, pai = wr == 1 ? ai : 0;
                float r1p[2][4], r2p[2][4];
#pragma unroll
                for (int bj = 0; bj < 2; ++bj) { f32x4 h = (f32x4){0.f, 0.f, 0.f, 0.f};
                    if (!none && fr >= 14) h = *(const PG8_LAS f32x4*)(halo + ((((pw * 2 + pai) * 2 + (fr - 14)) * 4 + fq) * 64) + (bj * 2 + n) * 16);
#pragma unroll
                    for (int e = 0; e < 4; ++e) { r1p[bj][e] = dppf<0x121>(h[e]); r2p[bj][e] = dppf<0x122>(h[e]); } }
#pragma unroll
                for (int m = 0; m < 4; ++m) { f32x4 c[2];
#pragma unroll
                    for (int bj = 0; bj < 2; ++bj)
#pragma unroll
                        for (int e = 0; e < 4; ++e) { const float x = acc[ai][bj][m][n][e] * rsv[ai][m]; const float r1 = dppf<0x121>(x), r2 = dppf<0x122>(x);
                            const float u1 = fr == 0 ? r1p[bj][e] : r1, u2 = fr < 2 ? r2p[bj][e] : r2;
                            c[bj][e] = bb[bj][e] + w[0][bj][e] * u2 + w[1][bj][e] * u1 + w[2][bj][e] * x; r1p[bj][e] = r1; r2p[bj][e] = r2; }
                    if (none && m == 0 && fr < 2) {
#pragma unroll
                        for (int bj = 0; bj < 2; ++bj) *(f32x4*)(EDGEP + ((size_t)(u.pm * 2 + fr)) * nup + 256 * u.pn + 128 * bj + 32 * wc + 8 * fq + 4 * n) = c[bj]; }
                    float o[4];
#pragma unroll
                    for (int e = 0; e < 4; ++e) { const float g = c[0][e]; o[e] = g * __builtin_amdgcn_rcpf(1.0f + __builtin_amdgcn_exp2f(-g * 1.4426950408889634f)) * c[1][e]; }
                    u32x2 ow; ow.x = cvt_pk_bf16_v(o[0], o[1]); ow.y = cvt_pk_bf16_v(o[2], o[3]);
                    if (n == 0) { pend[ai][m] = ow; asm volatile("" : "+v"(pend[ai][m])); }
                    else { u32x4 w4; w4.x = pend[ai][m].x; w4.y = pend[ai][m].y; w4.z = ow.x; w4.w = ow.y; *(u32x4*)(ACT + acb + (u.pm * BM + ai * HALF + wr * 64 + m * 16 + fr) * 64) = w4; } }
            }
        }
    }
};

template <class Epi, class Sched, bool ALIGN_EPI = false, bool SP2 = false>
__device__ __forceinline__ void gemm_phase(PG8_LAS unsigned char* lds, const Gemm g, const Sched& S, const Epi& E, int tid_) {
    asm volatile("" : "+v"(tid_)); const int tid = tid_, wid = __builtin_amdgcn_readfirstlane(tid >> 6), lane = tid & 63, wr = wid >> 2, wc = wid & 3, fr = lane & 15, fq = lane >> 4;
    const int K = g.K, nt = K / BK, lda = g.lda, ldb = g.ldb;
    unsigned voffA[2], voffB[2];
#pragma unroll
    for (int i = 0; i < 2; ++i) { int R, C; stage_rc(tid * 16 + i * 8192, R, C); const int Rb = Epi::PERM ? ((R & ~31) + perm32(R & 31)) : R;
        voffA[i] = (unsigned)(R * lda + C) * 2u; voffB[i] = (unsigned)(Rb * ldb + C) * 2u; }
    const size_t kstepB = g.kstrB ? g.kstrB : (size_t)(BK * 2), kstepA = g.kstrA ? g.kstrA : (size_t)(BK * 2);
    const size_t hstepA = (size_t)HALF * lda * 2, hstepB = (size_t)HALF * ldb * 2;
    const size_t tstepA = 2 * hstepA, tstepB = 2 * hstepB;
    const unsigned ldsw = (unsigned)wid * 1024u;
    const int aoff = lds_byte(wr * 64 + fr, fq * 8), boff = lds_byte(wc * 32 + fr, fq * 8);
#define PG8_SA(b, h) (((b) * 2 + (h)) * HTB)
#define PG8_SB(b, h) ((4 + (b) * 2 + (h)) * HTB)
#define PG8_STAGE(bufoff, gbase, voff) do { _Pragma("unroll") for (int _i = 0; _i < 2; ++_i) \
        __builtin_amdgcn_global_load_lds((const unsigned*)((const char*)(gbase) + (voff)[_i]), (PG8_LAS unsigned*)(lds + (bufoff) + ldsw + _i * 8192), 16, 0, 0); } while (0)
#define PG8_LDA(dst, b, h) do { _Pragma("unroll") for (int m = 0; m < 4; ++m) _Pragma("unroll") for (int k = 0; k < 2; ++k) dst[m][k] = *(const PG8_LAS bf16x8*)(lds + PG8_SA(b, h) + aoff + m * 2048 + k * 1024); } while (0)
#define PG8_LDB(dst, b, h) do { _Pragma("unroll") for (int n = 0; n < 2; ++n) _Pragma("unroll") for (int k = 0; k < 2; ++k) dst[n][k] = *(const PG8_LAS bf16x8*)(lds + PG8_SB(b, h) + boff + n * 2048 + k * 1024); } while (0)
#define PG8_MMA(ai, bj, At, Bt) do { __builtin_amdgcn_s_setprio(1); _Pragma("unroll") for (int m = 0; m < 4; ++m) _Pragma("unroll") for (int n = 0; n < 2; ++n) _Pragma("unroll") for (int k = 0; k < 2; ++k) \
        acc[ai][bj][m][n] = __builtin_amdgcn_mfma_f32_16x16x32_bf16(Bt[n][k], At[m][k], acc[ai][bj][m][n], 0, 0, 0); __builtin_amdgcn_s_setprio(0); } while (0)
#define PG8_WAIT_V(n) asm volatile("s_waitcnt vmcnt(" #n ")" ::: "memory")
#define PG8_WAIT_L(n) asm volatile("s_waitcnt lgkmcnt(" #n ")" ::: "memory")
#define PG8_BAR __builtin_amdgcn_s_barrier()
#define PG8_SCHED __builtin_amdgcn_sched_barrier(0)
    Unit cur, nxt; int ui = 0;
    if (!S.next(0, cur)) return;
    f32x4 acc[2][2][4][2];
#pragma unroll
    for (int a = 0; a < 2; ++a)
#pragma unroll
        for (int b = 0; b < 2; ++b)
#pragma unroll
            for (int m = 0; m < 4; ++m)
#pragma unroll
                for (int n = 0; n < 2; ++n) acc[a][b][m][n] = (f32x4){0.f, 0.f, 0.f, 0.f};
    bf16x8 At[4][2], B0[2][2], B1[2][2];
    const char* cA = (const char*)g.A + (size_t)cur.pm * tstepA; const char* cB = (const char*)g.Bt + (size_t)cur.pn * tstepB;
    S.a_ready(cur);
    if constexpr (Epi::PREFETCH) E.prefetch(cur, 0, wid, lane);
    if constexpr (SP2) {
        PG8_STAGE(PG8_SB(0, 0), cB, voffB); PG8_STAGE(PG8_SB(0, 1), cB + hstepB, voffB); PG8_STAGE(PG8_SA(0, 0), cA, voffA); PG8_STAGE(PG8_SA(0, 1), cA + hstepA, voffA);
        if (wr == 1) PG8_BAR;
        PG8_WAIT_V(2); PG8_BAR;
        PG8_STAGE(PG8_SB(1, 0), cB + kstepB, voffB); PG8_STAGE(PG8_SA(1, 0), cA + kstepA, voffA); PG8_STAGE(PG8_SB(1, 1), cB + hstepB + kstepB, voffB);
        PG8_WAIT_V(6); PG8_BAR;
    } else {
        PG8_STAGE(PG8_SB(0, 0), cB, voffB); PG8_STAGE(PG8_SA(0, 0), cA, voffA); PG8_STAGE(PG8_SB(0, 1), cB + hstepB, voffB); PG8_STAGE(PG8_SA(0, 1), cA + hstepA, voffA);
        if (wr == 1) PG8_BAR;
        PG8_WAIT_V(4); PG8_BAR;
        PG8_STAGE(PG8_SB(1, 0), cB + kstepB, voffB); PG8_STAGE(PG8_SA(1, 0), cA + kstepA, voffA); PG8_STAGE(PG8_SB(1, 1), cB + hstepB + kstepB, voffB);
        PG8_WAIT_V(6); PG8_BAR;
    }
    for (;;) {
        const bool has_next = S.next(ui + 1, nxt);
        const char* nA = has_next ? (const char*)g.A + (size_t)nxt.pm * tstepA : cA; const char* nB = has_next ? (const char*)g.Bt + (size_t)nxt.pn * tstepB : cB;
        for (int t = 0; t < nt; t += 2) {
            const bool last = (t == nt - 2);
            const char* a1 = cA + (size_t)(t + 1) * kstepA;
            const char* a2 = last ? nA : cA + (size_t)(t + 2) * kstepA; const char* b2 = last ? nB : cB + (size_t)(t + 2) * kstepB;
            const char* a3 = a2 + kstepA; const char* b3 = b2 + kstepB;
            if (last && has_next) { S.a_ready(nxt); if constexpr (Epi::PREFETCH) E.prefetch(nxt, (ui + 1) & 1, wid, lane); }
            if constexpr (SP2) {
            PG8_LDB(B0, 0, 0); PG8_LDB(B1, 0, 1); PG8_SCHED; PG8_LDA(At, 0, 0); PG8_STAGE(PG8_SA(1, 1), a1 + hstepA, voffA);
            PG8_WAIT_V(8); PG8_WAIT_L(0); PG8_BAR; PG8_MMA(0, 0, At, B0); PG8_MMA(0, 1, At, B1); PG8_BAR; PG8_SCHED;
            PG8_LDA(At, 0, 1); PG8_STAGE(PG8_SB(0, 0), b2, voffB); PG8_STAGE(PG8_SB(0, 1), b2 + hstepB, voffB); PG8_STAGE(PG8_SA(0, 0), a2, voffA);
            PG8_WAIT_V(8); PG8_WAIT_L(0); PG8_BAR; PG8_MMA(1, 0, At, B0); PG8_MMA(1, 1, At, B1); PG8_BAR; PG8_SCHED;
            PG8_LDB(B0, 1, 0); PG8_LDB(B1, 1, 1); PG8_SCHED; PG8_LDA(At, 1, 0); PG8_STAGE(PG8_SA(0, 1), a2 + hstepA, voffA);
            PG8_WAIT_V(8); PG8_WAIT_L(0); PG8_BAR; PG8_MMA(0, 0, At, B0); PG8_MMA(0, 1, At, B1); PG8_BAR; PG8_SCHED;
            PG8_LDA(At, 1, 1); PG8_STAGE(PG8_SB(1, 0), b3, voffB); PG8_STAGE(PG8_SB(1, 1), b3 + hstepB, voffB); PG8_STAGE(PG8_SA(1, 0), a3, voffA);
            PG8_WAIT_V(8); PG8_WAIT_L(0); PG8_BAR; PG8_MMA(1, 0, At, B0); PG8_MMA(1, 1, At, B1); PG8_BAR; PG8_SCHED;
            } else {
            PG8_LDB(B0, 0, 0); PG8_SCHED; PG8_LDA(At, 0, 0); PG8_STAGE(PG8_SA(1, 1), a1 + hstepA, voffA);
            PG8_WAIT_L(8); PG8_BAR; PG8_WAIT_L(0); PG8_MMA(0, 0, At, B0); PG8_BAR; PG8_SCHED;
            PG8_LDB(B1, 0, 1); PG8_STAGE(PG8_SB(0, 0), b2, voffB);
            PG8_BAR; PG8_WAIT_L(0); PG8_MMA(0, 1, At, B1); PG8_BAR;
            PG8_LDA(At, 0, 1); PG8_STAGE(PG8_SA(0, 0), a2, voffA);
            PG8_BAR; PG8_WAIT_L(0); PG8_MMA(1, 0, At, B0); PG8_BAR; PG8_SCHED;
            PG8_STAGE(PG8_SB(0, 1), b2 + hstepB, voffB);
            PG8_WAIT_V(6); PG8_BAR; PG8_MMA(1, 1, At, B1); PG8_BAR;
            PG8_LDB(B0, 1, 0); PG8_SCHED; PG8_LDA(At, 1, 0); PG8_STAGE(PG8_SA(0, 1), a2 + hstepA, voffA);
            PG8_WAIT_L(8); PG8_BAR; PG8_WAIT_L(0); PG8_MMA(0, 0, At, B0); PG8_BAR; PG8_SCHED;
            PG8_LDB(B1, 1, 1); PG8_STAGE(PG8_SB(1, 0), b3, voffB);
            PG8_BAR; PG8_WAIT_L(0); PG8_MMA(0, 1, At, B1); PG8_BAR;
            PG8_LDA(At, 1, 1); PG8_STAGE(PG8_SA(1, 0), a3, voffA);
            PG8_BAR; PG8_WAIT_L(0); PG8_MMA(1, 0, At, B0); PG8_BAR; PG8_SCHED;
            PG8_STAGE(PG8_SB(1, 1), b3 + hstepB, voffB);
            PG8_WAIT_V(6); PG8_BAR; PG8_MMA(1, 1, At, B1); PG8_BAR;
            }
        }
        if constexpr (ALIGN_EPI) { if (wr == 0) PG8_BAR; }
        if constexpr (!Epi::AFTER_DRAIN) { if constexpr (Epi::PREFETCH) E(acc, cur, wr, wc, fr, fq, ui & 1); else E(acc, cur, wr, wc, fr, fq); S.done(cur); }
        if (!has_next) break;
#pragma unroll
        for (int a = 0; a < 2; ++a)
#pragma unroll
            for (int b = 0; b < 2; ++b)
#pragma unroll
                for (int m = 0; m < 4; ++m)
#pragma unroll
                    for (int n = 0; n < 2; ++n) acc[a][b][m][n] = (f32x4){0.f, 0.f, 0.f, 0.f};
        cur = nxt; cA = nA; cB = nB; ++ui;
        if constexpr (ALIGN_EPI) { if (wr == 1) PG8_BAR; }
    }
    PG8_WAIT_V(0);
    if constexpr (!ALIGN_EPI) { if (wr == 0) PG8_BAR; }
    PG8_BAR;
    if constexpr (Epi::AFTER_DRAIN) { E.fused(acc, cur, wr, wc, fr, fq, lds, wid, lane); S.done(cur); }
#undef PG8_SA
#undef PG8_SB
#undef PG8_STAGE
#undef PG8_LDA
#undef PG8_LDB
#undef PG8_MMA
#undef PG8_WAIT_V
#undef PG8_WAIT_L
#undef PG8_BAR
#undef PG8_SCHED
}
}

#define GAS __attribute__((address_space(1)))
#define LAS __attribute__((address_space(3)))
typedef unsigned short bf16;
typedef unsigned v4u __attribute__((ext_vector_type(4)));
typedef unsigned v2u __attribute__((ext_vector_type(2)));
typedef float f32x4 __attribute__((ext_vector_type(4)));
typedef short bf16x8 __attribute__((ext_vector_type(8)));
typedef GAS unsigned gu32;
typedef GAS unsigned long long gu64;
#define RLX_AGENT __ATOMIC_RELAXED, __HIP_MEMORY_SCOPE_AGENT
#define LDS_WAIT() asm volatile("s_waitcnt lgkmcnt(0)" ::: "memory")
#define VM_WAIT() asm volatile("s_waitcnt vmcnt(0)" ::: "memory")
__device__ __forceinline__ unsigned long long rt() { return __builtin_amdgcn_s_memrealtime(); }
__device__ __forceinline__ unsigned f2bf(float f) { unsigned u = __builtin_bit_cast(unsigned, f); return (u + 0x7fffu + ((u >> 16) & 1u)) >> 16; }
__device__ __forceinline__ unsigned pk2(float lo, float hi) { return f2bf(lo) | (f2bf(hi) << 16); }

#define XB_TMO      128
#define XB_XCNT(j)  (256  + 64 * (j))
#define XB_XSUB(j)  (1280 + 64 * (j))
#define XB_XGEN(j)  (2304 + 64 * (j))
#define XB_TOP      3328
#define XB_TOPGEN   3392
#define XCD_BAR_WORDS 3456
#define XB_SPIN_CAP (1u << 18)

__device__ __forceinline__ unsigned xb_ld(unsigned* p)              { return __hip_atomic_load(p, __ATOMIC_RELAXED, __HIP_MEMORY_SCOPE_AGENT); }
__device__ __forceinline__ unsigned xb_add(unsigned* p, unsigned v) { return __hip_atomic_fetch_add(p, v, __ATOMIC_RELAXED, __HIP_MEMORY_SCOPE_AGENT); }
__device__ __forceinline__ unsigned xb_xcc_id() { return (unsigned)__builtin_amdgcn_s_getreg((3 << 11) | 20) & 0xFu; }
#define XB_SPIN(cond, bar) do { unsigned _sp = 0; while (cond) { __builtin_amdgcn_s_sleep(1); \
    if ((++_sp & 255u) == 0u) { if (xb_ld(&(bar)[XB_TMO])) break; if (_sp > XB_SPIN_CAP) { atomicAdd(&(bar)[XB_TMO], 1u); break; } } } } while (0)

struct XcdBarrier {
    unsigned* bar; unsigned x;
    volatile LAS unsigned* st;
};

__device__ __forceinline__ XcdBarrier xcd_barrier_post(unsigned* bar, volatile LAS unsigned* st) {
    XcdBarrier b; b.bar = bar; b.x = xb_xcc_id(); b.st = st;
    if (threadIdx.x == 0) (void)xb_add(&bar[XB_XCNT(b.x)], 1u);
    return b;
}
__device__ __forceinline__ void xcd_barrier_complete(unsigned* bar, unsigned x, unsigned& nloc, unsigned& nx) {
    const unsigned G = gridDim.x * gridDim.y * gridDim.z;
    unsigned sum, cnt, mine, sp = 0u;
    for (;;) {
        sum = 0u; cnt = 0u; mine = 0u;
#pragma unroll
        for (unsigned j = 0; j < 16; ++j) { const unsigned c = xb_ld(&bar[XB_XCNT(j)]); sum += c; cnt += (c > 0u) ? 1u : 0u; mine = (j == x) ? c : mine; }
        if (sum == G) break;
        __builtin_amdgcn_s_sleep(1);
        if ((++sp & 255u) == 0u) { if (xb_ld(&bar[XB_TMO])) break; if (sp > XB_SPIN_CAP) { atomicAdd(&bar[XB_TMO], 1u); break; } }
    }
    nloc = mine > 0u ? mine : 1u; nx = cnt > 0u ? cnt : 1u;
}

__device__ __forceinline__ void xcd_barrier(const XcdBarrier& b, bool is_t0) {
    asm volatile("s_waitcnt vmcnt(0)" ::: "memory");
    __syncthreads();
    if (is_t0) {
        unsigned* bar = b.bar;
        __builtin_amdgcn_s_waitcnt(0);
        unsigned nloc = b.st[0], nx = b.st[1];
        if (nloc == 0u) { xcd_barrier_complete(bar, b.x, nloc, nx); b.st[0] = nloc; b.st[1] = nx; }
        const unsigned old = xb_add(&bar[XB_XSUB(b.x)], 1u);
        const unsigned gen = old / nloc;
        if (old + 1u == (gen + 1u) * nloc) {
            __builtin_amdgcn_fence(__ATOMIC_RELEASE, "agent");
            asm volatile("s_waitcnt vmcnt(0)" ::: "memory");
            const unsigned og = xb_add(&bar[XB_TOP], 1u);
            const unsigned tg = og / nx;
            if (og + 1u == (tg + 1u) * nx) xb_add(&bar[XB_TOPGEN], 1u);
            else XB_SPIN(xb_ld(&bar[XB_TOPGEN]) == tg, bar);
            __builtin_amdgcn_fence(__ATOMIC_ACQUIRE, "agent");
            xb_add(&bar[XB_XGEN(b.x)], 1u);
            asm volatile("s_waitcnt vmcnt(0)" ::: "memory");
        } else {
            XB_SPIN(xb_ld(&bar[XB_XGEN(b.x)]) == gen, bar);
            __builtin_amdgcn_fence(__ATOMIC_ACQUIRE, "agent");
            asm volatile("s_waitcnt vmcnt(0)" ::: "memory");
        }
    }
    __syncthreads();
}


constexpr int NB = 16, T = 4096, D = 1024, DEPTH = 4, M = NB * T;
constexpr int HD = 64, H_HGRN = 6, H_FOX = 6, H_RET = 4;
constexpr int IN_COLS = 4102, NP = 4096, D_FF = 2816, NUP = 2 * D_FF;
constexpr float EPS = 1e-6f;
constexpr int OC_AQ = 0, OC_AF = 384, OC_AI = 768, OC_AG = 1152, OC_BQ = 1536, OC_BK = 1920, OC_BV = 2304, OC_BF = 2688, OC_BG = 2694, OC_CQ = 3078, OC_CK = 3334, OC_CV = 3590, OC_CG = 3846;
constexpr int PC_AQ = 0, PC_BQ = 384, PC_CQ = 768, PC_AF = 1024, PC_AI = 1408, PC_AG = 1792, PC_BK = 2176, PC_BV = 2560, PC_BG = 2944, PC_CK = 3328, PC_CV = 3584, PC_CG = 3840;
#define CB(pc) ((size_t)((pc) >> 6) * (size_t)M * 64)
__device__ __forceinline__ int pcol_to_orig(int n) {
    if (n < 384) return OC_AQ + n; if (n < 768) return OC_BQ + (n - 384); if (n < 1024) return OC_CQ + (n - 768);
    if (n < 1408) return OC_AF + (n - 1024); if (n < 1792) return OC_AI + (n - 1408); if (n < 2176) return OC_AG + (n - 1792);
    if (n < 2560) return OC_BK + (n - 2176); if (n < 2944) return OC_BV + (n - 2560); if (n < 3328) return OC_BG + (n - 2944);
    if (n < 3584) return OC_CK + (n - 3328); if (n < 3840) return OC_CV + (n - 3584); return OC_CG + (n - 3840);
}
constexpr size_t MiB = 1u << 20;
constexpr size_t WS_CTL = 0, CTL_ZERO_BYTES = 1 * MiB;
constexpr size_t WS_WIN = 2 * MiB, WS_WOUT = 34 * MiB, WS_WUP = 42 * MiB, WS_WDN = 86 * MiB;
constexpr size_t WS_WF = 108 * MiB;
constexpr size_t WS_COS = 109 * MiB, WS_SIN = WS_COS + 512 * 1024;
constexpr size_t WS_LB = 110 * MiB;
constexpr size_t WS_LOGF = 111 * MiB;
constexpr size_t WS_FCUM = 113 * MiB;
constexpr size_t WS_H = 116 * MiB;
constexpr size_t WS_MIX = 244 * MiB;
constexpr size_t WS_P = 372 * MiB;
constexpr size_t WS_ACT = WS_P;
constexpr size_t WS_EDGEL = WS_P + 352 * MiB, WS_EDGEP = WS_P + 364 * MiB;
constexpr size_t WS_SLOT1 = WS_MIX, WS_SLOT2 = WS_MIX + 1 * MiB, WS_LPART = WS_MIX + 2 * MiB;
constexpr size_t WS_XB = 884 * MiB;
constexpr size_t WS_RS = 114 * MiB + 512 * 1024;
constexpr size_t WS_END = 1012 * MiB;
constexpr int CW_BAR = 4096, CW_QUEUE = 16384, CW_FLAGS = 20480, CW_CNT = 65536;
constexpr int RING_BYTES = 131072, LDSCTL_OFF = RING_BYTES, MISC_OFF = LDSCTL_OFF + 320, HALO_OFF = RING_BYTES + 1024, GAIN_OFF = RING_BYTES + 10240, LGL_OFF = RING_BYTES + 6400, LDS_BYTES = 163840;
constexpr int NWAVES = 8;

__device__ __forceinline__ float wave_sum(float v, int lane) {
    (void)lane;
    v += dppf<0xB1>(v); v += dppf<0x4E>(v); v += dppf<0x141>(v); v += dppf<0x140>(v);
    { auto r = __builtin_amdgcn_permlane16_swap(__float_as_uint(v), __float_as_uint(v), false, false); v = __uint_as_float(r[0]) + __uint_as_float(r[1]); }
    { auto r = __builtin_amdgcn_permlane32_swap(__float_as_uint(v), __float_as_uint(v), false, false); v = __uint_as_float(r[0]) + __uint_as_float(r[1]); }
    return v;
}
__device__ __forceinline__ float bf_lo(unsigned w) { return __uint_as_float(w << 16); }
__device__ __forceinline__ float bf_hi(unsigned w) { return __uint_as_float(w & 0xffff0000u); }
__device__ __forceinline__ float bf1(bf16 w) { return __uint_as_float(((unsigned)w) << 16); }

__device__ __forceinline__ void tr_item(const float* W, int ldw, int src_col0, int k0, bf16* WT, int ldt, int dst_row0_, LAS float* scr, int lane, const float* gk = nullptr, bool ilv = false, bool wperm = false) {
    const int dst_row0 = wperm ? ((dst_row0_ & ~255) | (((dst_row0_ >> 5) & 1) << 7) | (((dst_row0_ >> 6) & 3) << 5)) : dst_row0_;
    const int j_ = lane & 31, scol = src_col0 + (ilv ? ((j_ & 1) ? (j_ >> 1) + 32 : (j_ >> 1)) : j_);
    float wv[32];
#pragma unroll
    for (int i = 0; i < 32; ++i) { const int kk = 2 * i + (lane >> 5); wv[i] = W[(size_t)(k0 + kk) * ldw + scol]; }
    asm volatile("" ::: "memory");
#pragma unroll
    for (int i = 0; i < 32; ++i) { const int kk = 2 * i + (lane >> 5); scr[kk * 33 + (lane & 31)] = wv[i] * (gk ? gk[k0 + kk] : 1.0f); }
    LDS_WAIT(); asm volatile("" ::: "memory");
    const int c = lane & 7;
#pragma unroll
    for (int j = 0; j < 4; ++j) { const int n = (lane >> 3) + 8 * j; const LAS float* s = scr + (8 * c) * 33 + n;
        v4u o; o.x = pk2(s[0 * 33], s[1 * 33]); o.y = pk2(s[2 * 33], s[3 * 33]); o.z = pk2(s[4 * 33], s[5 * 33]); o.w = pk2(s[6 * 33], s[7 * 33]);
        *(GAS v4u*)(WT + ((size_t)(k0 >> 6) * ldt + dst_row0 + n) * 64 + 8 * c) = o; }
    LDS_WAIT(); asm volatile("" ::: "memory");
}

struct TrP { const float* W; int ldw, scol0, k0; bf16* WT; int ldt, drow; const float* gk; bool ilv, wperm; };
__device__ __forceinline__ void tr_load(float (&wv)[32], f32x4 (&g8)[2], const TrP& p, int lane) {
    const int j_ = lane & 31, scol = p.scol0 + (p.ilv ? ((j_ & 1) ? (j_ >> 1) + 32 : (j_ >> 1)) : j_);
#pragma unroll
    for (int i = 0; i < 32; ++i) { const int kk = 2 * i + (lane >> 5); wv[i] = p.W[(size_t)(p.k0 + kk) * p.ldw + scol]; }
    g8[0] = (f32x4){1.f, 1.f, 1.f, 1.f}; g8[1] = g8[0];
    if (p.gk) { g8[0] = *(const f32x4*)(p.gk + p.k0 + 8 * (lane & 7)); g8[1] = *(const f32x4*)(p.gk + p.k0 + 8 * (lane & 7) + 4); }
}
__device__ __forceinline__ void tr_finish(const float (&wv)[32], const f32x4 (&g8)[2], const TrP& p, LAS float* scr, int lane) {
    const int dst_row0 = p.wperm ? ((p.drow & ~255) | (((p.drow >> 5) & 1) << 7) | (((p.drow >> 6) & 3) << 5)) : p.drow;
#pragma unroll
    for (int i = 0; i < 32; ++i) { const int kk = 2 * i + (lane >> 5); scr[kk * 33 + (lane & 31)] = wv[i]; }
    LDS_WAIT(); asm volatile("" ::: "memory");
    const int c = lane & 7;
#pragma unroll
    for (int j = 0; j < 4; ++j) { const int n = (lane >> 3) + 8 * j; const LAS float* s_ = scr + (8 * c) * 33 + n;
        v4u o; o.x = pk2(s_[0 * 33] * g8[0][0], s_[1 * 33] * g8[0][1]); o.y = pk2(s_[2 * 33] * g8[0][2], s_[3 * 33] * g8[0][3]); o.z = pk2(s_[4 * 33] * g8[1][0], s_[5 * 33] * g8[1][1]); o.w = pk2(s_[6 * 33] * g8[1][2], s_[7 * 33] * g8[1][3]);
        *(GAS v4u*)(p.WT + ((size_t)(p.k0 >> 6) * p.ldt + dst_row0 + n) * 64 + 8 * c) = o; }
    LDS_WAIT(); asm volatile("" ::: "memory");
}

__device__ __forceinline__ float log_sigmoid_f(float v) { return fminf(v, 0.f) - 0.6931471805599453f * __builtin_amdgcn_logf(1.0f + __builtin_amdgcn_exp2f(-fabsf(v) * 1.4426950408889634f)); }

template <int R> __device__ __forceinline__ void row_updateNx(int lane, size_t m, size_t dm, const float* xf_base, const bf16* xb_base, const bf16* add_base, const float* gpost,
                                             bf16* xb_obase, float* xf_obase, float* rs_base, const float* wf, const float* bfox, float* logf_base, const f32x4 (*pre)[4] = nullptr) {
    const float bfl = wf ? bfox[lane < 6 ? lane : 0] : 0.f;
    f32x4 v[R][4];
#pragma unroll
    for (int r = 0; r < R; ++r) { const size_t row = m + r * dm;
        if (pre) {
#pragma unroll
            for (int j = 0; j < 4; ++j) v[r][j] = pre[r][j];
        } else if (xf_base) {
#pragma unroll
            for (int j = 0; j < 4; ++j) v[r][j] = *(const f32x4*)(xf_base + row * D + 4 * lane + 256 * j);
        } else {
#pragma unroll
            for (int j = 0; j < 4; ++j) { const uint2 w = *(const uint2*)(xb_base + row * D + 4 * lane + 256 * j); v[r][j] = (f32x4){bf_lo(w.x), bf_hi(w.x), bf_lo(w.y), bf_hi(w.y)}; }
        } }
    if (add_base) {
        f32x4 a[R][4]; float ss[R];
#pragma unroll
        for (int r = 0; r < R; ++r) ss[r] = 0.f;
#pragma unroll
        for (int r = 0; r < R; ++r)
#pragma unroll
            for (int j = 0; j < 4; ++j) { const uint2 w = *(const uint2*)(add_base + (m + r * dm) * D + 4 * lane + 256 * j); a[r][j] = (f32x4){bf_lo(w.x), bf_hi(w.x), bf_lo(w.y), bf_hi(w.y)};
                ss[r] += (a[r][j].x * a[r][j].x + a[r][j].y * a[r][j].y) + (a[r][j].z * a[r][j].z + a[r][j].w * a[r][j].w); }
        f32x4 g[4];
#pragma unroll
        for (int j = 0; j < 4; ++j) g[j] = *(const f32x4*)(gpost + 4 * lane + 256 * j);
#pragma unroll
        for (int r = 0; r < R; ++r) { const float rs = 1.0f / sqrtf(wave_sum(ss[r], lane) * (1.f / D) + EPS);
#pragma unroll
            for (int j = 0; j < 4; ++j) v[r][j] = v[r][j] + a[r][j] * rs * g[j]; }
    }
#pragma unroll
    for (int r = 0; r < R; ++r) { const size_t row = m + r * dm;
        if (xf_obase) {
#pragma unroll
            for (int j = 0; j < 4; ++j) *(f32x4*)(xf_obase + row * D + 4 * lane + 256 * j) = v[r][j];
        }
        if (xb_obase) {
#pragma unroll
            for (int j = 0; j < 4; ++j) { uint2 w; w.x = pk2(v[r][j].x, v[r][j].y); w.y = pk2(v[r][j].z, v[r][j].w); *(uint2*)(xb_obase + ((size_t)(4 * j + (lane >> 4)) * M + row) * 64 + ((4 * lane) & 63)) = w; }
        } }
    if (rs_base) {
        float rs[R];
#pragma unroll
        for (int r = 0; r < R; ++r) { float ss = 0.f;
#pragma unroll
            for (int j = 0; j < 4; ++j) ss += (v[r][j].x * v[r][j].x + v[r][j].y * v[r][j].y) + (v[r][j].z * v[r][j].z + v[r][j].w * v[r][j].w);
            const float sst = wave_sum(ss, lane); rs[r] = 1.0f / sqrtf(sst * (1.f / D) + EPS);
            if (lane == 0) *(f32x4*)(rs_base + 4 * (m + r * dm)) = (f32x4){sst, 0.f, 0.f, 0.f}; }
        if (wf) {
            float mine[R];
#pragma unroll
            for (int r = 0; r < R; ++r) mine[r] = 0.f;
#pragma unroll
            for (int jj = 0; jj < 6; ++jj) { f32x4 w[4];
#pragma unroll
                for (int j = 0; j < 4; ++j) w[j] = *(const f32x4*)(wf + jj * 1024 + 4 * lane + 256 * j);
#pragma unroll
                for (int r = 0; r < R; ++r) { float d = 0.f;
#pragma unroll
                    for (int j = 0; j < 4; ++j) d += (v[r][j].x * w[j].x + v[r][j].y * w[j].y) + (v[r][j].z * w[j].z + v[r][j].w * w[j].w);
                    d = wave_sum(d, lane); if (lane == jj) mine[r] = d; } }
            if (lane < 6) {
#pragma unroll
                for (int r = 0; r < R; ++r) logf_base[(m + r * dm) * 8 + lane] = log_sigmoid_f(mine[r] * rs[r] + bfl); }
        }
    }
}


template <int R> __device__ __forceinline__ void row_pass_pf(int lane, int gw, int NGW, bf16* XB, const bf16* MIXp, const float* gpost, bool write_xb, float* xf_obase, float* rs_base,
                                                             const float* wf, const float* bfox, float* logf_base) {
    uint2 xr[R][4], ar[R][4];
    const size_t step = (size_t)R * NGW; size_t m = (size_t)R * gw;
#pragma unroll
    for (int r = 0; r < R; ++r)
#pragma unroll
        for (int j = 0; j < 4; ++j) { xr[r][j] = *(const uint2*)(XB + (m + r) * D + 4 * lane + 256 * j); ar[r][j] = *(const uint2*)(MIXp + (m + r) * D + 4 * lane + 256 * j); }
    f32x4 g[4];
#pragma unroll
    for (int j = 0; j < 4; ++j) g[j] = *(const f32x4*)(gpost + 4 * lane + 256 * j);
    for (; m < (size_t)M; m += step) {
        f32x4 v[R][4], a[R][4]; float ss[R];
#pragma unroll
        for (int r = 0; r < R; ++r) { ss[r] = 0.f;
#pragma unroll
            for (int j = 0; j < 4; ++j) { v[r][j] = (f32x4){bf_lo(xr[r][j].x), bf_hi(xr[r][j].x), bf_lo(xr[r][j].y), bf_hi(xr[r][j].y)}; a[r][j] = (f32x4){bf_lo(ar[r][j].x), bf_hi(ar[r][j].x), bf_lo(ar[r][j].y), bf_hi(ar[r][j].y)};
                ss[r] += (a[r][j].x * a[r][j].x + a[r][j].y * a[r][j].y) + (a[r][j].z * a[r][j].z + a[r][j].w * a[r][j].w); } }
        const size_t mn = m + step;
        if (mn < (size_t)M) {
#pragma unroll
            for (int r = 0; r < R; ++r)
#pragma unroll
                for (int j = 0; j < 4; ++j) { xr[r][j] = *(const uint2*)(XB + (mn + r) * D + 4 * lane + 256 * j); ar[r][j] = *(const uint2*)(MIXp + (mn + r) * D + 4 * lane + 256 * j); } }
        asm volatile("" ::: "memory");
        float rs2[R], s2t[R];
#pragma unroll
        for (int r = 0; r < R; ++r) { const float rs = 1.0f / sqrtf(wave_sum(ss[r], lane) * (1.f / D) + EPS); float s2 = 0.f;
#pragma unroll
            for (int j = 0; j < 4; ++j) { v[r][j] = v[r][j] + a[r][j] * rs * g[j]; s2 += (v[r][j].x * v[r][j].x + v[r][j].y * v[r][j].y) + (v[r][j].z * v[r][j].z + v[r][j].w * v[r][j].w); }
            s2t[r] = wave_sum(s2, lane); rs2[r] = 1.0f / sqrtf(s2t[r] * (1.f / D) + EPS); }
#pragma unroll
        for (int r = 0; r < R; ++r) {
            if (write_xb) {
#pragma unroll
                for (int j = 0; j < 4; ++j) { uint2 w; w.x = pk2(v[r][j].x, v[r][j].y); w.y = pk2(v[r][j].z, v[r][j].w); *(uint2*)(XB + (m + r) * D + 4 * lane + 256 * j) = w; }
            } else {
#pragma unroll
                for (int j = 0; j < 4; ++j) *(f32x4*)(xf_obase + (m + r) * D + 4 * lane + 256 * j) = v[r][j];
            }
            if (rs_base && lane == 0) *(f32x4*)(rs_base + 4 * (m + r)) = (f32x4){s2t[r], 0.f, 0.f, 0.f}; }
        if (wf) {
            float mine[R];
#pragma unroll
            for (int r = 0; r < R; ++r) mine[r] = 0.f;
#pragma unroll
            for (int jj = 0; jj < 6; ++jj) { f32x4 w[4];
#pragma unroll
                for (int j = 0; j < 4; ++j) w[j] = *(const f32x4*)(wf + jj * 1024 + 4 * lane + 256 * j);
#pragma unroll
                for (int r = 0; r < R; ++r) { float d = 0.f;
#pragma unroll
                    for (int j = 0; j < 4; ++j) d += (v[r][j].x * w[j].x + v[r][j].y * w[j].y) + (v[r][j].z * w[j].z + v[r][j].w * w[j].w);
                    d = wave_sum(d, lane); if (lane == jj) mine[r] = d; } }
            if (lane < 6) {
#pragma unroll
                for (int r = 0; r < R; ++r) logf_base[(m + r) * 8 + lane] = log_sigmoid_f(mine[r] * rs2[r] + bfox[lane]); }
        }
    }
}

namespace pg8 {
__device__ __forceinline__ float fq_sum(float v) {
    { auto r = __builtin_amdgcn_permlane16_swap(__float_as_uint(v), __float_as_uint(v), false, false); v = __uint_as_float(r[0]) + __uint_as_float(r[1]); }
    { auto r = __builtin_amdgcn_permlane32_swap(__float_as_uint(v), __float_as_uint(v), false, false); v = __uint_as_float(r[0]) + __uint_as_float(r[1]); }
    return v; }
struct EpiNormRes {
    static constexpr bool PERM = true, AFTER_DRAIN = false, PREFETCH = false;
    bf16_t* XB; const PG8_LAS float* gl; float* SLOT1; unsigned* CNT1; float* RS; PG8_LAS float* red;
    __device__ __forceinline__ void operator()(f32x4 (&acc)[2][2][4][2], const Unit& u, int wr, int wc, int fr, int fq) const {
        { const int l_ = fresh_lane(); fr = l_ & 15; fq = l_ >> 4; }
        const int tid = (wr * 4 + wc) * 64 + fq * 16 + fr, rl0 = wr * 64 + fr;
        PG8_LAS float* rowfac = red + 1024; volatile PG8_LAS unsigned* bc = (volatile PG8_LAS unsigned*)(red + 1280);
        const int col0 = u.pn * BM + wc * 64 + 8 * fq;
#pragma unroll
        for (int ai = 0; ai < 2; ++ai)
#pragma unroll
            for (int m = 0; m < 4; ++m) { float s = 0.f;
#pragma unroll
                for (int bj = 0; bj < 2; ++bj)
#pragma unroll
                    for (int n = 0; n < 2; ++n) { const f32x4 a = acc[ai][bj][m][n]; s += (a[0] * a[0] + a[1] * a[1]) + (a[2] * a[2] + a[3] * a[3]); }
                s = fq_sum(s); if (fq == 0) red[(rl0 + ai * HALF + m * 16) * 4 + wc] = s; }
        asm volatile("s_waitcnt lgkmcnt(0)" ::: "memory"); __builtin_amdgcn_s_barrier(); asm volatile("" ::: "memory");
        if (tid < 256) { const f32x4 q = *(const PG8_LAS f32x4*)(red + 4 * tid); __hip_atomic_store(SLOT1 + (size_t)(u.pm * 4 + u.pn) * 256 + tid, (q[0] + q[1]) + (q[2] + q[3]), __ATOMIC_RELAXED, __HIP_MEMORY_SCOPE_AGENT); }
        asm volatile("s_waitcnt vmcnt(0)" ::: "memory"); __builtin_amdgcn_s_barrier(); asm volatile("" ::: "memory");
        u32x4 xw[2][4][2];
#pragma unroll
        for (int ai = 0; ai < 2; ++ai)
#pragma unroll
            for (int m = 0; m < 4; ++m)
#pragma unroll
                for (int bj = 0; bj < 2; ++bj) xw[ai][m][bj] = *(const u32x4*)(XB + ((size_t)(col0 >> 6) * M + (u.pm * BM + rl0 + ai * HALF + m * 16)) * 64 + (col0 & 63) + 32 * bj);
        if (tid == 0) { unsigned* c = CNT1 + u.pm * 16; __hip_atomic_fetch_add(c, 1u, __ATOMIC_RELAXED, __HIP_MEMORY_SCOPE_AGENT); unsigned sp = 0u;
            while (__hip_atomic_load(c, __ATOMIC_RELAXED, __HIP_MEMORY_SCOPE_AGENT) < 4u) { __builtin_amdgcn_s_sleep(1); if (++sp > (1u << 22)) break; }
            __builtin_amdgcn_fence(__ATOMIC_ACQUIRE, "agent"); asm volatile("s_waitcnt vmcnt(0)" ::: "memory"); }
        __builtin_amdgcn_s_barrier(); asm volatile("" ::: "memory");
        if (tid < 256) { float tot = 0.f;
#pragma unroll
            for (int q = 0; q < 4; ++q) tot += SLOT1[(size_t)(u.pm * 4 + q) * 256 + tid];
            rowfac[tid] = __builtin_amdgcn_rsqf(tot * (1.f / 1024.f) + 1e-6f); }
        asm volatile("s_waitcnt lgkmcnt(0)" ::: "memory"); __builtin_amdgcn_s_barrier(); asm volatile("" ::: "memory");
#pragma unroll
        for (int ai = 0; ai < 2; ++ai)
#pragma unroll
            for (int m = 0; m < 4; ++m) { const int rl = rl0 + ai * HALF + m * 16; const float ry = rowfac[rl]; float s2 = 0.f;
#pragma unroll
                for (int bj = 0; bj < 2; ++bj) { const u32x4 xo = xw[ai][m][bj];
                    const PG8_LAS float* gp = gl + col0 + bj * 32;
                    f32x4 v0 = acc[ai][bj][m][0] * ry * *(const PG8_LAS f32x4*)gp, v1 = acc[ai][bj][m][1] * ry * *(const PG8_LAS f32x4*)(gp + 4);
                    v0[0] += __uint_as_float(xo.x << 16); v0[1] += __uint_as_float(xo.x & 0xffff0000u); v0[2] += __uint_as_float(xo.y << 16); v0[3] += __uint_as_float(xo.y & 0xffff0000u);
                    v1[0] += __uint_as_float(xo.z << 16); v1[1] += __uint_as_float(xo.z & 0xffff0000u); v1[2] += __uint_as_float(xo.w << 16); v1[3] += __uint_as_float(xo.w & 0xffff0000u);
                    s2 += ((v0[0] * v0[0] + v0[1] * v0[1]) + (v0[2] * v0[2] + v0[3] * v0[3])) + ((v1[0] * v1[0] + v1[1] * v1[1]) + (v1[2] * v1[2] + v1[3] * v1[3]));
                    acc[ai][bj][m][0] = v0; acc[ai][bj][m][1] = v1; }
                s2 = fq_sum(s2); if (fq == 0) red[rl * 4 + wc] = s2; }
        asm volatile("s_waitcnt lgkmcnt(0)" ::: "memory"); __builtin_amdgcn_s_barrier(); asm volatile("" ::: "memory");
        if (tid < 256) { const f32x4 q = *(const PG8_LAS f32x4*)(red + 4 * tid); RS[(size_t)(u.pm * BM + tid) * 4 + u.pn] = (q[0] + q[1]) + (q[2] + q[3]); }
#pragma unroll
        for (int ai = 0; ai < 2; ++ai)
#pragma unroll
            for (int m = 0; m < 4; ++m) { bf16_t* rowp = XB + ((size_t)(col0 >> 6) * M + (u.pm * BM + rl0 + ai * HALF + m * 16)) * 64 + (col0 & 63);
#pragma unroll
                for (int bj = 0; bj < 2; ++bj) { const f32x4 v0 = acc[ai][bj][m][0], v1 = acc[ai][bj][m][1];
                    u32x4 w; w.x = cvt_pk_bf16_v(v0[0], v0[1]); w.y = cvt_pk_bf16_v(v0[2], v0[3]); w.z = cvt_pk_bf16_v(v1[0], v1[1]); w.w = cvt_pk_bf16_v(v1[2], v1[3]);
                    *(u32x4*)(rowp + bj * 32) = w; } }
    }
};
struct EpiNormResFFN {
    static constexpr bool PERM = true, AFTER_DRAIN = false, PREFETCH = false;
    bf16_t* XB; const float* gain; float* SLOT1; unsigned* CNT1; float* RS; PG8_LAS float* red; float* XF; const float* WF; const float* bias; float* LPART; unsigned* CNT2; float* LOGF; PG8_LAS float* lgl;
    __device__ __forceinline__ void operator()(f32x4 (&acc)[2][2][4][2], const Unit& u, int wr, int wc, int fr, int fq) const {
        { const int l_ = fresh_lane(); fr = l_ & 15; fq = l_ >> 4; }
        const int tid = (wr * 4 + wc) * 64 + fq * 16 + fr, rl0 = wr * 64 + fr;
        PG8_LAS float* rowfac = red + 1024; volatile PG8_LAS unsigned* bc = (volatile PG8_LAS unsigned*)(red + 1280);
        const int col0 = u.pn * BM + wc * 64 + 8 * fq;
        lgl[tid] = gain[tid]; lgl[tid + 512] = gain[tid + 512];
#pragma unroll
        for (int ai = 0; ai < 2; ++ai)
#pragma unroll
            for (int m = 0; m < 4; ++m) { float s = 0.f;
#pragma unroll
                for (int bj = 0; bj < 2; ++bj)
#pragma unroll
                    for (int n = 0; n < 2; ++n) { const f32x4 a = acc[ai][bj][m][n]; s += (a[0] * a[0] + a[1] * a[1]) + (a[2] * a[2] + a[3] * a[3]); }
                s = fq_sum(s); if (fq == 0) red[(rl0 + ai * HALF + m * 16) * 4 + wc] = s; }
        asm volatile("s_waitcnt lgkmcnt(0)" ::: "memory"); __builtin_amdgcn_s_barrier(); asm volatile("" ::: "memory");
        if (tid < 256) { const f32x4 q = *(const PG8_LAS f32x4*)(red + 4 * tid); __hip_atomic_store(SLOT1 + (size_t)(u.pm * 4 + u.pn) * 256 + tid, (q[0] + q[1]) + (q[2] + q[3]), __ATOMIC_RELAXED, __HIP_MEMORY_SCOPE_AGENT); }
        asm volatile("s_waitcnt vmcnt(0)" ::: "memory"); __builtin_amdgcn_s_barrier(); asm volatile("" ::: "memory");
        u32x4 xw[2][4][2];
#pragma unroll
        for (int ai = 0; ai < 2; ++ai)
#pragma unroll
            for (int m = 0; m < 4; ++m)
#pragma unroll
                for (int bj = 0; bj < 2; ++bj) xw[ai][m][bj] = *(const u32x4*)(XB + ((size_t)(col0 >> 6) * M + (u.pm * BM + rl0 + ai * HALF + m * 16)) * 64 + (col0 & 63) + 32 * bj);
        if (tid == 0) { unsigned* c = CNT1 + u.pm * 16; __hip_atomic_fetch_add(c, 1u, __ATOMIC_RELAXED, __HIP_MEMORY_SCOPE_AGENT); unsigned sp = 0u;
            while (__hip_atomic_load(c, __ATOMIC_RELAXED, __HIP_MEMORY_SCOPE_AGENT) < 4u) { __builtin_amdgcn_s_sleep(1); if (++sp > (1u << 22)) break; }
            __builtin_amdgcn_fence(__ATOMIC_ACQUIRE, "agent"); asm volatile("s_waitcnt vmcnt(0)" ::: "memory"); }
        __builtin_amdgcn_s_barrier(); asm volatile("" ::: "memory");
        if (tid < 256) { float tot = 0.f;
#pragma unroll
            for (int q = 0; q < 4; ++q) tot += SLOT1[(size_t)(u.pm * 4 + q) * 256 + tid];
            rowfac[tid] = __builtin_amdgcn_rsqf(tot * (1.f / 1024.f) + 1e-6f); }
        asm volatile("s_waitcnt lgkmcnt(0)" ::: "memory"); __builtin_amdgcn_s_barrier(); asm volatile("" ::: "memory");
#pragma unroll
        for (int ai = 0; ai < 2; ++ai)
#pragma unroll
            for (int m = 0; m < 4; ++m) { const int rl = rl0 + ai * HALF + m * 16; const float ry = rowfac[rl]; float s2 = 0.f;
#pragma unroll
                for (int bj = 0; bj < 2; ++bj) { const u32x4 xo = xw[ai][m][bj];
                    const PG8_LAS float* gp = lgl + col0 + bj * 32;
                    f32x4 v0 = acc[ai][bj][m][0] * ry * *(const PG8_LAS f32x4*)gp, v1 = acc[ai][bj][m][1] * ry * *(const PG8_LAS f32x4*)(gp + 4);
                    v0[0] += __uint_as_float(xo.x << 16); v0[1] += __uint_as_float(xo.x & 0xffff0000u); v0[2] += __uint_as_float(xo.y << 16); v0[3] += __uint_as_float(xo.y & 0xffff0000u);
                    v1[0] += __uint_as_float(xo.z << 16); v1[1] += __uint_as_float(xo.z & 0xffff0000u); v1[2] += __uint_as_float(xo.w << 16); v1[3] += __uint_as_float(xo.w & 0xffff0000u);
                    s2 += ((v0[0] * v0[0] + v0[1] * v0[1]) + (v0[2] * v0[2] + v0[3] * v0[3])) + ((v1[0] * v1[0] + v1[1] * v1[1]) + (v1[2] * v1[2] + v1[3] * v1[3]));
                    acc[ai][bj][m][0] = v0; acc[ai][bj][m][1] = v1; }
                if (!XF) { s2 = fq_sum(s2); if (fq == 0) red[rl * 4 + wc] = s2; } }
        if (XF) {
            int rl0b = rl0, col0b = col0; asm volatile("" : "+v"(rl0b), "+v"(col0b));
#pragma unroll
            for (int ai = 0; ai < 2; ++ai)
#pragma unroll
                for (int m = 0; m < 4; ++m) { float* rowp = XF + (size_t)(u.pm * BM + rl0b + ai * HALF + m * 16) * 1024 + col0b;
#pragma unroll
                    for (int bj = 0; bj < 2; ++bj) { *(f32x4*)(rowp + bj * 32) = acc[ai][bj][m][0]; *(f32x4*)(rowp + bj * 32 + 4) = acc[ai][bj][m][1]; } }
            return; }
        f32x4 wfc[2][2], wfn[2][2];
#pragma unroll
        for (int bj = 0; bj < 2; ++bj)
#pragma unroll
            for (int n = 0; n < 2; ++n) wfc[bj][n] = *(const f32x4*)(WF + col0 + bj * 32 + 4 * n);
        asm volatile("s_waitcnt lgkmcnt(0)" ::: "memory"); __builtin_amdgcn_s_barrier(); asm volatile("" ::: "memory");
#pragma unroll
        for (int j = 0; j < 6; ++j) {
            if (j < 5) {
#pragma unroll
                for (int bj = 0; bj < 2; ++bj)
#pragma unroll
                    for (int n = 0; n < 2; ++n) wfn[bj][n] = *(const f32x4*)(WF + (j + 1) * 1024 + col0 + bj * 32 + 4 * n); }
#pragma unroll
            for (int ai = 0; ai < 2; ++ai)
#pragma unroll
                for (int m = 0; m < 4; ++m) { float d = 0.f;
#pragma unroll
                    for (int bj = 0; bj < 2; ++bj)
#pragma unroll
                        for (int n = 0; n < 2; ++n) { const f32x4 a = acc[ai][bj][m][n], w = wfc[bj][n]; d += (a[0] * w[0] + a[1] * w[1]) + (a[2] * w[2] + a[3] * w[3]); }
                    d = fq_sum(d); if (fq == 0) lgl[((rl0 + ai * HALF + m * 16) * 4 + wc) * 6 + j] = d; }
#pragma unroll
            for (int bj = 0; bj < 2; ++bj)
#pragma unroll
                for (int n = 0; n < 2; ++n) wfc[bj][n] = wfn[bj][n]; }
        asm volatile("s_waitcnt lgkmcnt(0)" ::: "memory"); __builtin_amdgcn_s_barrier(); asm volatile("" ::: "memory");
        if (tid < 256) { const f32x4 q = *(const PG8_LAS f32x4*)(red + 4 * tid); const float s2t = (q[0] + q[1]) + (q[2] + q[3]);
            RS[(size_t)(u.pm * BM + tid) * 4 + u.pn] = s2t;
            float* lp = LPART + ((size_t)(u.pm * 4 + u.pn) * 256 + tid) * 8; __hip_atomic_store(lp, s2t, __ATOMIC_RELAXED, __HIP_MEMORY_SCOPE_AGENT);
#pragma unroll
            for (int j = 0; j < 6; ++j) { const PG8_LAS float* lg = lgl + (tid * 4) * 6 + j; __hip_atomic_store(lp + 1 + j, (lg[0] + lg[6]) + (lg[12] + lg[18]), __ATOMIC_RELAXED, __HIP_MEMORY_SCOPE_AGENT); } }
        asm volatile("s_waitcnt vmcnt(0)" ::: "memory"); __builtin_amdgcn_s_barrier(); asm volatile("" ::: "memory");
        if (tid == 0) { const unsigned old = __hip_atomic_fetch_add(CNT2 + u.pm * 16, 1u, __ATOMIC_RELAXED, __HIP_MEMORY_SCOPE_AGENT);
            if (old == 3u) { __builtin_amdgcn_fence(__ATOMIC_ACQUIRE, "agent"); asm volatile("s_waitcnt vmcnt(0)" ::: "memory"); }
            *bc = old; }
        asm volatile("s_waitcnt lgkmcnt(0)" ::: "memory"); __builtin_amdgcn_s_barrier(); asm volatile("" ::: "memory");
        if (*bc == 3u && tid < 256) { float t7[7];
#pragma unroll
            for (int j = 0; j < 7; ++j) t7[j] = 0.f;
#pragma unroll
            for (int q = 0; q < 4; ++q) { const f32x4* lp = (const f32x4*)(LPART + ((size_t)(u.pm * 4 + q) * 256 + tid) * 8); const f32x4 p0 = lp[0], p1 = lp[1];
                t7[0] += p0[0]; t7[1] += p0[1]; t7[2] += p0[2]; t7[3] += p0[3]; t7[4] += p1[0]; t7[5] += p1[1]; t7[6] += p1[2]; }
            const float rs = __builtin_amdgcn_rsqf(t7[0] * (1.f / 1024.f) + 1e-6f);
#pragma unroll
            for (int j = 0; j < 6; ++j) LOGF[(size_t)(u.pm * BM + tid) * 8 + j] = ::log_sigmoid_f(t7[1 + j] * rs + bias[j]); }
        int rl0c = rl0, col0c = col0; asm volatile("" : "+v"(rl0c), "+v"(col0c));
#pragma unroll
        for (int ai = 0; ai < 2; ++ai)
#pragma unroll
            for (int m = 0; m < 4; ++m) { bf16_t* rowp = XB + ((size_t)(col0c >> 6) * M + (u.pm * BM + rl0c + ai * HALF + m * 16)) * 64 + (col0c & 63);
#pragma unroll
                for (int bj = 0; bj < 2; ++bj) { const f32x4 v0 = acc[ai][bj][m][0], v1 = acc[ai][bj][m][1];
                    u32x4 w; w.x = cvt_pk_bf16_v(v0[0], v0[1]); w.y = cvt_pk_bf16_v(v0[2], v0[3]); w.z = cvt_pk_bf16_v(v1[0], v1[1]); w.w = cvt_pk_bf16_v(v1[2], v1[3]);
                    *(u32x4*)(rowp + bj * 32) = w; } }
    }
};
}

typedef float f32x16 __attribute__((ext_vector_type(16)));
typedef short s16x4 __attribute__((ext_vector_type(4)));
typedef unsigned u32x4 __attribute__((ext_vector_type(4)));
typedef float f32x2_t __attribute__((ext_vector_type(2))); typedef __bf16 bf16x2_t __attribute__((ext_vector_type(2)));
__device__ __forceinline__ unsigned cvt_pk_bf16(float lo, float hi) { f32x2_t v = {lo, hi}; bf16x2_t b = __builtin_convertvector(v, bf16x2_t); return __builtin_bit_cast(unsigned, b); }
__device__ __forceinline__ int crow(int r, int hi) { return (r & 3) + 8 * (r >> 2) + 4 * hi; }
__device__ __forceinline__ s16x4 vtr(const LAS unsigned char* p) { return __builtin_bit_cast(s16x4, __builtin_amdgcn_ds_read_tr16_b64_v4i16((LAS s16x4*)p)); }
constexpr float ATT_THR = 40.0f, ATT_MOVE = 8.0f;
__device__ __forceinline__ float half_swap_max(float v) { auto r = __builtin_amdgcn_permlane32_swap(__float_as_uint(v), __float_as_uint(v), false, false); return fmaxf(__uint_as_float(r[0]), __uint_as_float(r[1])); }
__device__ __forceinline__ float half_swap_sum(float v) { auto r = __builtin_amdgcn_permlane32_swap(__float_as_uint(v), __float_as_uint(v), false, false); return __uint_as_float(r[0]) + __uint_as_float(r[1]); }
__device__ __forceinline__ void attn_v3(LAS unsigned char* lds, bf16* P, const float* FCUM, int tid, unsigned* qctr, float bound2, const float* qgain, const float* kgain) {
    constexpr int A2_KA = 0, A2_KB = 9216, A2_VA = 18432, A2_VB = 26624, A2_BUF = 34816, A2_Z = 2 * A2_BUF, A2_Q = A2_Z + 1024;
    const int wid = __builtin_amdgcn_readfirstlane(tid >> 6), tid_in = tid;
    int qsel = (int)(xb_xcc_id() & 7u), qleft = 8, par = 0;
    if (tid == 0) { unsigned v = 192u;
        while (qleft > 0) { v = __hip_atomic_fetch_add(qctr + 16 * qsel, 1u, __ATOMIC_RELAXED, __HIP_MEMORY_SCOPE_AGENT); if (v < 192u) break; qsel = (qsel + 1) & 7; --qleft; }
        *(LAS unsigned*)(lds + A2_Q) = qleft > 0 ? (unsigned)qsel * 192u + v : 0xffffffffu; }
    for (;;) {
        __syncthreads();
        const int u = (int)*(const LAS unsigned*)(lds + A2_Q + 4 * par);
        if (u < 0) break;
        int tid = tid_in; asm volatile("" : "+v"(tid));
        const int lane = tid & 63, r32 = lane & 31, hi = lane >> 5;
        const int sr = tid >> 3, sch = tid & 7;
        const int vb0 = ((lane >> 4) & 1) * 32 + (lane & 3) * 8 + (4 * hi + ((lane & 15) >> 2)) * 64;
        unsigned nv = 192u;
        if (tid == 0 && qleft > 0) nv = __hip_atomic_fetch_add(qctr + 16 * qsel, 1u, __ATOMIC_RELAXED, __HIP_MEMORY_SCOPE_AGENT);
        par ^= 1;
        {
            const int bh = u >> 4, qb = 15 - (u & 15), b = bh / 6, h = bh % 6;
            const size_t rowbase = (size_t)b * T; const int q0 = qb * 256, tq = q0 + wid * 32 + r32;
            bf16x8 qf[4];
            uint2 gwr[2][4];
            { const bf16* gp = (P + CB(PC_BG) + ((size_t)h * M + rowbase) * 64) + tq * 64;
#pragma unroll
              for (int db = 0; db < 2; ++db)
#pragma unroll
                  for (int jg = 0; jg < 4; ++jg) gwr[db][jg] = *(const uint2*)(gp + 32 * db + 8 * jg + 4 * hi); }
            { const bf16* qp = (P + CB(PC_BQ) + ((size_t)h * M + rowbase) * 64) + (tq * 64 + hi * 8);
              float qx[4][8]; float ss = 0.f;
#pragma unroll
              for (int ks = 0; ks < 4; ++ks) { const v4u w = *(const v4u*)(qp + 16 * ks);
                  qx[ks][0] = bf_lo(w.x); qx[ks][1] = bf_hi(w.x); qx[ks][2] = bf_lo(w.y); qx[ks][3] = bf_hi(w.y); qx[ks][4] = bf_lo(w.z); qx[ks][5] = bf_hi(w.z); qx[ks][6] = bf_lo(w.w); qx[ks][7] = bf_hi(w.w);
#pragma unroll
                  for (int e = 0; e < 8; ++e) ss += qx[ks][e] * qx[ks][e]; }
              ss = half_swap_sum(ss);
              const float rs = (0.125f * 1.4426950408889634f) / sqrtf(ss * (1.f / 64.f) + EPS);
#pragma unroll
              for (int ks = 0; ks < 4; ++ks) { const f32x4 g0 = *(const f32x4*)(qgain + 16 * ks + 8 * hi) * *(const f32x4*)(kgain + 16 * ks + 8 * hi), g1 = *(const f32x4*)(qgain + 16 * ks + 8 * hi + 4) * *(const f32x4*)(kgain + 16 * ks + 8 * hi + 4); float y[8];
#pragma unroll
                  for (int e = 0; e < 4; ++e) { y[e] = qx[ks][e] * rs * g0[e]; y[4 + e] = qx[ks][4 + e] * rs * g1[e]; }
                  u32x4 w; w.x = cvt_pk_bf16(y[0], y[1]); w.y = cvt_pk_bf16(y[2], y[3]); w.z = cvt_pk_bf16(y[4], y[5]); w.w = cvt_pk_bf16(y[6], y[7]); qf[ks] = __builtin_bit_cast(bf16x8, w); }
            }
            float m = 0.f, lsum = 0.f; f32x16 o0, o1;
#pragma unroll
            for (int r = 0; r < 16; ++r) { o0[r] = 0.f; o1[r] = 0.f; }
            const int NT = (q0 + 256) / 64, NS = NT / 2;
            const int kvo = sr * 64 + sch * 8; const bf16* kg = (P + CB(PC_BK) + ((size_t)h * M + rowbase) * 64) + kvo; const bf16* vg = (P + CB(PC_BV) + ((size_t)h * M + rowbase) * 64) + kvo;
            const float* fb = FCUM + (size_t)bh * T; const float* fg = fb + (tid & 127);
            const float lim = -ATT_THR - bound2 - fb[q0] * 1.4426950408889634f;
            v4u kA = *(const v4u*)(kg + (size_t)(NT - 1) * 64 * 64), vA = *(const v4u*)(vg + (size_t)(NT - 1) * 64 * 64), kB = *(const v4u*)(kg + (size_t)(NT - 2) * 64 * 64), vB = *(const v4u*)(vg + (size_t)(NT - 2) * 64 * 64);
            float freg = tid < 128 ? fg[(NT - 2) * 64] : 0.f;
#pragma unroll 1
            for (int it = 0; it < NS; ++it) {
                const int jA = NT - 1 - 2 * it, jB = jA - 1;
                { LAS unsigned char* buf = lds + (it & 1) * A2_BUF;
#pragma unroll
                  for (int tl = 0; tl < 2; ++tl) { const v4u kr = tl ? kB : kA;
                    float kx[8] = {bf_lo(kr.x), bf_hi(kr.x), bf_lo(kr.y), bf_hi(kr.y), bf_lo(kr.z), bf_hi(kr.z), bf_lo(kr.w), bf_hi(kr.w)}; float ss = 0.f;
#pragma unroll
                    for (int e = 0; e < 8; ++e) ss += kx[e] * kx[e];
                    ss += dppf<0xB1>(ss); ss += dppf<0x4E>(ss); ss += dppf<0x141>(ss);
                    const float rs = __builtin_amdgcn_rsqf(ss * (1.f / 64.f) + EPS);
#pragma unroll
                    for (int e = 0; e < 8; ++e) kx[e] = kx[e] * rs;
                    u32x4 w; w.x = cvt_pk_bf16(kx[0], kx[1]); w.y = cvt_pk_bf16(kx[2], kx[3]); w.z = cvt_pk_bf16(kx[4], kx[5]); w.w = cvt_pk_bf16(kx[6], kx[7]);
                    *(LAS u32x4*)(buf + (tl ? A2_KB : A2_KA) + sch * 1024 + sr * 16) = w; }
                  *(LAS v4u*)(buf + A2_VA + (sch >> 2) * 4096 + sr * 64 + (sch & 3) * 16) = vA;
                  *(LAS v4u*)(buf + A2_VB + (sch >> 2) * 4096 + sr * 64 + (sch & 3) * 16) = vB;
                  if (tid < 128) *(LAS float*)(buf + (tid < 64 ? A2_KB : A2_KA) + 8 * 1024 + (tid & 63) * 4) = -freg * 1.4426950408889634f; }
                const int ja2 = jA - 2 > 0 ? jA - 2 : 0, jb2 = jB - 2 > 0 ? jB - 2 : 0, jb1 = jB - 1 > 0 ? jB - 1 : 0;
                kA = *(const v4u*)(kg + (size_t)ja2 * 64 * 64); vA = *(const v4u*)(vg + (size_t)ja2 * 64 * 64); kB = *(const v4u*)(kg + (size_t)jb2 * 64 * 64); vB = *(const v4u*)(vg + (size_t)jb2 * 64 * 64);
                if (tid < 128) freg = fg[jb2 * 64];
                const float fchk = fb[jb1 * 64 + 63];
                asm volatile("s_waitcnt lgkmcnt(0)" ::: "memory"); __builtin_amdgcn_s_barrier(); asm volatile("" ::: "memory");
                if (jB * 64 <= q0 + wid * 32 + 31) {
                    const LAS unsigned char* buf = lds + (it & 1) * A2_BUF;
                    f32x16 s[4];
                    bf16x8 ka[3][2];
#define A2_KLOAD(g_, d_) do { const LAS unsigned char* kp_ = buf + (((g_) & 1) ? A2_KA : A2_KB) + (2 * ((g_) >> 1) + hi) * 1024 + r32 * 16; d_[0] = *(const LAS bf16x8*)kp_; d_[1] = *(const LAS bf16x8*)(kp_ + 512); } while (0)
                    A2_KLOAD(0, ka[0]); A2_KLOAD(1, ka[1]);
#pragma unroll
                    for (int c = 0; c < 4; ++c) { const LAS unsigned char* bp = buf + (c < 2 ? A2_KB : A2_KA) + 8 * 1024 + (32 * (c & 1) + 4 * hi) * 4;
#pragma unroll
                        for (int g = 0; g < 4; ++g) { const f32x4 b4 = *(const LAS f32x4*)(bp + 32 * g);
#pragma unroll
                            for (int e = 0; e < 4; ++e) s[c][4 * g + e] = b4[e]; } }
                    __builtin_amdgcn_sched_barrier(0);
#pragma unroll
                    for (int c = 0; c < 4; ++c)
#pragma unroll
                        for (int r = 0; r < 16; ++r) s[c][r] -= m;
                    __builtin_amdgcn_sched_barrier(0);
#pragma unroll
                    for (int g = 0; g < 8; ++g) { const int ks = g >> 1, tl = g & 1;
                        if (g + 2 < 8) A2_KLOAD(g + 2, ka[(g + 2) % 3]);
                        __builtin_amdgcn_sched_barrier(0);
                        s[2 * tl] = __builtin_amdgcn_mfma_f32_32x32x16_bf16(ka[g % 3][0], qf[ks], s[2 * tl], 0, 0, 0);
                        s[2 * tl + 1] = __builtin_amdgcn_mfma_f32_32x32x16_bf16(ka[g % 3][1], qf[ks], s[2 * tl + 1], 0, 0, 0);
                        __builtin_amdgcn_sched_barrier(0); }
#undef A2_KLOAD
                    if (it < 2) {
#pragma unroll
                        for (int c = 0; c < 4; ++c)
#pragma unroll
                            for (int r = 0; r < 16; ++r) { const int kv = (c < 2 ? jB : jA) * 64 + 32 * (c & 1) + crow(r, hi); if (kv > tq) s[c][r] = -1e30f; } }
                    float mxa = fmaxf(s[0][0], s[1][0]), mxb = fmaxf(s[2][0], s[3][0]);
#pragma unroll
                    for (int r = 1; r < 16; ++r) { mxa = fmaxf(fmaxf(mxa, s[0][r]), s[1][r]); mxb = fmaxf(fmaxf(mxb, s[2][r]), s[3][r]); }
                    const float mx = half_swap_max(fmaxf(mxa, mxb));
                    float ps = 0.f;
                    if (it == 0 || __builtin_amdgcn_ballot_w64(mx > ATT_MOVE) != 0ull) {
                        const float d = (it == 0) ? mx : fmaxf(mx, 0.f), alpha = __builtin_amdgcn_exp2f(-d); m += d;
#pragma unroll
                        for (int c = 0; c < 4; ++c)
#pragma unroll
                            for (int r = 0; r < 16; ++r) { s[c][r] = __builtin_amdgcn_exp2f(s[c][r] - d); ps += s[c][r]; }
                        lsum = lsum * alpha + ps;
#pragma unroll
                        for (int r = 0; r < 16; ++r) { o0[r] *= alpha; o1[r] *= alpha; }
                    } else {
#pragma unroll
                        for (int c = 0; c < 4; ++c)
#pragma unroll
                            for (int r = 0; r < 16; ++r) { s[c][r] = __builtin_amdgcn_exp2f(s[c][r]); ps += s[c][r]; }
                        lsum += ps;
                    }
                    bf16x8 vfa[3], vfb[3];
#define A2_VLOAD(g_, i_) do { const LAS unsigned char* vp_ = buf + (((g_) >> 1) < 2 ? A2_VB : A2_VA) + vb0 + (((g_) >> 1) & 1) * 2048 + ((g_) & 1) * 1024; \
                        const s16x4 al_ = vtr(vp_), ah_ = vtr(vp_ + 512), bl_ = vtr(vp_ + 4096), bh_ = vtr(vp_ + 4096 + 512); \
                        vfa[i_] = (bf16x8){al_[0], al_[1], al_[2], al_[3], ah_[0], ah_[1], ah_[2], ah_[3]}; vfb[i_] = (bf16x8){bl_[0], bl_[1], bl_[2], bl_[3], bh_[0], bh_[1], bh_[2], bh_[3]}; } while (0)
                    A2_VLOAD(0, 0); A2_VLOAD(1, 1);
                    __builtin_amdgcn_sched_barrier(0);
#pragma unroll
                    for (int g = 0; g < 8; ++g) { const int c = g >> 1, h2 = g & 1;
                        if (g + 2 < 8) A2_VLOAD(g + 2, (g + 2) % 3);
                        u32x4 w; w.x = cvt_pk_bf16(s[c][8 * h2 + 0], s[c][8 * h2 + 1]); w.y = cvt_pk_bf16(s[c][8 * h2 + 2], s[c][8 * h2 + 3]); w.z = cvt_pk_bf16(s[c][8 * h2 + 4], s[c][8 * h2 + 5]); w.w = cvt_pk_bf16(s[c][8 * h2 + 6], s[c][8 * h2 + 7]);
                        const bf16x8 pa = __builtin_bit_cast(bf16x8, w);
                        __builtin_amdgcn_sched_barrier(0);
                        o0 = __builtin_amdgcn_mfma_f32_32x32x16_bf16(vfa[g % 3], pa, o0, 0, 0, 0);
                        o1 = __builtin_amdgcn_mfma_f32_32x32x16_bf16(vfb[g % 3], pa, o1, 0, 0, 0);
                        __builtin_amdgcn_sched_barrier(0); }
#undef A2_VLOAD
                }
                if (jB > 0 && jB - 1 < NT - 4 && -fchk * 1.4426950408889634f < lim) break;
            }
            lsum = half_swap_sum(lsum);
            const float inv = 1.0f / lsum;
            bf16* op = (P + CB(PC_BQ) + ((size_t)h * M + rowbase) * 64) + tq * 64;
#pragma unroll
            for (int db = 0; db < 2; ++db)
#pragma unroll
                for (int jg = 0; jg < 4; ++jg) { const int d = 32 * db + 8 * jg + 4 * hi; const uint2 gw2 = gwr[db][jg];
                    const float g[4] = {bf_lo(gw2.x), bf_hi(gw2.x), bf_lo(gw2.y), bf_hi(gw2.y)}; float ov[4];
#pragma unroll
                    for (int e = 0; e < 4; ++e) ov[e] = (db ? o1[4 * jg + e] : o0[4 * jg + e]) * inv * __builtin_amdgcn_rcpf(1.0f + __builtin_amdgcn_exp2f(-g[e] * 1.4426950408889634f));
                    uint2 ow; ow.x = pk2(ov[0], ov[1]); ow.y = pk2(ov[2], ov[3]); *(uint2*)(op + d) = ow; }
        }
        if (tid == 0) { unsigned v = nv;
            while (v >= 192u && qleft > 0) { qsel = (qsel + 1) & 7; if (--qleft <= 0) break; v = __hip_atomic_fetch_add(qctr + 16 * qsel, 1u, __ATOMIC_RELAXED, __HIP_MEMORY_SCOPE_AGENT); }
            *(LAS unsigned*)(lds + A2_Q + 4 * par) = (qleft > 0 && v < 192u) ? (unsigned)qsel * 192u + v : 0xffffffffu; }
    }
}

constexpr size_t WS_U = WS_H;
constexpr size_t WS_ST = WS_H + 160 * MiB;
constexpr size_t WS_DK = WS_H + 240 * MiB;
constexpr int N_HG_UNITS = 96 * 64, N_RT_UNITS = 64 * 64;
__device__ __forceinline__ void stage_tile(LAS unsigned char* dst, const bf16* src, int lane) {
#pragma unroll
    for (int i = 0; i < 8; ++i) { const int r = i * 8 + (lane >> 3), ch = lane & 7; const v4u w = *(const v4u*)(src + (size_t)r * 64 + ch * 8);
        *(LAS v4u*)(dst + (ch >> 2) * 4096 + r * 64 + (ch & 3) * 16) = w; }
}
__device__ __forceinline__ bf16x8 ltri_op(int tb, int ts, int t_l, int hi) {
    const int t = 32 * tb + t_l; bf16x8 o;
#pragma unroll
    for (int j = 0; j < 8; ++j) { const int tp = 16 * ts + 8 * (j >> 2) + 4 * hi + (j & 3); o[j] = (tp <= t) ? (short)0x3f80 : (short)0; }
    return o;
}
__device__ __forceinline__ bf16x8 pack8(const float* x) { u32x4 w; w.x = cvt_pk_bf16(x[0], x[1]); w.y = cvt_pk_bf16(x[2], x[3]); w.z = cvt_pk_bf16(x[4], x[5]); w.w = cvt_pk_bf16(x[6], x[7]); return __builtin_bit_cast(bf16x8, w); }
__device__ __forceinline__ bf16x8 vfrag(const LAS unsigned char* p) { const s16x4 lo = vtr(p), hi4 = vtr(p + 512); return (bf16x8){lo[0], lo[1], lo[2], lo[3], hi4[0], hi4[1], hi4[2], hi4[3]}; }
__device__ __forceinline__ float s16f(short s) { return __uint_as_float(((unsigned)(unsigned short)s) << 16); }
#define MFMA32(a, b, c) __builtin_amdgcn_mfma_f32_32x32x16_bf16((a), (b), (c), 0, 0, 0)
__device__ __forceinline__ void hgrn_gate(float z, float lb, float& lf2, float& kk) {
    z = fminf(fmaxf(z, -30.f), 30.f);
    const float e = __builtin_amdgcn_exp2f(-z * 1.4426950408889634f), sig = __builtin_amdgcn_rcpf(1.0f + e);
    const float f = lb + (1.0f - lb) * sig; lf2 = __builtin_amdgcn_logf(fmaxf(f, 1e-12f)); kk = (1.0f - lb) * (e * sig);
}

struct TilePF { v4u a[8], b[8]; };
__device__ __forceinline__ void tile_fetch(TilePF& r, const bf16* sa, const bf16* sb, int lane) {
#pragma unroll
    for (int i = 0; i < 8; ++i) { const int rr = i * 8 + (lane >> 3), ch = lane & 7; r.a[i] = *(const v4u*)(sa + (size_t)rr * 64 + ch * 8); r.b[i] = *(const v4u*)(sb + (size_t)rr * 64 + ch * 8); }
}
__device__ __forceinline__ void tile_put(LAS unsigned char* da, LAS unsigned char* db, const TilePF& r, int lane) {
#pragma unroll
    for (int i = 0; i < 8; ++i) { const int rr = i * 8 + (lane >> 3), ch = lane & 7; const int o = (ch >> 2) * 4096 + rr * 64 + (ch & 3) * 16; *(LAS v4u*)(da + o) = r.a[i]; *(LAS v4u*)(db + o) = r.b[i]; }
}
__device__ __forceinline__ void tile_fetch_b(TilePF& r, const bf16* sb, int lane) {
#pragma unroll
    for (int i = 0; i < 8; ++i) { const int rr = i * 8 + (lane >> 3), ch = lane & 7; r.b[i] = *(const v4u*)(sb + (size_t)rr * 64 + ch * 8); }
}
__device__ __forceinline__ void tile_put_b(LAS unsigned char* db, const TilePF& r, int lane) {
#pragma unroll
    for (int i = 0; i < 8; ++i) { const int rr = i * 8 + (lane >> 3), ch = lane & 7; *(LAS v4u*)(db + (ch >> 2) * 4096 + rr * 64 + (ch & 3) * 16) = r.b[i]; }
}
__device__ __forceinline__ const bf16* hgrn_tile(const bf16* P, int unit) { const int chain = unit >> 6, n = unit & 63, b = chain / 6, h = chain % 6; return P + ((size_t)h * M + (size_t)b * T + n * 64) * 64; }
template <bool WT  >
__device__ __forceinline__ void rec_pass1_hgrn(LAS unsigned char* wl, const bf16* P, const float* LBl, bf16* U, float* DK, int unit, int lane, TilePF& pf, bool has_next) {
    const int c_l = lane & 31, hi = lane >> 5, chain = unit >> 6, h = chain % 6;
    const bf16* tile = hgrn_tile(P, unit);
    const float lb0_ = LBl[h * 64 + c_l], lb1_ = LBl[h * 64 + 32 + c_l];
    tile_put(wl, wl + 8192, pf, lane);
    { const size_t nx = has_next ? (size_t)NWAVES * 4096 : 0; tile_fetch(pf, tile + CB(PC_AF) + nx, tile + CB(PC_AI) + nx, lane); }
    asm volatile("s_waitcnt lgkmcnt(0)" ::: "memory");
    const int vb0 = ((lane >> 4) & 1) * 32 + (lane & 3) * 8 + (4 * hi + ((lane & 15) >> 2)) * 64;
    bf16* Uo = U + (size_t)unit * 4096;
#pragma unroll 1
    for (int fb = 0; fb < 2; ++fb) {
        const float lb = fb ? lb1_ : lb0_;
        float kk[4][8]; bf16x8 lfh[4], lfl[4]; s16x4 zr[4][2];
#pragma unroll
        for (int ts = 0; ts < 4; ++ts)
#pragma unroll
            for (int jj = 0; jj < 2; ++jj) zr[ts][jj] = vtr(wl + fb * 4096 + (16 * ts + 8 * jj) * 64 + vb0);
        __builtin_amdgcn_sched_barrier(0);
#pragma unroll
        for (int ts = 0; ts < 4; ++ts) { float lf[8], lo[8];
#pragma unroll
            for (int jj = 0; jj < 2; ++jj) { const s16x4 z4 = zr[ts][jj];
#pragma unroll
                for (int e = 0; e < 4; ++e) hgrn_gate(s16f(z4[e]), lb, lf[4 * jj + e], kk[ts][4 * jj + e]); }
            lfh[ts] = pack8(lf);
#pragma unroll
            for (int j = 0; j < 8; ++j) lo[j] = lf[j] - s16f(lfh[ts][j]);
            lfl[ts] = pack8(lo); }
        f32x16 cum[2];
#pragma unroll
        for (int tb = 0; tb < 2; ++tb) {
#pragma unroll
            for (int r = 0; r < 16; ++r) cum[tb][r] = 0.f;
#pragma unroll
            for (int ts = 0; ts < 2 * tb + 2; ++ts) { const bf16x8 L = ltri_op(tb, ts, c_l, hi); cum[tb] = MFMA32(L, lfh[ts], cum[tb]); cum[tb] = MFMA32(L, lfl[ts], cum[tb]); } }
        const float c63 = shfl_i(cum[1][15], 32 + c_l);
        if (hi == 0) { float* dkp = DK + (size_t)unit * 64 + 32 * fb + c_l; const float dkv = __builtin_amdgcn_exp2f(c63); if (WT) __hip_atomic_store(dkp, dkv, __ATOMIC_RELAXED, __HIP_MEMORY_SCOPE_AGENT); else *dkp = dkv; }
        bf16x8 kh[4];
#pragma unroll
        for (int ts = 0; ts < 4; ++ts) { float x[8];
#pragma unroll
            for (int j = 0; j < 8; ++j) x[j] = kk[ts][j] * __builtin_amdgcn_exp2f(c63 - cum[ts >> 1][8 * (ts & 1) + j]);
            kh[ts] = pack8(x); }
#pragma unroll
        for (int vb = 0; vb < 2; ++vb) { f32x16 acc;
#pragma unroll
            for (int r = 0; r < 16; ++r) acc[r] = 0.f;
#pragma unroll
            for (int ts = 0; ts < 4; ++ts) acc = MFMA32(vfrag(wl + 8192 + vb * 4096 + ts * 1024 + vb0), kh[ts], acc);
#pragma unroll
            for (int r = 0; r < 16; ++r) { bf16* up_ = Uo + (32 * vb + crow(r, hi)) * 64 + 32 * fb + c_l; const bf16 uv_ = (bf16)f2bf(acc[r]); if (WT) __hip_atomic_store(up_, uv_, __ATOMIC_RELAXED, __HIP_MEMORY_SCOPE_AGENT); else *up_ = uv_; } }
    }
}
__device__ __forceinline__ const bf16* ret_tile(const bf16* P, int unit) { const int chain = unit >> 6, n = unit & 63, b = chain / 4, h = chain % 4; return P + ((size_t)h * M + (size_t)b * T + n * 64) * 64; }
__device__ __forceinline__ void rec_pass1_ret(LAS unsigned char* wl, const bf16* P, bf16* U, int unit, int lane, TilePF& pf, bool has_next) {
    const int c_l = lane & 31, hi = lane >> 5, chain = unit >> 6, h = chain % 4;
    const bf16* tile = ret_tile(P, unit);
    tile_put(wl, wl + 8192, pf, lane);
    { const size_t nx = has_next ? (size_t)NWAVES * 4096 : 0; tile_fetch(pf, tile + CB(PC_CK) + nx, tile + CB(PC_CV) + nx, lane); }
    asm volatile("s_waitcnt lgkmcnt(0)" ::: "memory");
    const int vb0 = ((lane >> 4) & 1) * 32 + (lane & 3) * 8 + (4 * hi + ((lane & 15) >> 2)) * 64;
    const float lg2 = __builtin_amdgcn_logf(1.0f - __builtin_amdgcn_exp2f(-5.0f - (float)h));
    bf16* Uo = U + (size_t)(N_HG_UNITS + unit) * 4096;
    bf16x8 kh[2][4];
#pragma unroll
    for (int ts = 0; ts < 4; ++ts) { float x0[8], x1[8];
#pragma unroll
        for (int jj = 0; jj < 2; ++jj) { const s16x4 a4 = vtr(wl + (16 * ts + 8 * jj) * 64 + vb0), b4 = vtr(wl + 4096 + (16 * ts + 8 * jj) * 64 + vb0);
#pragma unroll
            for (int e = 0; e < 4; ++e) { const int t = 16 * ts + 8 * jj + 4 * hi + e; const float w = __builtin_amdgcn_exp2f(lg2 * (float)(63 - t));
                x0[4 * jj + e] = s16f(a4[e]) * w; x1[4 * jj + e] = s16f(b4[e]) * w; } }
        kh[0][ts] = pack8(x0); kh[1][ts] = pack8(x1); }
#pragma unroll
    for (int vb = 0; vb < 2; ++vb) { bf16x8 vf[4];
#pragma unroll
        for (int ts = 0; ts < 4; ++ts) vf[ts] = vfrag(wl + 8192 + vb * 4096 + ts * 1024 + vb0);
#pragma unroll
        for (int fb = 0; fb < 2; ++fb) { f32x16 acc;
#pragma unroll
            for (int r = 0; r < 16; ++r) acc[r] = 0.f;
#pragma unroll
            for (int ts = 0; ts < 4; ++ts) acc = MFMA32(vf[ts], kh[fb][ts], acc);
#pragma unroll
            for (int r = 0; r < 16; ++r) Uo[(32 * vb + crow(r, hi)) * 64 + 32 * fb + c_l] = (bf16)f2bf(acc[r]); } }
}
__device__ __forceinline__ void rec_pass2_chain(const bf16* U, const float* DK, bf16* ST, int chain, int tid) {
    constexpr int NE = 8;
    const int k = tid & 63, kp = (k & ~12) | ((k & 8) >> 1) | ((k & 4) << 1); const bool hg = chain < 96;
    const bf16* up = U + (size_t)chain * 64 * 4096 + tid; bf16* sp = ST + (size_t)chain * 64 * 4096 + (tid & ~63) + kp;
    const float* dp = DK + (size_t)(hg ? chain : 0) * 64 * 64 + k; int h = (chain - 96) & 3; asm volatile("" : "+s"(h));
    const float g64 = __builtin_amdgcn_exp2f(64.0f * __builtin_amdgcn_logf(1.0f - __builtin_amdgcn_exp2f(-5.0f - (float)h)));
    float S[NE];
#pragma unroll
    for (int i = 0; i < NE; ++i) S[i] = 0.f;
    bf16 un[8][NE]; float dn[8];
#pragma unroll
    for (int j = 0; j < 8; ++j) { dn[j] = hg ? dp[j * 64] : g64;
#pragma unroll
        for (int i = 0; i < NE; ++i) un[j][i] = up[(size_t)j * 4096 + 512 * i]; }
#pragma unroll 1
    for (int nb = 0; nb < 64; nb += 8) { bf16 uc[8][NE]; float dc[8];
#pragma unroll
        for (int j = 0; j < 8; ++j) { dc[j] = dn[j];
#pragma unroll
            for (int i = 0; i < NE; ++i) uc[j][i] = un[j][i]; }
        if (nb + 8 < 64) {
#pragma unroll
            for (int j = 0; j < 8; ++j) { dn[j] = hg ? dp[(nb + 8 + j) * 64] : g64;
#pragma unroll
                for (int i = 0; i < NE; ++i) un[j][i] = up[(size_t)(nb + 8 + j) * 4096 + 512 * i]; } }
        asm volatile("" ::: "memory");
#pragma unroll
        for (int j = 0; j < 8; ++j)
#pragma unroll
            for (int i = 0; i < NE; ++i) { sp[(size_t)(nb + j) * 4096 + 512 * i] = (bf16)f2bf(S[i]); S[i] = dc[j] * S[i] + bf1(uc[j][i]); } }
}
__device__ __forceinline__ void rec_pass3_tail(const LAS unsigned char* vt, const bf16x8 (&qt)[2][2][2], const bf16x8 (&kt)[2][2][2], const bf16x8 (&qh)[2][2][2], const bf16* STu,
                                               const float* gain, const bf16* grow  , bf16* orow, int lane, TilePF* pf = nullptr, const bf16* nxa = nullptr, const bf16* nxb = nullptr) {
    asm volatile("" : "+v"(lane));
    const int t_l = lane & 31, hi = lane >> 5;
    const int vb0 = ((lane >> 4) & 1) * 32 + (lane & 3) * 8 + (4 * hi + ((lane & 15) >> 2)) * 64;
    bf16x8 sfr[2][2][2];
#pragma unroll
    for (int vb = 0; vb < 2; ++vb)
#pragma unroll
        for (int fb = 0; fb < 2; ++fb)
#pragma unroll
            for (int ks = 0; ks < 2; ++ks) sfr[vb][fb][ks] = *(const bf16x8*)(STu + (32 * vb + t_l) * 64 + 32 * fb + 16 * ks + 8 * hi);
    __builtin_amdgcn_sched_barrier(0);
    bf16x8 pt[3][2];
#pragma unroll
    for (int blk = 0; blk < 3; ++blk) { const int sb = blk == 2 ? 1 : 0, tb = blk == 0 ? 0 : 1; f32x16 sc;
#pragma unroll
        for (int r = 0; r < 16; ++r) sc[r] = 0.f;
#pragma unroll
        for (int fb = 0; fb < 2; ++fb)
#pragma unroll
            for (int ks = 0; ks < 2; ++ks) sc = MFMA32(kt[sb][fb][ks], qt[tb][fb][ks], sc);
        if (sb == tb) {
#pragma unroll
            for (int r = 0; r < 16; ++r) if (crow(r, hi) > t_l) sc[r] = 0.f; }
#pragma unroll
        for (int s16 = 0; s16 < 2; ++s16) { float x[8];
#pragma unroll
            for (int j = 0; j < 8; ++j) x[j] = sc[8 * s16 + j];
            pt[blk][s16] = pack8(x); } }
    uint2 gwr[2][2][4];
#pragma unroll
    for (int tb = 0; tb < 2; ++tb)
#pragma unroll
        for (int vb = 0; vb < 2; ++vb)
#pragma unroll
            for (int g4 = 0; g4 < 4; ++g4) gwr[tb][vb][g4] = *(const uint2*)(grow + (size_t)tb * 32 * 64 + 32 * vb + 8 * g4 + 4 * hi);
    __builtin_amdgcn_sched_barrier(0);
    f32x16 o[2][2];
#pragma unroll
    for (int vb = 0; vb < 2; ++vb) {
#pragma unroll
        for (int tb = 0; tb < 2; ++tb)
#pragma unroll
            for (int r = 0; r < 16; ++r) o[vb][tb][r] = 0.f;
#pragma unroll
        for (int sb = 0; sb < 2; ++sb)
#pragma unroll
            for (int s16 = 0; s16 < 2; ++s16) { const bf16x8 vf = vfrag(vt + vb * 4096 + (32 * sb + 16 * s16) * 64 + vb0);
                if (sb == 0) { o[vb][0] = MFMA32(vf, pt[0][s16], o[vb][0]); o[vb][1] = MFMA32(vf, pt[1][s16], o[vb][1]); }
                else o[vb][1] = MFMA32(vf, pt[2][s16], o[vb][1]); }
#pragma unroll
        for (int fb = 0; fb < 2; ++fb)
#pragma unroll
            for (int ks = 0; ks < 2; ++ks) { const bf16x8 sf = sfr[vb][fb][ks];
                o[vb][0] = MFMA32(sf, qh[0][fb][ks], o[vb][0]); o[vb][1] = MFMA32(sf, qh[1][fb][ks], o[vb][1]); }
    }
    f32x4 gnr[2][4];
#pragma unroll
    for (int vb = 0; vb < 2; ++vb)
#pragma unroll
        for (int g4 = 0; g4 < 4; ++g4) gnr[vb][g4] = *(const f32x4*)(gain + 32 * vb + 8 * g4 + 4 * hi);
    if (pf) { if (nxa) tile_fetch(*pf, nxa, nxb, lane); else tile_fetch_b(*pf, nxb, lane); }
    __builtin_amdgcn_sched_barrier(0);
#pragma unroll
    for (int tb = 0; tb < 2; ++tb) { float ss = 0.f;
#pragma unroll
        for (int vb = 0; vb < 2; ++vb)
#pragma unroll
            for (int r = 0; r < 16; ++r) ss += o[vb][tb][r] * o[vb][tb][r];
        ss += shfl_i(ss, lane ^ 32);
        const float rs = 1.0f / sqrtf(ss * (1.f / 64.f) + EPS);
#pragma unroll
        for (int vb = 0; vb < 2; ++vb)
#pragma unroll
            for (int g4 = 0; g4 < 4; ++g4) { const int c = 32 * vb + 8 * g4 + 4 * hi; const uint2 gw2 = gwr[tb][vb][g4]; const f32x4 gn = gnr[vb][g4];
                const float g[4] = {bf_lo(gw2.x), bf_hi(gw2.x), bf_lo(gw2.y), bf_hi(gw2.y)}; float y[4];
#pragma unroll
                for (int e = 0; e < 4; ++e) y[e] = o[vb][tb][4 * g4 + e] * rs * gn[e] * (g[e] * __builtin_amdgcn_rcpf(1.0f + __builtin_amdgcn_exp2f(-g[e] * 1.4426950408889634f)));
                uint2 ow; ow.x = pk2(y[0], y[1]); ow.y = pk2(y[2], y[3]); *(uint2*)(orow + (size_t)tb * 32 * 64 + c) = ow; } }
}
__device__ __forceinline__ void rec_pass3_hgrn(LAS unsigned char* wl, bf16* P, const float* LBl, const float* gainl, const bf16* ST, int unit, int lane, TilePF& pf, bool has_next) {
    const int t_l = lane & 31, hi = lane >> 5, chain = unit >> 6, n = unit & 63, b = chain / 6, h = chain % 6;
    bf16* tile = P + ((size_t)h * M + (size_t)b * T + n * 64) * 64;
    const float lbv_[2] = {LBl[h * 64 + t_l], LBl[h * 64 + 32 + t_l]};
    tile_put(wl, wl + 8192, pf, lane);
    asm volatile("s_waitcnt lgkmcnt(0)" ::: "memory");
    const int vb0 = ((lane >> 4) & 1) * 32 + (lane & 3) * 8 + (4 * hi + ((lane & 15) >> 2)) * 64;
    uint2 qwa[2][2][4];
#pragma unroll
    for (int fb = 0; fb < 2; ++fb)
#pragma unroll
        for (int tb = 0; tb < 2; ++tb)
#pragma unroll
            for (int g = 0; g < 4; ++g) qwa[fb][tb][g] = *(const uint2*)(tile + CB(PC_AQ) + (size_t)(32 * tb + t_l) * 64 + 32 * fb + 4 * hi + 8 * g);
    __builtin_amdgcn_sched_barrier(0);
    bf16x8 qt[2][2][2], kt[2][2][2], qh[2][2][2];
#pragma unroll
    for (int fb = 0; fb < 2; ++fb) {
        const float lb_l1 = lbv_[fb];
        f32x16 cumT[2];
        { const float lb = lb_l1;
          bf16x8 lfh[4], lfl[4]; s16x4 zr[4][2];
#pragma unroll
          for (int ts = 0; ts < 4; ++ts)
#pragma unroll
              for (int jj = 0; jj < 2; ++jj) zr[ts][jj] = vtr(wl + fb * 4096 + (16 * ts + 8 * jj) * 64 + vb0);
          __builtin_amdgcn_sched_barrier(0);
#pragma unroll
          for (int ts = 0; ts < 4; ++ts) { float lf[8], lo[8];
#pragma unroll
              for (int jj = 0; jj < 2; ++jj) { const s16x4 z4 = zr[ts][jj];
#pragma unroll
                  for (int e = 0; e < 4; ++e) { float kkd; hgrn_gate(s16f(z4[e]), lb, lf[4 * jj + e], kkd);
                      *(LAS unsigned short*)(wl + fb * 4096 + (16 * ts + 8 * jj + 4 * hi + e) * 64 + t_l * 2) = (unsigned short)f2bf(kkd); } }
              lfh[ts] = pack8(lf);
#pragma unroll
              for (int j = 0; j < 8; ++j) lo[j] = lf[j] - s16f(lfh[ts][j]);
              lfl[ts] = pack8(lo); }
#pragma unroll
          for (int tb = 0; tb < 2; ++tb) {
#pragma unroll
              for (int r = 0; r < 16; ++r) cumT[tb][r] = 0.f;
#pragma unroll
              for (int ts = 0; ts < 2 * tb + 2; ++ts) { const bf16x8 L = ltri_op(tb, ts, t_l, hi); cumT[tb] = MFMA32(lfh[ts], L, cumT[tb]); cumT[tb] = MFMA32(lfl[ts], L, cumT[tb]); } } }
        float cmv[16];
#pragma unroll
        for (int r = 0; r < 16; ++r) { const int ci = (int)__float_as_uint(cumT[0][r]); const float s31 = __uint_as_float((unsigned)__builtin_amdgcn_readlane(ci, 31)), s63 = __uint_as_float((unsigned)__builtin_amdgcn_readlane(ci, 63)); cmv[r] = hi ? s63 : s31; }
#pragma unroll
        for (int tb = 0; tb < 2; ++tb) {
#pragma unroll
            for (int ks = 0; ks < 2; ++ks) { float xq[8], xk[8], xh[8];
#pragma unroll
                for (int gg = 0; gg < 2; ++gg) { const int g = 2 * ks + gg;
                    const uint2 qw = qwa[fb][tb][g]; const v2u kw = *(const LAS v2u*)(wl + fb * 4096 + (32 * tb + t_l) * 64 + (8 * g + 4 * hi) * 2);
                    const float qv[4] = {bf_lo(qw.x), bf_hi(qw.x), bf_lo(qw.y), bf_hi(qw.y)}, kv[4] = {bf_lo(kw.x), bf_hi(kw.x), bf_lo(kw.y), bf_hi(kw.y)};
#pragma unroll
                    for (int e = 0; e < 4; ++e) { const int r = 4 * g + e, x = 4 * gg + e; const float kk = kv[e];
                        const float cm = cmv[r], c = cumT[tb][r];
                        xq[x] = qv[e] * __builtin_amdgcn_exp2f(c - cm); xk[x] = kk * __builtin_amdgcn_exp2f(cm - c); xh[x] = qv[e] * __builtin_amdgcn_exp2f(c); } }
                qt[tb][fb][ks] = pack8(xq); kt[tb][fb][ks] = pack8(xk); qh[tb][fb][ks] = pack8(xh);
                asm volatile("" : "+v"(qt[tb][fb][ks]), "+v"(kt[tb][fb][ks]), "+v"(qh[tb][fb][ks])); }
        }
    }
    rec_pass3_tail(wl + 8192, qt, kt, qh, ST + (size_t)unit * 4096, gainl + h * 64, tile + CB(PC_AG) + (size_t)t_l * 64, tile + CB(PC_AQ) + (size_t)t_l * 64, lane, &pf, tile + CB(PC_AF) + (has_next ? (size_t)NWAVES * 4096 : 0), tile + CB(PC_AI) + (has_next ? (size_t)NWAVES * 4096 : 0));
}
__device__ __forceinline__ void rec_pass3_ret(LAS unsigned char* wl, bf16* P, const float* gainl, const bf16* ST, int unit, int lane, TilePF& pf, bool has_next) {
    const int t_l = lane & 31, hi = lane >> 5, chain = unit >> 6, n = unit & 63, b = chain / 4, h = chain % 4;
    bf16* tile = P + ((size_t)h * M + (size_t)b * T + n * 64) * 64;
    tile_put_b(wl + 8192, pf, lane);
    asm volatile("s_waitcnt lgkmcnt(0)" ::: "memory");
    const float lg2 = __builtin_amdgcn_logf(1.0f - __builtin_amdgcn_exp2f(-5.0f - (float)h));
    bf16x8 qt[2][2][2], kt[2][2][2], qh[2][2][2];
#pragma unroll
    for (int tb = 0; tb < 2; ++tb) {
        const int t = 32 * tb + t_l; const bf16* rowp = tile + (size_t)t * 64 + 4 * hi;
        uint2 qwr[2][4], kwr[2][4];
#pragma unroll
        for (int fb = 0; fb < 2; ++fb)
#pragma unroll
            for (int g = 0; g < 4; ++g) { qwr[fb][g] = *(const uint2*)(rowp + CB(PC_CQ) + 32 * fb + 8 * g); kwr[fb][g] = *(const uint2*)(rowp + CB(PC_CK) + 32 * fb + 8 * g); }
        __builtin_amdgcn_sched_barrier(0);
        const float wq = __builtin_amdgcn_exp2f(lg2 * (float)(t - 31)), wk = __builtin_amdgcn_exp2f(lg2 * (float)(31 - t)), wh = __builtin_amdgcn_exp2f(lg2 * (float)(t + 1));
#pragma unroll
        for (int fb = 0; fb < 2; ++fb)
#pragma unroll
            for (int ks = 0; ks < 2; ++ks) { float xq[8], xk[8], xh[8];
#pragma unroll
                for (int gg = 0; gg < 2; ++gg) { const int g = 2 * ks + gg;
                    const uint2 qw = qwr[fb][g], kw = kwr[fb][g];
                    const float qv[4] = {bf_lo(qw.x), bf_hi(qw.x), bf_lo(qw.y), bf_hi(qw.y)}, kv[4] = {bf_lo(kw.x), bf_hi(kw.x), bf_lo(kw.y), bf_hi(kw.y)};
#pragma unroll
                    for (int e = 0; e < 4; ++e) { const int x = 4 * gg + e; xq[x] = qv[e] * wq; xk[x] = kv[e] * wk; xh[x] = qv[e] * wh; } }
                qt[tb][fb][ks] = pack8(xq); kt[tb][fb][ks] = pack8(xk); qh[tb][fb][ks] = pack8(xh); }
    }
    rec_pass3_tail(wl + 8192, qt, kt, qh, ST + (size_t)(N_HG_UNITS + unit) * 4096, gainl + h * 64, tile + CB(PC_CG) + (size_t)t_l * 64, tile + CB(PC_CQ) + (size_t)t_l * 64, lane, &pf, nullptr, tile + CB(PC_CV) + (has_next ? (size_t)NWAVES * 4096 : 0));
}

struct Args { const float* in[17]; float* out; unsigned char* ws; };
enum { I_X = 0, I_WIN, I_BFOX, I_QG, I_KG, I_HLB, I_HOG, I_ROG, I_WOUT, I_GMPRE, I_GMPOST, I_WUP, I_CW, I_CB, I_WDN, I_GFPRE, I_GFPOST };
typedef const __attribute__((address_space(4))) Args* CArgs;
__device__ __forceinline__ int lane_id() { return pg8::fresh_lane(); }
__device__ __forceinline__ int opaque_tid(int wave_s) { int t = wave_s * 64 + lane_id(); asm volatile("" : "+v"(t)); return t; }
__device__ __forceinline__ CArgs opaque_args() { CArgs p = (CArgs)__builtin_amdgcn_kernarg_segment_ptr(); asm volatile("" : "+s"(p)); return p; }
#define PH_BEGIN const int tid = opaque_tid(wave_s), lane = tid & 63, wave = __builtin_amdgcn_readfirstlane(tid >> 6); const int G = gridDim.x, gw = blockIdx.x * NWAVES + wave, NGW = G * NWAVES; \
    CArgs ap = opaque_args(); unsigned char* ws = ap->ws; (void)lane; (void)gw; (void)NGW; (void)ws;

#define GRID_BAR() do { XcdBarrier b_; b_.bar = (unsigned*)((gu32*)(opaque_args()->ws + WS_CTL) + CW_BAR); b_.x = xb_xcc_id(); b_.st = (volatile LAS unsigned*)(lds + MISC_OFF) + 8; xcd_barrier(b_, opaque_tid(wave_s) == 0); } while (0)
__global__ void __launch_bounds__(NWAVES * 64, 2) fwd(Args args_unused) {
    extern __shared__ __attribute__((aligned(16))) unsigned char lds_raw[];
    LAS unsigned char* lds = (LAS unsigned char*)lds_raw;
    const int wave_s = __builtin_amdgcn_readfirstlane((int)threadIdx.x >> 6);
    { volatile LAS unsigned* MISC = (volatile LAS unsigned*)(lds + MISC_OFF);
      CArgs ap0 = opaque_args();
      for (int u = threadIdx.x; u < (LDS_BYTES - LDSCTL_OFF) / 4; u += NWAVES * 64) ((LAS unsigned*)(lds + LDSCTL_OFF))[u] = 0u;
      __syncthreads();
      (void)xcd_barrier_post((unsigned*)((gu32*)(ap0->ws + WS_CTL) + CW_BAR), MISC + 8); }

    { PH_BEGIN
        bf16* WinT = (bf16*)(ws + WS_WIN); bf16* WoutT = (bf16*)(ws + WS_WOUT); bf16* WupT = (bf16*)(ws + WS_WUP); bf16* WdnT = (bf16*)(ws + WS_WDN);
        float* WF = (float*)(ws + WS_WF); float* COS = (float*)(ws + WS_COS); float* SIN = (float*)(ws + WS_SIN); float* LB = (float*)(ws + WS_LB);
        LAS float* scr = (LAS float*)(lds + wave * 16384);
        constexpr int I_IN = 16 * 128, I_OUT = 16 * 32, I_UP = 16 * 176, I_DN = 44 * 32, I_L = I_IN + I_OUT + I_UP + I_DN;
        auto tr_decode = [&](int it) -> TrP {
            const int l = it / I_L; int r = it % I_L;
            if (r < I_IN) { const int kb = r / 128, nb = r % 128; const int pc = 32 * nb; const bool rot = (pc >= PC_CQ && pc < PC_CQ + 256) || (pc >= PC_CK && pc < PC_CK + 256);
                const int scol = rot ? pcol_to_orig(pc & ~63) + ((pc & 63) >> 1) : pcol_to_orig(pc);
                return TrP{ap->in[I_WIN] + (size_t)l * D * IN_COLS, IN_COLS, scol, 64 * kb, WinT + (size_t)l * NP * D, NP, pc, ap->in[I_GMPRE] + l * D, rot, true}; }
            r -= I_IN;
            if (r < I_OUT) { const int kb = r / 32, nb = r % 32; return TrP{ap->in[I_WOUT] + (size_t)l * D * D, D, 32 * nb, 64 * kb, WoutT + (size_t)l * D * D, D, 32 * nb, nullptr, false, true}; }
            r -= I_OUT;
            if (r < I_UP) { const int kb = r / 176, nb = r % 176; const int np = 32 * nb, srcc = ((np >> 7) & 1) * D_FF + 128 * (np >> 8) + (np & 127); return TrP{ap->in[I_WUP] + (size_t)l * D * NUP, NUP, srcc, 64 * kb, WupT + (size_t)l * NUP * D, NUP, np, ap->in[I_GFPRE] + l * D, false, false}; }
            r -= I_UP;
            { const int kb = r / 32, nb = r % 32; return TrP{ap->in[I_WDN] + (size_t)l * D_FF * D, D, 32 * nb, 64 * kb, WdnT + (size_t)l * D * D_FF, D, 32 * nb, nullptr, false, true}; } };
        if (gw < DEPTH * I_L) { TrP pn = tr_decode(gw); float wn[32]; f32x4 gn[2]; tr_load(wn, gn, pn, lane);
            for (int it = gw; it < DEPTH * I_L; it += NGW) { const TrP pc = pn; float wc[32]; f32x4 gc[2] = {gn[0], gn[1]};
#pragma unroll
                for (int i = 0; i < 32; ++i) wc[i] = wn[i];
                if (it + NGW < DEPTH * I_L) { pn = tr_decode(it + NGW); tr_load(wn, gn, pn, lane); }
                asm volatile("" ::: "memory");
                tr_finish(wc, gc, pc, scr, lane); } }
        const int gt = blockIdx.x * (NWAVES * 64) + tid, NGT = G * NWAVES * 64;
        for (int i = gt; i < DEPTH * 8 * 1024; i += NGT) { const int l = i / 8192, j = (i / 1024) & 7, k = i & 1023; WF[i] = j < 6 ? ap->in[I_WIN][((size_t)l * D + k) * IN_COLS + OC_BF + j] * ap->in[I_GMPRE][l * D + k] : 0.f; }
        for (int i = gt; i < 384; i += NGT) { float v[DEPTH], mx = -1e30f;
#pragma unroll
            for (int l = 0; l < DEPTH; ++l) { v[l] = ap->in[I_HLB][l * 384 + i]; mx = fmaxf(mx, v[l]); }
            float sum = 0.f;
#pragma unroll
            for (int l = 0; l < DEPTH; ++l) { v[l] = expf(v[l] - mx); sum += v[l]; }
            float run = 0.f; const float p0 = v[0] / sum;
#pragma unroll
            for (int l = 0; l < DEPTH; ++l) { run += v[l] / sum; LB[l * 384 + i] = run - p0; } }
        for (int i = gt; i < T * 32; i += NGT) { const int t = i >> 5, f = i & 31;
            const float invf = 1.0f / (float)exp2((double)f * (13.287712379549449 / 32.0));
            const float ang = (float)t * invf; const double rev = (double)ang * 0.15915494309189535; const float fr = (float)(rev - floor(rev));
            COS[i] = __builtin_amdgcn_cosf(fr); SIN[i] = __builtin_amdgcn_sinf(fr); }
        __syncthreads();
        { LAS float* wf0 = (LAS float*)lds;
          for (int i = tid; i < 6 * 1024; i += NWAVES * 64) { const int j = i >> 10, k = i & 1023; wf0[i] = ap->in[I_WIN][(size_t)k * IN_COLS + OC_BF + j] * ap->in[I_GMPRE][k]; } }
        __syncthreads();
        { f32x4 nx[4][4];
#pragma unroll
          for (int r = 0; r < 4; ++r)
#pragma unroll
              for (int j = 0; j < 4; ++j) nx[r][j] = *(const f32x4*)(ap->in[I_X] + (size_t)(4 * gw + r) * D + 4 * lane + 256 * j);
          for (int m = 4 * gw; m < M; m += 4 * NGW) { f32x4 cur[4][4];
#pragma unroll
              for (int r = 0; r < 4; ++r)
#pragma unroll
                  for (int j = 0; j < 4; ++j) cur[r][j] = nx[r][j];
              const int mn = (m + 4 * NGW < M) ? m + 4 * NGW : m;
#pragma unroll
              for (int r = 0; r < 4; ++r)
#pragma unroll
                  for (int j = 0; j < 4; ++j) nx[r][j] = *(const f32x4*)(ap->in[I_X] + (size_t)(mn + r) * D + 4 * lane + 256 * j);
              asm volatile("" ::: "memory");
              row_updateNx<4>(lane, (size_t)m, (size_t)1, ap->in[I_X], nullptr, nullptr, nullptr, (bf16*)(ws + WS_XB), nullptr, (float*)(ws + WS_RS), (const float*)lds_raw, ap->in[I_BFOX], (float*)(ws + WS_LOGF), cur); } }
    }
    GRID_BAR();

#pragma unroll 1
    for (int l = 0; l < DEPTH; ++l) {
        { PH_BEGIN
          if (gw < 96) {
            const float* LOGF = (const float*)(ws + WS_LOGF); float* FCUM = (float*)(ws + WS_FCUM);
            const int b = gw / 6, h = gw % 6; const float* lf = LOGF + ((size_t)b * T + lane) * 8 + h; float* Fo = FCUM + (size_t)gw * T + lane; float carry = 0.f;
#pragma unroll 4
            for (int i = 0; i < 64; ++i) { float v = lf[(size_t)i * 512];
                v += dppf<0x111>(v); v += dppf<0x112>(v); v += dppf<0x114>(v); v += dppf<0x118>(v);
                v += __uint_as_float((unsigned)__builtin_amdgcn_update_dpp(0, (int)__float_as_uint(v), 0x142, 0xA, 0xF, false));
                v += __uint_as_float((unsigned)__builtin_amdgcn_update_dpp(0, (int)__float_as_uint(v), 0x143, 0xC, 0xF, false));
                v += carry; Fo[i * 64] = v; carry = __uint_as_float((unsigned)__builtin_amdgcn_readlane((int)__float_as_uint(v), 63)); } }
          pg8::Gemm g{(const bf16*)(ws + WS_XB), (const bf16*)(ws + WS_WIN) + (size_t)l * NP * D, M, NP, D, 64, 64, (size_t)M * 64 * 2, (size_t)NP * 64 * 2}; pg8::StaticOrder S; S.init(M, NP, G, (int)blockIdx.x);
          pg8::EpiBf16RS E{(bf16*)(ws + WS_P), M, (const float*)(ws + WS_RS), (const float*)(ws + WS_COS), (const float*)(ws + WS_SIN), PC_CQ / 256, PC_CK / 256, lds + HALO_OFF};
          pg8::gemm_phase<pg8::EpiBf16RS, pg8::StaticOrder, true, true>(lds, g, S, E, tid); }
        GRID_BAR();
        { PH_BEGIN
          bf16* P = (bf16*)(ws + WS_P); LAS unsigned char* wl = lds + wave * 16384;
          const bool helpers = (G >= 256);
          gu32* hflag = (gu32*)(ws + WS_CTL) + CW_FLAGS + (l * 96) * 16;
          if (blockIdx.x < 160) {
              const int chain = blockIdx.x;
              if (chain < 96) { const int nend = helpers ? 32 : 64; TilePF pf; { const bf16* t0 = hgrn_tile(P, chain * 64 + wave); tile_fetch(pf, t0 + CB(PC_AF), t0 + CB(PC_AI), lane); }
                  for (int n = wave; n < nend; n += NWAVES) rec_pass1_hgrn<false>(wl, P, (const float*)(ws + WS_LB) + l * 384, (bf16*)(ws + WS_U), (float*)(ws + WS_DK), chain * 64 + n, lane, pf, n + NWAVES < nend); }
              else { TilePF pf; { const bf16* t0 = ret_tile(P, (chain - 96) * 64 + wave); tile_fetch(pf, t0 + CB(PC_CK), t0 + CB(PC_CV), lane); }
                  for (int n = wave; n < 64; n += NWAVES) rec_pass1_ret(wl, P, (bf16*)(ws + WS_U), (chain - 96) * 64 + n, lane, pf, n + NWAVES < 64); }
              asm volatile("s_waitcnt vmcnt(0)" ::: "memory"); __syncthreads();
              if (chain < 96 && helpers) {
                  if (tid == 0) { unsigned sp = 0u; while (__hip_atomic_load(hflag + chain * 16, RLX_AGENT) == 0u) { __builtin_amdgcn_s_sleep(2); if (++sp > (1u << 22)) break; }
                      __builtin_amdgcn_fence(__ATOMIC_ACQUIRE, "agent"); asm volatile("s_waitcnt vmcnt(0)" ::: "memory"); }
                  __syncthreads(); }
              rec_pass2_chain((const bf16*)(ws + WS_U), (const float*)(ws + WS_DK), (bf16*)(ws + WS_ST), chain, tid);
              asm volatile("s_waitcnt vmcnt(0)" ::: "memory"); __syncthreads();
              if (chain < 96) { TilePF pf; { const bf16* t0 = hgrn_tile(P, chain * 64 + wave); tile_fetch(pf, t0 + CB(PC_AF), t0 + CB(PC_AI), lane); }
                  for (int n = wave; n < 64; n += NWAVES) rec_pass3_hgrn(wl, P, (const float*)(ws + WS_LB) + l * 384, ap->in[I_HOG] + l * 384, (const bf16*)(ws + WS_ST), chain * 64 + n, lane, pf, n + NWAVES < 64); }
              else { TilePF pf; tile_fetch_b(pf, ret_tile(P, (chain - 96) * 64 + wave) + CB(PC_CV), lane);
                  for (int n = wave; n < 64; n += NWAVES) rec_pass3_ret(wl, P, ap->in[I_ROG] + l * 256, (const bf16*)(ws + WS_ST), (chain - 96) * 64 + n, lane, pf, n + NWAVES < 64); }
              __syncthreads();
          } else if (helpers && blockIdx.x < 256) {
              const int chain = blockIdx.x - 160;
              TilePF pf; { const bf16* t0 = hgrn_tile(P, chain * 64 + 32 + wave); tile_fetch(pf, t0 + CB(PC_AF), t0 + CB(PC_AI), lane); }
              for (int n = 32 + wave; n < 64; n += NWAVES) rec_pass1_hgrn<true>(wl, P, (const float*)(ws + WS_LB) + l * 384, (bf16*)(ws + WS_U), (float*)(ws + WS_DK), chain * 64 + n, lane, pf, n + NWAVES < 64);
              asm volatile("s_waitcnt vmcnt(0)" ::: "memory"); __syncthreads();
              if (tid == 0) __hip_atomic_store(hflag + chain * 16, 1u, RLX_AGENT);
              __syncthreads();
          }
          float gq = 0.f, gk = 0.f;
          for (int i = 0; i < 64; ++i) { gq = fmaxf(gq, fabsf(ap->in[I_QG][l * 64 + i])); gk = fmaxf(gk, fabsf(ap->in[I_KG][l * 64 + i])); }
          const float bound2 = 2.0f * (8.0f * gq * 0.125f * 1.4426950408889634f * 1.004f) * (8.0f * gk * 1.004f);
          attn_v3(lds, P, (const float*)(ws + WS_FCUM), tid, (unsigned*)((gu32*)(ws + WS_CTL) + CW_QUEUE + 128 * l), bound2, ap->in[I_QG] + l * 64, ap->in[I_KG] + l * 64); }
        GRID_BAR();
        { PH_BEGIN
          pg8::Gemm g{(const bf16*)(ws + WS_P), (const bf16*)(ws + WS_WOUT) + (size_t)l * D * D, M, D, D, 64, 64, (size_t)M * 64 * 2, (size_t)D * 64 * 2}; pg8::StaticOrder S; S.init(M, D, G, (int)blockIdx.x);
          { LAS float* gl = (LAS float*)(lds + GAIN_OFF); const float* gsrc = ap->in[I_GMPOST] + l * D; gl[tid] = gsrc[tid]; gl[tid + 512] = gsrc[tid + 512]; }
          pg8::EpiNormRes E{(bf16*)(ws + WS_XB), (const LAS float*)(lds + GAIN_OFF), (float*)(ws + WS_SLOT1), (unsigned*)((gu32*)(ws + WS_CTL) + CW_CNT + (l * 4 + 0) * 4096),
                            (float*)(ws + WS_RS), (LAS float*)(lds + HALO_OFF)};
          pg8::gemm_phase<pg8::EpiNormRes, pg8::StaticOrder, true, true>(lds, g, S, E, tid); }
        GRID_BAR();
        { PH_BEGIN
          pg8::Gemm g{(const bf16*)(ws + WS_XB), (const bf16*)(ws + WS_WUP) + (size_t)l * NUP * D, M, NUP, D, 64, 64, (size_t)M * 64 * 2, (size_t)NUP * 64 * 2}; pg8::StaticOrder S; S.init(M, NUP, G, (int)blockIdx.x);
          pg8::EpiConvAct E{(bf16*)(ws + WS_ACT), ap->in[I_CW] + (size_t)l * 3 * NUP, ap->in[I_CB] + (size_t)l * NUP, (float*)(ws + WS_EDGEL), (float*)(ws + WS_EDGEP), lds + HALO_OFF, D_FF, (const float*)(ws + WS_RS), (size_t)M * 64, lds + RING_BYTES + 10240};
          pg8::gemm_phase<pg8::EpiConvAct, pg8::StaticOrder, true, true>(lds, g, S, E, tid); }
        GRID_BAR();
        { PH_BEGIN
          pg8::Gemm g{(const bf16*)(ws + WS_ACT), (const bf16*)(ws + WS_WDN) + (size_t)l * D * D_FF, M, D, D_FF, 64, 64, (size_t)M * 64 * 2, (size_t)D * 64 * 2}; pg8::StaticOrder S; S.init(M, D, G, (int)blockIdx.x);
          { const float* EL = (const float*)(ws + WS_EDGEL); const float* EP = (const float*)(ws + WS_EDGEP); bf16* ACT = (bf16*)(ws + WS_ACT);
            const float* cw = ap->in[I_CW] + (size_t)l * 3 * NUP; pg8::Unit fu;
            for (int ui = 0; S.next(ui, fu); ++ui) { const int pm = fu.pm; if ((pm & 15) == 0) continue;
              for (int ch = tid; ch < D_FF; ch += NWAVES * 64) {
                const int ng = 256 * (ch >> 7) + (ch & 127), nv = ng + 128;
                const float w0g = cw[ch], w1g = cw[NUP + ch], w0v = cw[D_FF + ch], w1v = cw[NUP + D_FF + ch];
                const float lg0 = EL[(size_t)((pm - 1) * 2 + 0) * NUP + ng], lg1 = EL[(size_t)((pm - 1) * 2 + 1) * NUP + ng], lv0 = EL[(size_t)((pm - 1) * 2 + 0) * NUP + nv], lv1 = EL[(size_t)((pm - 1) * 2 + 1) * NUP + nv];
                const float g0 = EP[(size_t)(pm * 2 + 0) * NUP + ng] + w0g * lg0 + w1g * lg1, v0 = EP[(size_t)(pm * 2 + 0) * NUP + nv] + w0v * lv0 + w1v * lv1;
                const float g1 = EP[(size_t)(pm * 2 + 1) * NUP + ng] + w0g * lg1, v1 = EP[(size_t)(pm * 2 + 1) * NUP + nv] + w0v * lv1;
                ACT[((size_t)(ch >> 6) * M + (pm * 256 + 0)) * 64 + (ch & 63)] = (bf16)f2bf(g0 / (1.0f + __expf(-g0)) * v0);
                ACT[((size_t)(ch >> 6) * M + (pm * 256 + 1)) * 64 + (ch & 63)] = (bf16)f2bf(g1 / (1.0f + __expf(-g1)) * v1); } }
            asm volatile("s_waitcnt vmcnt(0)" ::: "memory"); __syncthreads(); }
          const bool last = (l == DEPTH - 1);
          pg8::EpiNormResFFN E{(bf16*)(ws + WS_XB), ap->in[I_GFPOST] + l * D, (float*)(ws + WS_SLOT1), (unsigned*)((gu32*)(ws + WS_CTL) + CW_CNT + (l * 4 + 2) * 4096), (float*)(ws + WS_RS), (LAS float*)(lds + HALO_OFF),
                               last ? ap->out : nullptr, (const float*)(ws + WS_WF) + (l + 1) * 8192, ap->in[I_BFOX] + (l + 1) * 6, (float*)(ws + WS_LPART), (unsigned*)((gu32*)(ws + WS_CTL) + CW_CNT + (l * 4 + 3) * 4096),
                               (float*)(ws + WS_LOGF), (LAS float*)(lds + LGL_OFF)};
          pg8::gemm_phase<pg8::EpiNormResFFN, pg8::StaticOrder, true, true>(lds, g, S, E, tid); }
        if (l < DEPTH - 1) GRID_BAR();
    }
}

extern "C" void kernel_launch(void* const* d_in, const int* in_sizes, int n_in, void* d_out, int out_size, void* d_ws, size_t ws_size, hipStream_t stream) {
    static int grid = 0;
    if (grid == 0) {
        if (n_in != 17 || in_sizes[0] != M * D || out_size != M * D || ws_size < WS_END) { fprintf(stderr, "kernel_launch: unexpected shapes (n_in %d, in0 %d, out %d, ws %zu)\n", n_in, n_in > 0 ? in_sizes[0] : -1, out_size, ws_size); grid = -1; return; }
        int dev = 0, cus = 0;
        if (hipGetDevice(&dev) != hipSuccess || hipDeviceGetAttribute(&cus, hipDeviceAttributeMultiprocessorCount, dev) != hipSuccess) { grid = -1; return; }
        if (hipFuncSetAttribute((const void*)fwd, hipFuncAttributeMaxDynamicSharedMemorySize, LDS_BYTES) != hipSuccess) { grid = -1; return; }
        (void)hipGetLastError();
        grid = cus;
    }
    if (grid < 0) return;
    if (hipMemsetAsync((char*)d_ws + WS_CTL, 0, CTL_ZERO_BYTES, stream) != hipSuccess) return;
    Args a{};
    for (int i = 0; i < 17; ++i) a.in[i] = (const float*)d_in[i];
    a.out = (float*)d_out; a.ws = (unsigned char*)d_ws;
    hipLaunchKernelGGL(fwd, dim3(grid), dim3(NWAVES * 64), LDS_BYTES, stream, a);
}
```

```cpp
#include <hip/hip_runtime.h>
#include <cstdio>
#include <cstdint>
#include <cmath>
__device__ __forceinline__ float shfl_i(float v, int src) { return __uint_as_float((unsigned)__builtin_amdgcn_ds_bpermute(src << 2, (int)__float_as_uint(v))); }
template <int CTRL> __device__ __forceinline__ float dppf(float v) { return __uint_as_float((unsigned)__builtin_amdgcn_update_dpp(0, (int)__float_as_uint(v), CTRL, 0xf, 0xf, true)); }
namespace pg8 {
#define PG8_LAS __attribute__((address_space(3)))
__device__ __forceinline__ int fresh_lane() { int l; asm volatile("v_mbcnt_lo_u32_b32 %0, -1, 0\n\tv_mbcnt_hi_u32_b32 %0, -1, %0\n\ts_nop 1" : "=v"(l)); return l; }
typedef unsigned short bf16_t;
typedef short bf16x8 __attribute__((ext_vector_type(8)));
typedef float f32x4 __attribute__((ext_vector_type(4)));
typedef unsigned u32x4 __attribute__((ext_vector_type(4)));
constexpr int BM = 256, BK = 64, HALF = 128, HTB = HALF * BK * 2  , STAGE_BYTES = 8 * HTB, NXCD = 8, WGM = 8;

__host__ __device__ __forceinline__ int lds_byte(int r, int c) { const int st = (r >> 4) * 2 + (c >> 5), rr = r & 15, cc = c & 31, ob = rr * 64 + cc * 2; return st * 1024 + (ob ^ (((ob >> 9) & 1) << 5)); }
__host__ __device__ __forceinline__ void stage_rc(int b, int& R, int& C) { const int st = b / 1024, sb = b % 1024, swz = sb ^ (((sb >> 9) & 1) << 5); R = (st >> 1) * 16 + swz / 64; C = (st & 1) * 32 + (swz % 64) / 2; }
__host__ __device__ __forceinline__ int perm32(int rho) { const int n = rho >> 4, i = rho & 15; return 8 * (i >> 2) + 4 * n + (i & 3); }

struct Unit { int pm, pn; };
struct Gemm { const bf16_t* A; const bf16_t* Bt; int M, N, K, lda, ldb; size_t kstrA, kstrB; };

struct StaticOrder {
    int nM, nN, nwg, G, c;
    __host__ __device__ void init(int M, int N, int G_, int c_) { nM = M / BM; nN = N / BM; nwg = nM * nN; G = G_; c = c_; }
    __host__ __device__ bool next(int i, Unit& u) const {
        const long L = (long)i * G + c; if (L >= nwg) return false;
        int wgid = (int)L; { const int q = nwg / NXCD, r = nwg % NXCD, xcd = wgid % NXCD, off = wgid / NXCD; wgid = (xcd < r ? xcd * (q + 1) : r * (q + 1) + (xcd - r) * q) + off; }
        const int nig = WGM * nN, gid = wgid / nig, fm = gid * WGM, gsz = (nM - fm) < WGM ? (nM - fm) : WGM;
        u.pm = fm + ((wgid % nig) % gsz); u.pn = (wgid % nig) / gsz; return true;
    }
    __device__ __forceinline__ void a_ready(const Unit&) const {}
    __device__ __forceinline__ void done(const Unit&) const {}
};


__device__ __forceinline__ unsigned cvt_pk_bf16(float lo, float hi) { unsigned r; asm volatile("v_cvt_pk_bf16_f32 %0, %1, %2" : "=v"(r) : "v"(lo), "v"(hi)); return r; }
typedef float f32x2 __attribute__((ext_vector_type(2)));

template <int ACT  > struct EpiBf16 {
    static constexpr bool PERM = true, AFTER_DRAIN = false, PREFETCH = false; static_assert(ACT == 0, "EpiBf16: ACT is 0");
    bf16_t* O; int ldc; const float* bias; int split_cols; size_t split_stride; float scale0;
    __device__ __forceinline__ void operator()(const f32x4 (&acc)[2][2][4][2], const Unit& u, int wr, int wc, int fr, int fq) const {
        const int row0 = u.pm * BM + wr * 64 + fr; int colt = u.pn * BM; bf16_t* base = O;
        float sc = 1.f; if (split_cols) { const int t = colt / split_cols; base += (size_t)t * split_stride; colt -= t * split_cols; if (t == 0) sc = scale0; }
        const int col0 = colt + wc * 32 + 8 * fq, bcol0 = u.pn * BM + wc * 32 + 8 * fq;
        f32x4 bv[2][2];
#pragma unroll
        for (int bj = 0; bj < 2; ++bj)
#pragma unroll
            for (int n = 0; n < 2; ++n) bv[bj][n] = bias ? *(const f32x4*)(bias + bcol0 + bj * HALF + 4 * n) : (f32x4){0.f, 0.f, 0.f, 0.f};
#pragma unroll
        for (int ai = 0; ai < 2; ++ai)
#pragma unroll
            for (int m = 0; m < 4; ++m) { bf16_t* rowp = base + (size_t)(row0 + ai * HALF + m * 16) * ldc + col0;
#pragma unroll
                for (int bj = 0; bj < 2; ++bj) { f32x4 v0 = acc[ai][bj][m][0] + bv[bj][0], v1 = acc[ai][bj][m][1] + bv[bj][1];

                    v0 = v0 * sc; v1 = v1 * sc; u32x4 w; w.x = cvt_pk_bf16(v0[0], v0[1]); w.y = cvt_pk_bf16(v0[2], v0[3]); w.z = cvt_pk_bf16(v1[0], v1[1]); w.w = cvt_pk_bf16(v1[2], v1[3]);
                    *(u32x4*)(rowp + bj * HALF) = w; } }
    }
};


struct EpiBf16RS {
    static constexpr bool PERM = true, AFTER_DRAIN = false, PREFETCH = true;
    bf16_t* O; int ldc; const float* rs; const float* cosT; const float* sinT; int pn_q, pn_k; PG8_LAS unsigned char* rbuf;
    __device__ __forceinline__ void prefetch(const Unit& u, int par, int wid, int lane) const {
        if (wid < 4) __builtin_amdgcn_global_load_lds((const unsigned*)(rs + ((size_t)u.pm * BM + wid * 64 + lane) * 4), (PG8_LAS unsigned*)(rbuf + par * 4096 + wid * 1024), 16, 0, 0); }
    __device__ __forceinline__ void operator()(const f32x4 (&acc)[2][2][4][2], const Unit& u, int wr, int wc, int fr, int fq, int par) const {
        const int row0 = u.pm * BM + wr * 64 + fr, col0 = u.pn * BM + wc * 64 + 8 * fq;
        const bool rot = (u.pn == pn_q) || (u.pn == pn_k); const float ksc = (u.pn == pn_k) ? 0.125f : 1.0f; const int p0 = 4 * fq;
        float scv[2][4];
#pragma unroll
        for (int ai = 0; ai < 2; ++ai)
#pragma unroll
            for (int m = 0; m < 4; ++m) { const f32x4 q4 = *(const PG8_LAS f32x4*)(rbuf + par * 4096 + (wr * 64 + fr + ai * HALF + m * 16) * 16); scv[ai][m] = __builtin_amdgcn_rsqf(((q4[0] + q4[1]) + (q4[2] + q4[3])) * (1.f / 1024.f) + 1e-6f); }
        bf16_t* rowb = O + ((size_t)(col0 >> 6) * (size_t)ldc + row0) * 64 + (col0 & 63);
        if (!rot) {
#pragma unroll
            for (int ai = 0; ai < 2; ++ai)
#pragma unroll
                for (int m = 0; m < 4; ++m) { const float sc = scv[ai][m]; bf16_t* rowp = rowb + (ai * HALF + m * 16) * 64;
#pragma unroll
                    for (int bj = 0; bj < 2; ++bj) { const f32x4 v0 = acc[ai][bj][m][0] * sc, v1 = acc[ai][bj][m][1] * sc;
                        u32x4 w; w.x = cvt_pk_bf16(v0[0], v0[1]); w.y = cvt_pk_bf16(v0[2], v0[3]); w.z = cvt_pk_bf16(v1[0], v1[1]); w.w = cvt_pk_bf16(v1[2], v1[3]);
                        *(u32x4*)(rowp + bj * 32) = w; } }
        } else {
            f32x4 cn[2], sn[2];
#pragma unroll
            for (int bj = 0; bj < 2; ++bj) { const int t = row0 & 4095; cn[bj] = *(const f32x4*)(cosT + t * 32 + p0 + 16 * bj); sn[bj] = *(const f32x4*)(sinT + t * 32 + p0 + 16 * bj); }
#pragma unroll
            for (int i = 0; i < 8; ++i) { const int ai = i >> 2, m = i & 3; const float sc = scv[ai][m]; bf16_t* rowp = rowb + (ai * HALF + m * 16) * 64;
                f32x4 c4b[2], s4b[2];
#pragma unroll
                for (int bj = 0; bj < 2; ++bj) { c4b[bj] = cn[bj] * ksc; s4b[bj] = sn[bj] * ksc; }
                if (i < 7) { const int t = (row0 + ((i + 1) >> 2) * HALF + ((i + 1) & 3) * 16) & 4095;
#pragma unroll
                    for (int bj = 0; bj < 2; ++bj) { cn[bj] = *(const f32x4*)(cosT + t * 32 + p0 + 16 * bj); sn[bj] = *(const f32x4*)(sinT + t * 32 + p0 + 16 * bj); } }
                asm volatile("" ::: "memory");
#pragma unroll
                for (int bj = 0; bj < 2; ++bj) { f32x4 v0 = acc[ai][bj][m][0] * sc, v1 = acc[ai][bj][m][1] * sc; const f32x4 c4 = c4b[bj], s4 = s4b[bj];
                    const f32x4 a0 = v0, a1 = v1;
                    v0[0] = a0[0] * c4[0] - a0[1] * s4[0]; v0[1] = a0[0] * s4[0] + a0[1] * c4[0]; v0[2] = a0[2] * c4[1] - a0[3] * s4[1]; v0[3] = a0[2] * s4[1] + a0[3] * c4[1];
                    v1[0] = a1[0] * c4[2] - a1[1] * s4[2]; v1[1] = a1[0] * s4[2] + a1[1] * c4[2]; v1[2] = a1[2] * c4[3] - a1[3] * s4[3]; v1[3] = a1[2] * s4[3] + a1[3] * c4[3];
                    u32x4 w; w.x = cvt_pk_bf16(v0[0], v0[1]); w.y = cvt_pk_bf16(v0[2], v0[3]); w.z = cvt_pk_bf16(v1[0], v1[1]); w.w = cvt_pk_bf16(v1[2], v1[3]);
                    *(u32x4*)(rowp + bj * 32) = w; } }
        }
    }
};

typedef float f32x2e __attribute__((ext_vector_type(2))); typedef __bf16 bf16x2e __attribute__((ext_vector_type(2)));
__device__ __forceinline__ unsigned cvt_pk_bf16_v(float lo, float hi) { f32x2e v = {lo, hi}; bf16x2e b = __builtin_convertvector(v, bf16x2e); return __builtin_bit_cast(unsigned, b); }
struct EpiConvAct {
    static constexpr bool PERM = true, AFTER_DRAIN = false, PREFETCH = true;
    bf16_t* ACT; const float* cw; const float* cb; float* EDGEL; float* EDGEP; PG8_LAS unsigned char* halo; int dff; const float* rs; size_t blk; PG8_LAS unsigned char* wbuf;
    __device__ __forceinline__ void prefetch(const Unit& u, int par, int wid, int lane) const {
        if (wid < 4) { const int sg = 2 * wid + (lane >> 5); const float* src = (sg < 6 ? cw + (size_t)(sg >> 1) * (2 * dff) : cb) + (sg & 1) * dff + 128 * u.pn + (lane & 31) * 4;
            __builtin_amdgcn_global_load_lds((const unsigned*)src, (PG8_LAS unsigned*)(wbuf + par * 8192 + wid * 1024), 16, 0, 0); }
        else { const float* src = rs + ((size_t)u.pm * BM + (wid - 4) * 64 + lane) * 4;
            __builtin_amdgcn_global_load_lds((const unsigned*)src, (PG8_LAS unsigned*)(wbuf + par * 8192 + 4096 + (wid - 4) * 1024), 16, 0, 0); } }
    __device__ __forceinline__ void operator()(const f32x4 (&acc)[2][2][4][2], const Unit& u, int wr, int wc, int fr, int fq, int par) const {
        { const int l_ = fresh_lane(); fr = l_ & 15; fq = l_ >> 4; }
        const int wave = wr * 4 + wc, lane = fq * 16 + fr, nup = 2 * dff;
        const int ch0 = 128 * u.pn + 32 * wc + 8 * fq;
        float rsv[2][4];
#pragma unroll
        for (int ai = 0; ai < 2; ++ai)
#pragma unroll
            for (int m = 0; m < 4; ++m) { const f32x4 q4 = *(const PG8_LAS f32x4*)(wbuf + par * 8192 + 4096 + (ai * HALF + wr * 64 + m * 16 + fr) * 16); rsv[ai][m] = __builtin_amdgcn_rsqf(((q4[0] + q4[1]) + (q4[2] + q4[3])) * (1.f / 1024.f) + 1e-6f); }
#pragma unroll
        for (int ai = 0; ai < 2; ++ai) if (fr >= 14) {
#pragma unroll
            for (int bj = 0; bj < 2; ++bj)
#pragma unroll
                for (int n = 0; n < 2; ++n) *(PG8_LAS f32x4*)(halo + ((((wave * 2 + ai) * 2 + (fr - 14)) * 4 + fq) * 64) + (bj * 2 + n) * 16) = acc[ai][bj][3][n] * rsv[ai][3]; }
        if (wr == 1 && fr >= 14) {
#pragma unroll
            for (int bj = 0; bj < 2; ++bj)
#pragma unroll
                for (int n = 0; n < 2; ++n) *(f32x4*)(EDGEL + ((size_t)(u.pm * 2 + (fr - 14))) * nup + 256 * u.pn + 128 * bj + 32 * wc + 8 * fq + 4 * n) = acc[1][bj][3][n] * rsv[1][3]; }
        asm volatile("s_waitcnt lgkmcnt(0)" ::: "memory"); __builtin_amdgcn_s_barrier(); asm volatile("" ::: "memory");
        const size_t acb = (size_t)(ch0 >> 6) * blk + (ch0 & 63);
        typedef unsigned u32x2 __attribute__((ext_vector_type(2)));
        u32x2 pend[2][4];
#pragma unroll
        for (int n = 0; n < 2; ++n) {
            f32x4 w[3][2], bb[2];
#pragma unroll
            for (int bj = 0; bj < 2; ++bj) { const PG8_LAS float* wl_ = (const PG8_LAS float*)(wbuf + par * 8192) + bj * 128 + 32 * wc + 8 * fq + 4 * n; bb[bj] = *(const PG8_LAS f32x4*)(wl_ + 6 * 128);
#pragma unroll
                for (int j = 0; j < 3; ++j) w[j][bj] = *(const PG8_LAS f32x4*)(wl_ + j * 256); }
#pragma unroll
            for (int ai = 0; ai < 2; ++ai) {
                const bool none = (ai == 0 && wr == 0); const int pw = wr == 1 ? wave - 4 : wave + 4, pai = wr == 1 ? ai : 0;
                float r1p[2][4], r2p[2][4];
#pragma unroll
                for (int bj = 0; bj < 2; ++bj) { f32x4 h = (f32x4){0.f, 0.f, 0.f, 0.f};
                    if (!none && fr >= 14) h = *(const PG8_LAS f32x4*)(halo + ((((pw * 2 + pai) * 2 + (fr - 14)) * 4 + fq) * 64) + (bj * 2 + n) * 16);
#pragma unroll
                    for (int e = 0; e < 4; ++e) { r1p[bj][e] = dppf<0x121>(h[e]); r2p[bj][e] = dppf<0x122>(h[e]); } }
#pragma unroll
                for (int m = 0; m < 4; ++m) { f32x4 c[2];
#pragma unroll
                    for (int bj = 0; bj < 2; ++bj)
#pragma unroll
                        for (int e = 0; e < 4; ++e) { const float x = acc[ai][bj][m][n][e] * rsv[ai][m]; const float r1 = dppf<0x121>(x), r2 = dppf<0x122>(x);
                            const float u1 = fr == 0 ? r1p[bj][e] : r1, u2 = fr < 2 ? r2p[bj][e] : r2;
                            c[bj][e] = bb[bj][e] + w[0][bj][e] * u2 + w[1][bj][e] * u1 + w[2][bj][e] * x; r1p[bj][e] = r1; r2p[bj][e] = r2; }
                    if (none && m == 0 && fr < 2) {
#pragma unroll
                        for (int bj = 0; bj < 2; ++bj) *(f32x4*)(EDGEP + ((size_t)(u.pm * 2 + fr)) * nup + 256 * u.pn + 128 * bj + 32 * wc + 8 * fq + 4 * n) = c[bj]; }
                    float o[4];
#pragma unroll
                    for (int e = 0; e < 4; ++e) { const float g = c[0][e]; o[e] = g * __builtin_amdgcn_rcpf(1.0f + __builtin_amdgcn_exp2f(-g * 1.4426950408889634f)) * c[1][e]; }
                    u32x2 ow; ow.x = cvt_pk_bf16_v(o[0], o[1]); ow.y = cvt_pk_bf16_v(o[2], o[3]);
                    if (n == 0) { pend[ai][m] = ow; asm volatile("" : "+v"(pend[ai][m])); }
                    else { u32x4 w4; w4.x = pend[ai][m].x; w4.y = pend[ai][m].y; w4.z = ow.x; w4.w = ow.y; *(u32x4*)(ACT + acb + (u.pm * BM + ai * HALF + wr * 64 + m * 16 + fr) * 64) = w4; } }
            }
        }
    }
};

template <class Epi, class Sched, bool ALIGN_EPI = false, bool SP2 = false>
__device__ __forceinline__ void gemm_phase(PG8_LAS unsigned char* lds, const Gemm g, const Sched& S, const Epi& E, int tid_) {
    asm volatile("" : "+v"(tid_)); const int tid = tid_, wid = __builtin_amdgcn_readfirstlane(tid >> 6), lane = tid & 63, wr = wid >> 2, wc = wid & 3, fr = lane & 15, fq = lane >> 4;
    const int K = g.K, nt = K / BK, lda = g.lda, ldb = g.ldb;
    unsigned voffA[2], voffB[2];
#pragma unroll
    for (int i = 0; i < 2; ++i) { int R, C; stage_rc(tid * 16 + i * 8192, R, C); const int Rb = Epi::PERM ? ((R & ~31) + perm32(R & 31)) : R;
        voffA[i] = (unsigned)(R * lda + C) * 2u; voffB[i] = (unsigned)(Rb * ldb + C) * 2u; }
    const size_t kstepB = g.kstrB ? g.kstrB : (size_t)(BK * 2), kstepA = g.kstrA ? g.kstrA : (size_t)(BK * 2);
    const size_t hstepA = (size_t)HALF * lda * 2, hstepB = (size_t)HALF * ldb * 2;
    const size_t tstepA = 2 * hstepA, tstepB = 2 * hstepB;
    const unsigned ldsw = (unsigned)wid * 1024u;
    const int aoff = lds_byte(wr * 64 + fr, fq * 8), boff = lds_byte(wc * 32 + fr, fq * 8);
#define PG8_SA(b, h) (((b) * 2 + (h)) * HTB)
#define PG8_SB(b, h) ((4 + (b) * 2 + (h)) * HTB)
#define PG8_STAGE(bufoff, gbase, voff) do { _Pragma("unroll") for (int _i = 0; _i < 2; ++_i) \
        __builtin_amdgcn_global_load_lds((const unsigned*)((const char*)(gbase) + (voff)[_i]), (PG8_LAS unsigned*)(lds + (bufoff) + ldsw + _i * 8192), 16, 0, 0); } while (0)
#define PG8_LDA(dst, b, h) do { _Pragma("unroll") for (int m = 0; m < 4; ++m) _Pragma("unroll") for (int k = 0; k < 2; ++k) dst[m][k] = *(const PG8_LAS bf16x8*)(lds + PG8_SA(b, h) + aoff + m * 2048 + k * 1024); } while (0)
#define PG8_LDB(dst, b, h) do { _Pragma("unroll") for (int n = 0; n < 2; ++n) _Pragma("unroll") for (int k = 0; k < 2; ++k) dst[n][k] = *(const PG8_LAS bf16x8*)(lds + PG8_SB(b, h) + boff + n * 2048 + k * 1024); } while (0)
#define PG8_MMA(ai, bj, At, Bt) do { __builtin_amdgcn_s_setprio(1); _Pragma("unroll") for (int m = 0; m < 4; ++m) _Pragma("unroll") for (int n = 0; n < 2; ++n) _Pragma("unroll") for (int k = 0; k < 2; ++k) \
        acc[ai][bj][m][n] = __builtin_amdgcn_mfma_f32_16x16x32_bf16(Bt[n][k], At[m][k], acc[ai][bj][m][n], 0, 0, 0); __builtin_amdgcn_s_setprio(0); } while (0)
#define PG8_WAIT_V(n) asm volatile("s_waitcnt vmcnt(" #n ")" ::: "memory")
#define PG8_WAIT_L(n) asm volatile("s_waitcnt lgkmcnt(" #n ")" ::: "memory")
#define PG8_BAR __builtin_amdgcn_s_barrier()
#define PG8_SCHED __builtin_amdgcn_sched_barrier(0)
    Unit cur, nxt; int ui = 0;
    if (!S.next(0, cur)) return;
    f32x4 acc[2][2][4][2];
#pragma unroll
    for (int a = 0; a < 2; ++a)
#pragma unroll
        for (int b = 0; b < 2; ++b)
#pragma unroll
            for (int m = 0; m < 4; ++m)
#pragma unroll
                for (int n = 0; n < 2; ++n) acc[a][b][m][n] = (f32x4){0.f, 0.f, 0.f, 0.f};
    bf16x8 At[4][2], B0[2][2], B1[2][2];
    const char* cA = (const char*)g.A + (size_t)cur.pm * tstepA; const char* cB = (const char*)g.Bt + (size_t)cur.pn * tstepB;
    S.a_ready(cur);
    if constexpr (Epi::PREFETCH) E.prefetch(cur, 0, wid, lane);
    if constexpr (SP2) {
        PG8_STAGE(PG8_SB(0, 0), cB, voffB); PG8_STAGE(PG8_SB(0, 1), cB + hstepB, voffB); PG8_STAGE(PG8_SA(0, 0), cA, voffA); PG8_STAGE(PG8_SA(0, 1), cA + hstepA, voffA);
        if (wr == 1) PG8_BAR;
        PG8_WAIT_V(2); PG8_BAR;
        PG8_STAGE(PG8_SB(1, 0), cB + kstepB, voffB); PG8_STAGE(PG8_SA(1, 0), cA + kstepA, voffA); PG8_STAGE(PG8_SB(1, 1), cB + hstepB + kstepB, voffB);
        PG8_WAIT_V(6); PG8_BAR;
    } else {
        PG8_STAGE(PG8_SB(0, 0), cB, voffB); PG8_STAGE(PG8_SA(0, 0), cA, voffA); PG8_STAGE(PG8_SB(0, 1), cB + hstepB, voffB); PG8_STAGE(PG8_SA(0, 1), cA + hstepA, voffA);
        if (wr == 1) PG8_BAR;
        PG8_WAIT_V(4); PG8_BAR;
        PG8_STAGE(PG8_SB(1, 0), cB + kstepB, voffB); PG8_STAGE(PG8_SA(1, 0), cA + kstepA, voffA); PG8_STAGE(PG8_SB(1, 1), cB + hstepB + kstepB, voffB);
        PG8_WAIT_V(6); PG8_BAR;
    }
    for (;;) {
        const bool has_next = S.next(ui + 1, nxt);
        const char* nA = has_next ? (const char*)g.A + (size_t)nxt.pm * tstepA : cA; const char* nB = has_next ? (const char*)g.Bt + (size_t)nxt.pn * tstepB : cB;
        for (int t = 0; t < nt; t += 2) {
            const bool last = (t == nt - 2);
            const char* a1 = cA + (size_t)(t + 1) * kstepA;
            const char* a2 = last ? nA : cA + (size_t)(t + 2) * kstepA; const char* b2 = last ? nB : cB + (size_t)(t + 2) * kstepB;
            const char* a3 = a2 + kstepA; const char* b3 = b2 + kstepB;
            if (last && has_next) { S.a_ready(nxt); if constexpr (Epi::PREFETCH) E.prefetch(nxt, (ui + 1) & 1, wid, lane); }
            if constexpr (SP2) {
            PG8_LDB(B0, 0, 0); PG8_LDB(B1, 0, 1); PG8_SCHED; PG8_LDA(At, 0, 0); PG8_STAGE(PG8_SA(1, 1), a1 + hstepA, voffA);
            PG8_WAIT_V(8); PG8_WAIT_L(0); PG8_BAR; PG8_MMA(0, 0, At, B0); PG8_MMA(0, 1, At, B1); PG8_BAR; PG8_SCHED;
            PG8_LDA(At, 0, 1); PG8_STAGE(PG8_SB(0, 0), b2, voffB); PG8_STAGE(PG8_SB(0, 1), b2 + hstepB, voffB); PG8_STAGE(PG8_SA(0, 0), a2, voffA);
            PG8_WAIT_V(8); PG8_WAIT_L(0); PG8_BAR; PG8_MMA(1, 0, At, B0); PG8_MMA(1, 1, At, B1); PG8_BAR; PG8_SCHED;
            PG8_LDB(B0, 1, 0); PG8_LDB(B1, 1, 1); PG8_SCHED; PG8_LDA(At, 1, 0); PG8_STAGE(PG8_SA(0, 1), a2 + hstepA, voffA);
            PG8_WAIT_V(8); PG8_WAIT_L(0); PG8_BAR; PG8_MMA(0, 0, At, B0); PG8_MMA(0, 1, At, B1); PG8_BAR; PG8_SCHED;
            PG8_LDA(At, 1, 1); PG8_STAGE(PG8_SB(1, 0), b3, voffB); PG8_STAGE(PG8_SB(1, 1), b3 + hstepB, voffB); PG8_STAGE(PG8_SA(1, 0), a3, voffA);
            PG8_WAIT_V(8); PG8_WAIT_L(0); PG8_BAR; PG8_MMA(1, 0, At, B0); PG8_MMA(1, 1, At, B1); PG8_BAR; PG8_SCHED;
            } else {
            PG8_LDB(B0, 0, 0); PG8_SCHED; PG8_LDA(At, 0, 0); PG8_STAGE(PG8_SA(1, 1), a1 + hstepA, voffA);
            PG8_WAIT_L(8); PG8_BAR; PG8_WAIT_L(0); PG8_MMA(0, 0, At, B0); PG8_BAR; PG8_SCHED;
            PG8_LDB(B1, 0, 1); PG8_STAGE(PG8_SB(0, 0), b2, voffB);
            PG8_BAR; PG8_WAIT_L(0); PG8_MMA(0, 1, At, B1); PG8_BAR;
            PG8_LDA(At, 0, 1); PG8_STAGE(PG8_SA(0, 0), a2, voffA);
            PG8_BAR; PG8_WAIT_L(0); PG8_MMA(1, 0, At, B0); PG8_BAR; PG8_SCHED;
            PG8_STAGE(PG8_SB(0, 1), b2 + hstepB, voffB);
            PG8_WAIT_V(6); PG8_BAR; PG8_MMA(1, 1, At, B1); PG8_BAR;
            PG8_LDB(B0, 1, 0); PG8_SCHED; PG8_LDA(At, 1, 0); PG8_STAGE(PG8_SA(0, 1), a2 + hstepA, voffA);
            PG8_WAIT_L(8); PG8_BAR; PG8_WAIT_L(0); PG8_MMA(0, 0, At, B0); PG8_BAR; PG8_SCHED;
            PG8_LDB(B1, 1, 1); PG8_STAGE(PG8_SB(1, 0), b3, voffB);
            PG8_BAR; PG8_WAIT_L(0); PG8_MMA(0, 1, At, B1); PG8_BAR;
            PG8_LDA(At, 1, 1); PG8_STAGE(PG8_SA(1, 0), a3, voffA);
            PG8_BAR; PG8_WAIT_L(0); PG8_MMA(1, 0, At, B0); PG8_BAR; PG8_SCHED;
            PG8_STAGE(PG8_SB(1, 1), b3 + hstepB, voffB);
            PG8_WAIT_V(6); PG8_BAR; PG8_MMA(1, 1, At, B1); PG8_BAR;
            }
        }
        if constexpr (ALIGN_EPI) { if (wr == 0) PG8_BAR; }
        if constexpr (!Epi::AFTER_DRAIN) { if constexpr (Epi::PREFETCH) E(acc, cur, wr, wc, fr, fq, ui & 1); else E(acc, cur, wr, wc, fr, fq); S.done(cur); }
        if (!has_next) break;
#pragma unroll
        for (int a = 0; a < 2; ++a)
#pragma unroll
            for (int b = 0; b < 2; ++b)
#pragma unroll
                for (int m = 0; m < 4; ++m)
#pragma unroll
                    for (int n = 0; n < 2; ++n) acc[a][b][m][n] = (f32x4){0.f, 0.f, 0.f, 0.f};
        cur = nxt; cA = nA; cB = nB; ++ui;
        if constexpr (ALIGN_EPI) { if (wr == 1) PG8_BAR; }
    }
    PG8_WAIT_V(0);
    if constexpr (!ALIGN_EPI) { if (wr == 0) PG8_BAR; }
    PG8_BAR;
    if constexpr (Epi::AFTER_DRAIN) { E.fused(acc, cur, wr, wc, fr, fq, lds, wid, lane); S.done(cur); }
#undef PG8_SA
#undef PG8_SB
#undef PG8_STAGE
#undef PG8_LDA
#undef PG8_LDB
#undef PG8_MMA
#undef PG8_WAIT_V
#undef PG8_WAIT_L
#undef PG8_BAR
#undef PG8_SCHED
}
}

#define GAS __attribute__((address_space(1)))
#define LAS __attribute__((address_space(3)))
typedef unsigned short bf16;
typedef unsigned v4u __attribute__((ext_vector_type(4)));
typedef unsigned v2u __attribute__((ext_vector_type(2)));
typedef float f32x4 __attribute__((ext_vector_type(4)));
typedef short bf16x8 __attribute__((ext_vector_type(8)));
typedef GAS unsigned gu32;
typedef GAS unsigned long long gu64;
#define RLX_AGENT __ATOMIC_RELAXED, __HIP_MEMORY_SCOPE_AGENT
#define LDS_WAIT() asm volatile("s_waitcnt lgkmcnt(0)" ::: "memory")
#define VM_WAIT() asm volatile("s_waitcnt vmcnt(0)" ::: "memory")
__device__ __forceinline__ unsigned long long rt() { return __builtin_amdgcn_s_memrealtime(); }
__device__ __forceinline__ unsigned f2bf(float f) { unsigned u = __builtin_bit_cast(unsigned, f); return (u + 0x7fffu + ((u >> 16) & 1u)) >> 16; }
__device__ __forceinline__ unsigned pk2(float lo, float hi) { return f2bf(lo) | (f2bf(hi) << 16); }

#define XB_TMO      128
#define XB_XCNT(j)  (256  + 64 * (j))
#define XB_XSUB(j)  (1280 + 64 * (j))
#define XB_XGEN(j)  (2304 + 64 * (j))
#define XB_TOP      3328
#define XB_TOPGEN   3392
#define XCD_BAR_WORDS 3456
#define XB_SPIN_CAP (1u << 18)

__device__ __forceinline__ unsigned xb_ld(unsigned* p)              { return __hip_atomic_load(p, __ATOMIC_RELAXED, __HIP_MEMORY_SCOPE_AGENT); }
__device__ __forceinline__ unsigned xb_add(unsigned* p, unsigned v) { return __hip_atomic_fetch_add(p, v, __ATOMIC_RELAXED, __HIP_MEMORY_SCOPE_AGENT); }
__device__ __forceinline__ unsigned xb_xcc_id() { return (unsigned)__builtin_amdgcn_s_getreg((3 << 11) | 20) & 0xFu; }
#define XB_SPIN(cond, bar) do { unsigned _sp = 0; while (cond) { __builtin_amdgcn_s_sleep(1); \
    if ((++_sp & 255u) == 0u) { if (xb_ld(&(bar)[XB_TMO])) break; if (_sp > XB_SPIN_CAP) { atomicAdd(&(bar)[XB_TMO], 1u); break; } } } } while (0)

struct XcdBarrier {
    unsigned* bar; unsigned x;
    volatile LAS unsigned* st;
};

__device__ __forceinline__ XcdBarrier xcd_barrier_post(unsigned* bar, volatile LAS unsigned* st) {
    XcdBarrier b; b.bar = bar; b.x = xb_xcc_id(); b.st = st;
    if (threadIdx.x == 0) (void)xb_add(&bar[XB_XCNT(b.x)], 1u);
    return b;
}
__device__ __forceinline__ void xcd_barrier_complete(unsigned* bar, unsigned x, unsigned& nloc, unsigned& nx) {
    const unsigned G = gridDim.x * gridDim.y * gridDim.z;
    unsigned sum, cnt, mine, sp = 0u;
    for (;;) {
        sum = 0u; cnt = 0u; mine = 0u;
#pragma unroll
        for (unsigned j = 0; j < 16; ++j) { const unsigned c = xb_ld(&bar[XB_XCNT(j)]); sum += c; cnt += (c > 0u) ? 1u : 0u; mine = (j == x) ? c : mine; }
        if (sum == G) break;
        __builtin_amdgcn_s_sleep(1);
        if ((++sp & 255u) == 0u) { if (xb_ld(&bar[XB_TMO])) break; if (sp > XB_SPIN_CAP) { atomicAdd(&bar[XB_TMO], 1u); break; } }
    }
    nloc = mine > 0u ? mine : 1u; nx = cnt > 0u ? cnt : 1u;
}

__device__ __forceinline__ void xcd_barrier(const XcdBarrier& b, bool is_t0) {
    asm volatile("s_waitcnt vmcnt(0)" ::: "memory");
    __syncthreads();
    if (is_t0) {
        unsigned* bar = b.bar;
        __builtin_amdgcn_s_waitcnt(0);
        unsigned nloc = b.st[0], nx = b.st[1];
        if (nloc == 0u) { xcd_barrier_complete(bar, b.x, nloc, nx); b.st[0] = nloc; b.st[1] = nx; }
        const unsigned old = xb_add(&bar[XB_XSUB(b.x)], 1u);
        const unsigned gen = old / nloc;
        if (old + 1u == (gen + 1u) * nloc) {
            __builtin_amdgcn_fence(__ATOMIC_RELEASE, "agent");
            asm volatile("s_waitcnt vmcnt(0)" ::: "memory");
            const unsigned og = xb_add(&bar[XB_TOP], 1u);
            const unsigned tg = og / nx;
            if (og + 1u == (tg + 1u) * nx) xb_add(&bar[XB_TOPGEN], 1u);
            else XB_SPIN(xb_ld(&bar[XB_TOPGEN]) == tg, bar);
            __builtin_amdgcn_fence(__ATOMIC_ACQUIRE, "agent");
            xb_add(&bar[XB_XGEN(b.x)], 1u);
            asm volatile("s_waitcnt vmcnt(0)" ::: "memory");
        } else {
            XB_SPIN(xb_ld(&bar[XB_XGEN(b.x)]) == gen, bar);
            __builtin_amdgcn_fence(__ATOMIC_ACQUIRE, "agent");
            asm volatile("s_waitcnt vmcnt(0)" ::: "memory");
        }
    }
    __syncthreads();
}


constexpr int NB = 16, T = 4096, D = 1024, DEPTH = 4, M = NB * T;
constexpr int HD = 64, H_HGRN = 6, H_FOX = 6, H_RET = 4;
constexpr int IN_COLS = 4102, NP = 4096, D_FF = 2816, NUP = 2 * D_FF;
constexpr float EPS = 1e-6f;
constexpr int OC_AQ = 0, OC_AF = 384, OC_AI = 768, OC_AG = 1152, OC_BQ = 1536, OC_BK = 1920, OC_BV = 2304, OC_BF = 2688, OC_BG = 2694, OC_CQ = 3078, OC_CK = 3334, OC_CV = 3590, OC_CG = 3846;
constexpr int PC_AQ = 0, PC_BQ = 384, PC_CQ = 768, PC_AF = 1024, PC_AI = 1408, PC_AG = 1792, PC_BK = 2176, PC_BV = 2560, PC_BG = 2944, PC_CK = 3328, PC_CV = 3584, PC_CG = 3840;
#define CB(pc) ((size_t)((pc) >> 6) * (size_t)M * 64)
__device__ __forceinline__ int pcol_to_orig(int n) {
    if (n < 384) return OC_AQ + n; if (n < 768) return OC_BQ + (n - 384); if (n < 1024) return OC_CQ + (n - 768);
    if (n < 1408) return OC_AF + (n - 1024); if (n < 1792) return OC_AI + (n - 1408); if (n < 2176) return OC_AG + (n - 1792);
    if (n < 2560) return OC_BK + (n - 2176); if (n < 2944) return OC_BV + (n - 2560); if (n < 3328) return OC_BG + (n - 2944);
    if (n < 3584) return OC_CK + (n - 3328); if (n < 3840) return OC_CV + (n - 3584); return OC_CG + (n - 3840);
}
constexpr size_t MiB = 1u << 20;
constexpr size_t WS_CTL = 0, CTL_ZERO_BYTES = 1 * MiB;
constexpr size_t WS_WIN = 2 * MiB, WS_WOUT = 34 * MiB, WS_WUP = 42 * MiB, WS_WDN = 86 * MiB;
constexpr size_t WS_WF = 108 * MiB;
constexpr size_t WS_COS = 109 * MiB, WS_SIN = WS_COS + 512 * 1024;
constexpr size_t WS_LB = 110 * MiB;
constexpr size_t WS_LOGF = 111 * MiB;
constexpr size_t WS_FCUM = 113 * MiB;
constexpr size_t WS_H = 116 * MiB;
constexpr size_t WS_MIX = 244 * MiB;
constexpr size_t WS_P = 372 * MiB;
constexpr size_t WS_ACT = WS_P;
constexpr size_t WS_EDGEL = WS_P + 352 * MiB, WS_EDGEP = WS_P + 364 * MiB;
constexpr size_t WS_SLOT1 = WS_MIX, WS_SLOT2 = WS_MIX + 1 * MiB, WS_LPART = WS_MIX + 2 * MiB;
constexpr size_t WS_XB = 884 * MiB;
constexpr size_t WS_RS = 114 * MiB + 512 * 1024;
constexpr size_t WS_END = 1012 * MiB;
constexpr int CW_BAR = 4096, CW_QUEUE = 16384, CW_FLAGS = 20480, CW_CNT = 65536;
constexpr int RING_BYTES = 131072, LDSCTL_OFF = RING_BYTES, MISC_OFF = LDSCTL_OFF + 320, HALO_OFF = RING_BYTES + 1024, GAIN_OFF = RING_BYTES + 10240, LGL_OFF = RING_BYTES + 6400, LDS_BYTES = 163840;
constexpr int NWAVES = 8;

__device__ __forceinline__ float wave_sum(float v, int lane) {
    (void)lane;
    v += dppf<0xB1>(v); v += dppf<0x4E>(v); v += dppf<0x141>(v); v += dppf<0x140>(v);
    { auto r = __builtin_amdgcn_permlane16_swap(__float_as_uint(v), __float_as_uint(v), false, false); v = __uint_as_float(r[0]) + __uint_as_float(r[1]); }
    { auto r = __builtin_amdgcn_permlane32_swap(__float_as_uint(v), __float_as_uint(v), false, false); v = __uint_as_float(r[0]) + __uint_as_float(r[1]); }
    return v;
}
__device__ __forceinline__ float bf_lo(unsigned w) { return __uint_as_float(w << 16); }
__device__ __forceinline__ float bf_hi(unsigned w) { return __uint_as_float(w & 0xffff0000u); }
__device__ __forceinline__ float bf1(bf16 w) { return __uint_as_float(((unsigned)w) << 16); }

__device__ __forceinline__ void tr_item(const float* W, int ldw, int src_col0, int k0, bf16* WT, int ldt, int dst_row0_, LAS float* scr, int lane, const float* gk = nullptr, bool ilv = false, bool wperm = false) {
    const int dst_row0 = wperm ? ((dst_row0_ & ~255) | (((dst_row0_ >> 5) & 1) << 7) | (((dst_row0_ >> 6) & 3) << 5)) : dst_row0_;
    const int j_ = lane & 31, scol = src_col0 + (ilv ? ((j_ & 1) ? (j_ >> 1) + 32 : (j_ >> 1)) : j_);
    float wv[32];
#pragma unroll
    for (int i = 0; i < 32; ++i) { const int kk = 2 * i + (lane >> 5); wv[i] = W[(size_t)(k0 + kk) * ldw + scol]; }
    asm volatile("" ::: "memory");
#pragma unroll
    for (int i = 0; i < 32; ++i) { const int kk = 2 * i + (lane >> 5); scr[kk * 33 + (lane & 31)] = wv[i] * (gk ? gk[k0 + kk] : 1.0f); }
    LDS_WAIT(); asm volatile("" ::: "memory");
    const int c = lane & 7;
#pragma unroll
    for (int j = 0; j < 4; ++j) { const int n = (lane >> 3) + 8 * j; const LAS float* s = scr + (8 * c) * 33 + n;
        v4u o; o.x = pk2(s[0 * 33], s[1 * 33]); o.y = pk2(s[2 * 33], s[3 * 33]); o.z = pk2(s[4 * 33], s[5 * 33]); o.w = pk2(s[6 * 33], s[7 * 33]);
        *(GAS v4u*)(WT + ((size_t)(k0 >> 6) * ldt + dst_row0 + n) * 64 + 8 * c) = o; }
    LDS_WAIT(); asm volatile("" ::: "memory");
}

struct TrP { const float* W; int ldw, scol0, k0; bf16* WT; int ldt, drow; const float* gk; bool ilv, wperm; };
__device__ __forceinline__ void tr_load(float (&wv)[32], f32x4 (&g8)[2], const TrP& p, int lane) {
    const int j_ = lane & 31, scol = p.scol0 + (p.ilv ? ((j_ & 1) ? (j_ >> 1) + 32 : (j_ >> 1)) : j_);
#pragma unroll
    for (int i = 0; i < 32; ++i) { const int kk = 2 * i + (lane >> 5); wv[i] = p.W[(size_t)(p.k0 + kk) * p.ldw + scol]; }
    g8[0] = (f32x4){1.f, 1.f, 1.f, 1.f}; g8[1] = g8[0];
    if (p.gk) { g8[0] = *(const f32x4*)(p.gk + p.k0 + 8 * (lane & 7)); g8[1] = *(const f32x4*)(p.gk + p.k0 + 8 * (lane & 7) + 4); }
}
__device__ __forceinline__ void tr_finish(const float (&wv)[32], const f32x4 (&g8)[2], const TrP& p, LAS float* scr, int lane) {
    const int dst_row0 = p.wperm ? ((p.drow & ~255) | (((p.drow >> 5) & 1) << 7) | (((p.drow >> 6) & 3) << 5)) : p.drow;
#pragma unroll
    for (int i = 0; i < 32; ++i) { const int kk = 2 * i + (lane >> 5); scr[kk * 33 + (lane & 31)] = wv[i]; }
    LDS_WAIT(); asm volatile("" ::: "memory");
    const int c = lane & 7;
#pragma unroll
    for (int j = 0; j < 4; ++j) { const int n = (lane >> 3) + 8 * j; const LAS float* s_ = scr + (8 * c) * 33 + n;
        v4u o; o.x = pk2(s_[0 * 33] * g8[0][0], s_[1 * 33] * g8[0][1]); o.y = pk2(s_[2 * 33] * g8[0][2], s_[3 * 33] * g8[0][3]); o.z = pk2(s_[4 * 33] * g8[1][0], s_[5 * 33] * g8[1][1]); o.w = pk2(s_[6 * 33] * g8[1][2], s_[7 * 33] * g8[1][3]);
        *(GAS v4u*)(p.WT + ((size_t)(p.k0 >> 6) * p.ldt + dst_row0 + n) * 64 + 8 * c) = o; }
    LDS_WAIT(); asm volatile("" ::: "memory");
}

__device__ __forceinline__ float log_sigmoid_f(float v) { return fminf(v, 0.f) - 0.6931471805599453f * __builtin_amdgcn_logf(1.0f + __builtin_amdgcn_exp2f(-fabsf(v) * 1.4426950408889634f)); }

template <int R> __device__ __forceinline__ void row_updateNx(int lane, size_t m, size_t dm, const float* xf_base, const bf16* xb_base, const bf16* add_base, const float* gpost,
                                             bf16* xb_obase, float* xf_obase, float* rs_base, const float* wf, const float* bfox, float* logf_base, const f32x4 (*pre)[4] = nullptr) {
    const float bfl = wf ? bfox[lane < 6 ? lane : 0] : 0.f;
    f32x4 v[R][4];
#pragma unroll
    for (int r = 0; r < R; ++r) { const size_t row = m + r * dm;
        if (pre) {
#pragma unroll
            for (int j = 0; j < 4; ++j) v[r][j] = pre[r][j];
        } else if (xf_base) {
#pragma unroll
            for (int j = 0; j < 4; ++j) v[r][j] = *(const f32x4*)(xf_base + row * D + 4 * lane + 256 * j);
        } else {
#pragma unroll
            for (int j = 0; j < 4; ++j) { const uint2 w = *(const uint2*)(xb_base + row * D + 4 * lane + 256 * j); v[r][j] = (f32x4){bf_lo(w.x), bf_hi(w.x), bf_lo(w.y), bf_hi(w.y)}; }
        } }
    if (add_base) {
        f32x4 a[R][4]; float ss[R];
#pragma unroll
        for (int r = 0; r < R; ++r) ss[r] = 0.f;
#pragma unroll
        for (int r = 0; r < R; ++r)
#pragma unroll
            for (int j = 0; j < 4; ++j) { const uint2 w = *(const uint2*)(add_base + (m + r * dm) * D + 4 * lane + 256 * j); a[r][j] = (f32x4){bf_lo(w.x), bf_hi(w.x), bf_lo(w.y), bf_hi(w.y)};
                ss[r] += (a[r][j].x * a[r][j].x + a[r][j].y * a[r][j].y) + (a[r][j].z * a[r][j].z + a[r][j].w * a[r][j].w); }
        f32x4 g[4];
#pragma unroll
        for (int j = 0; j < 4; ++j) g[j] = *(const f32x4*)(gpost + 4 * lane + 256 * j);
#pragma unroll
        for (int r = 0; r < R; ++r) { const float rs = 1.0f / sqrtf(wave_sum(ss[r], lane) * (1.f / D) + EPS);
#pragma unroll
            for (int j = 0; j < 4; ++j) v[r][j] = v[r][j] + a[r][j] * rs * g[j]; }
    }
#pragma unroll
    for (int r = 0; r < R; ++r) { const size_t row = m + r * dm;
        if (xf_obase) {
#pragma unroll
            for (int j = 0; j < 4; ++j) *(f32x4*)(xf_obase + row * D + 4 * lane + 256 * j) = v[r][j];
        }
        if (xb_obase) {
#pragma unroll
            for (int j = 0; j < 4; ++j) { uint2 w; w.x = pk2(v[r][j].x, v[r][j].y); w.y = pk2(v[r][j].z, v[r][j].w); *(uint2*)(xb_obase + ((size_t)(4 * j + (lane >> 4)) * M + row) * 64 + ((4 * lane) & 63)) = w; }
        } }
    if (rs_base) {
        float rs[R];
#pragma unroll
        for (int r = 0; r < R; ++r) { float ss = 0.f;
#pragma unroll
            for (int j = 0; j < 4; ++j) ss += (v[r][j].x * v[r][j].x + v[r][j].y * v[r][j].y) + (v[r][j].z * v[r][j].z + v[r][j].w * v[r][j].w);
            const float sst = wave_sum(ss, lane); rs[r] = 1.0f / sqrtf(sst * (1.f / D) + EPS);
            if (lane == 0) *(f32x4*)(rs_base + 4 * (m + r * dm)) = (f32x4){sst, 0.f, 0.f, 0.f}; }
        if (wf) {
            float mine[R];
#pragma unroll
            for (int r = 0; r < R; ++r) mine[r] = 0.f;
#pragma unroll
            for (int jj = 0; jj < 6; ++jj) { f32x4 w[4];
#pragma unroll
                for (int j = 0; j < 4; ++j) w[j] = *(const f32x4*)(wf + jj * 1024 + 4 * lane + 256 * j);
#pragma unroll
                for (int r = 0; r < R; ++r) { float d = 0.f;
#pragma unroll
                    for (int j = 0; j < 4; ++j) d += (v[r][j].x * w[j].x + v[r][j].y * w[j].y) + (v[r][j].z * w[j].z + v[r][j].w * w[j].w);
                    d = wave_sum(d, lane); if (lane == jj) mine[r] = d; } }
            if (lane < 6) {
#pragma unroll
                for (int r = 0; r < R; ++r) logf_base[(m + r * dm) * 8 + lane] = log_sigmoid_f(mine[r] * rs[r] + bfl); }
        }
    }
}


template <int R> __device__ __forceinline__ void row_pass_pf(int lane, int gw, int NGW, bf16* XB, const bf16* MIXp, const float* gpost, bool write_xb, float* xf_obase, float* rs_base,
                                                             const float* wf, const float* bfox, float* logf_base) {
    uint2 xr[R][4], ar[R][4];
    const size_t step = (size_t)R * NGW; size_t m = (size_t)R * gw;
#pragma unroll
    for (int r = 0; r < R; ++r)
#pragma unroll
        for (int j = 0; j < 4; ++j) { xr[r][j] = *(const uint2*)(XB + (m + r) * D + 4 * lane + 256 * j); ar[r][j] = *(const uint2*)(MIXp + (m + r) * D + 4 * lane + 256 * j); }
    f32x4 g[4];
#pragma unroll
    for (int j = 0; j < 4; ++j) g[j] = *(const f32x4*)(gpost + 4 * lane + 256 * j);
    for (; m < (size_t)M; m += step) {
        f32x4 v[R][4], a[R][4]; float ss[R];
#pragma unroll
        for (int r = 0; r < R; ++r) { ss[r] = 0.f;
#pragma unroll
            for (int j = 0; j < 4; ++j) { v[r][j] = (f32x4){bf_lo(xr[r][j].x), bf_hi(xr[r][j].x), bf_lo(xr[r][j].y), bf_hi(xr[r][j].y)}; a[r][j] = (f32x4){bf_lo(ar[r][j].x), bf_hi(ar[r][j].x), bf_lo(ar[r][j].y), bf_hi(ar[r][j].y)};
                ss[r] += (a[r][j].x * a[r][j].x + a[r][j].y * a[r][j].y) + (a[r][j].z * a[r][j].z + a[r][j].w * a[r][j].w); } }
        const size_t mn = m + step;
        if (mn < (size_t)M) {
#pragma unroll
            for (int r = 0; r < R; ++r)
#pragma unroll
                for (int j = 0; j < 4; ++j) { xr[r][j] = *(const uint2*)(XB + (mn + r) * D + 4 * lane + 256 * j); ar[r][j] = *(const uint2*)(MIXp + (mn + r) * D + 4 * lane + 256 * j); } }
        asm volatile("" ::: "memory");
        float rs2[R], s2t[R];
#pragma unroll
        for (int r = 0; r < R; ++r) { const float rs = 1.0f / sqrtf(wave_sum(ss[r], lane) * (1.f / D) + EPS); float s2 = 0.f;
#pragma unroll
            for (int j = 0; j < 4; ++j) { v[r][j] = v[r][j] + a[r][j] * rs * g[j]; s2 += (v[r][j].x * v[r][j].x + v[r][j].y * v[r][j].y) + (v[r][j].z * v[r][j].z + v[r][j].w * v[r][j].w); }
            s2t[r] = wave_sum(s2, lane); rs2[r] = 1.0f / sqrtf(s2t[r] * (1.f / D) + EPS); }
#pragma unroll
        for (int r = 0; r < R; ++r) {
            if (write_xb) {
#pragma unroll
                for (int j = 0; j < 4; ++j) { uint2 w; w.x = pk2(v[r][j].x, v[r][j].y); w.y = pk2(v[r][j].z, v[r][j].w); *(uint2*)(XB + (m + r) * D + 4 * lane + 256 * j) = w; }
            } else {
#pragma unroll
                for (int j = 0; j < 4; ++j) *(f32x4*)(xf_obase + (m + r) * D + 4 * lane + 256 * j) = v[r][j];
            }
            if (rs_base && lane == 0) *(f32x4*)(rs_base + 4 * (m + r)) = (f32x4){s2t[r], 0.f, 0.f, 0.f}; }
        if (wf) {
            float mine[R];
#pragma unroll
            for (int r = 0; r < R; ++r) mine[r] = 0.f;
#pragma unroll
            for (int jj = 0; jj < 6; ++jj) { f32x4 w[4];
#pragma unroll
                for (int j = 0; j < 4; ++j) w[j] = *(const f32x4*)(wf + jj * 1024 + 4 * lane + 256 * j);
#pragma unroll
                for (int r = 0; r < R; ++r) { float d = 0.f;
#pragma unroll
                    for (int j = 0; j < 4; ++j) d += (v[r][j].x * w[j].x + v[r][j].y * w[j].y) + (v[r][j].z * w[j].z + v[r][j].w * w[j].w);
                    d = wave_sum(d, lane); if (lane == jj) mine[r] = d; } }
            if (lane < 6) {
#pragma unroll
                for (int r = 0; r < R; ++r) logf_base[(m + r) * 8 + lane] = log_sigmoid_f(mine[r] * rs2[r] + bfox[lane]); }
        }
    }
}

namespace pg8 {
__device__ __forceinline__ float fq_sum(float v) {
    { auto r = __builtin_amdgcn_permlane16_swap(__float_as_uint(v), __float_as_uint(v), false, false); v = __uint_as_float(r[0]) + __uint_as_float(r[1]); }
    { auto r = __builtin_amdgcn_permlane32_swap(__float_as_uint(v), __float_as_uint(v), false, false); v = __uint_as_float(r[0]) + __uint_as_float(r[1]); }
    return v; }
struct EpiNormRes {
    static constexpr bool PERM = true, AFTER_DRAIN = false, PREFETCH = false;
    bf16_t* XB; const PG8_LAS float* gl; float* SLOT1; unsigned* CNT1; float* RS; PG8_LAS float* red;
    __device__ __forceinline__ void operator()(f32x4 (&acc)[2][2][4][2], const Unit& u, int wr, int wc, int fr, int fq) const {
        { const int l_ = fresh_lane(); fr = l_ & 15; fq = l_ >> 4; }
        const int tid = (wr * 4 + wc) * 64 + fq * 16 + fr, rl0 = wr * 64 + fr;
        PG8_LAS float* rowfac = red + 1024; volatile PG8_LAS unsigned* bc = (volatile PG8_LAS unsigned*)(red + 1280);
        const int col0 = u.pn * BM + wc * 64 + 8 * fq;
#pragma unroll
        for (int ai = 0; ai < 2; ++ai)
#pragma unroll
            for (int m = 0; m < 4; ++m) { float s = 0.f;
#pragma unroll
                for (int bj = 0; bj < 2; ++bj)
#pragma unroll
                    for (int n = 0; n < 2; ++n) { const f32x4 a = acc[ai][bj][m][n]; s += (a[0] * a[0] + a[1] * a[1]) + (a[2] * a[2] + a[3] * a[3]); }
                s = fq_sum(s); if (fq == 0) red[(rl0 + ai * HALF + m * 16) * 4 + wc] = s; }
        asm volatile("s_waitcnt lgkmcnt(0)" ::: "memory"); __builtin_amdgcn_s_barrier(); asm volatile("" ::: "memory");
        if (tid < 256) { const f32x4 q = *(const PG8_LAS f32x4*)(red + 4 * tid); __hip_atomic_store(SLOT1 + (size_t)(u.pm * 4 + u.pn) * 256 + tid, (q[0] + q[1]) + (q[2] + q[3]), __ATOMIC_RELAXED, __HIP_MEMORY_SCOPE_AGENT); }
        asm volatile("s_waitcnt vmcnt(0)" ::: "memory"); __builtin_amdgcn_s_barrier(); asm volatile("" ::: "memory");
        u32x4 xw[2][4][2];
#pragma unroll
        for (int ai = 0; ai < 2; ++ai)
#pragma unroll
            for (int m = 0; m < 4; ++m)
#pragma unroll
                for (int bj = 0; bj < 2; ++bj) xw[ai][m][bj] = *(const u32x4*)(XB + ((size_t)(col0 >> 6) * M + (u.pm * BM + rl0 + ai * HALF + m * 16)) * 64 + (col0 & 63) + 32 * bj);
        if (tid == 0) { unsigned* c = CNT1 + u.pm * 16; __hip_atomic_fetch_add(c, 1u, __ATOMIC_RELAXED, __HIP_MEMORY_SCOPE_AGENT); unsigned sp = 0u;
            while (__hip_atomic_load(c, __ATOMIC_RELAXED, __HIP_MEMORY_SCOPE_AGENT) < 4u) { __builtin_amdgcn_s_sleep(1); if (++sp > (1u << 22)) break; }
            __builtin_amdgcn_fence(__ATOMIC_ACQUIRE, "agent"); asm volatile("s_waitcnt vmcnt(0)" ::: "memory"); }
        __builtin_amdgcn_s_barrier(); asm volatile("" ::: "memory");
        if (tid < 256) { float tot = 0.f;
#pragma unroll
            for (int q = 0; q < 4; ++q) tot += SLOT1[(size_t)(u.pm * 4 + q) * 256 + tid];
            rowfac[tid] = __builtin_amdgcn_rsqf(tot * (1.f / 1024.f) + 1e-6f); }
        asm volatile("s_waitcnt lgkmcnt(0)" ::: "memory"); __builtin_amdgcn_s_barrier(); asm volatile("" ::: "memory");
#pragma unroll
        for (int ai = 0; ai < 2; ++ai)
#pragma unroll
            for (int m = 0; m < 4; ++m) { const int rl = rl0 + ai * HALF + m * 16; const float ry = rowfac[rl]; float s2 = 0.f;
#pragma unroll
                for (int bj = 0; bj < 2; ++bj) { const u32x4 xo = xw[ai][m][bj];
                    const PG8_LAS float* gp = gl + col0 + bj * 32;
                    f32x4 v0 = acc[ai][bj][m][0] * ry * *(const PG8_LAS f32x4*)gp, v1 = acc[ai][bj][m][1] * ry * *(const PG8_LAS f32x4*)(gp + 4);
                    v0[0] += __uint_as_float(xo.x << 16); v0[1] += __uint_as_float(xo.x & 0xffff0000u); v0[2] += __uint_as_float(xo.y << 16); v0[3] += __uint_as_float(xo.y & 0xffff0000u);
                    v1[0] += __uint_as_float(xo.z << 16); v1[1] += __uint_as_float(xo.z & 0xffff0000u); v1[2] += __uint_as_float(xo.w << 16); v1[3] += __uint_as_float(xo.w & 0xffff0000u);
                    s2 += ((v0[0] * v0[0] + v0[1] * v0[1]) + (v0[2] * v0[2] + v0[3] * v0[3])) + ((v1[0] * v1[0] + v1[1] * v1[1]) + (v1[2] * v1[2] + v1[3] * v1[3]));
                    acc[ai][bj][m][0] = v0; acc[ai][bj][m][1] = v1; }
                s2 = fq_sum(s2); if (fq == 0) red[rl * 4 + wc] = s2; }
        asm volatile("s_waitcnt lgkmcnt(0)" ::: "memory"); __builtin_amdgcn_s_barrier(); asm volatile("" ::: "memory");
        if (tid < 256) { const f32x4 q = *(const PG8_LAS f32x4*)(red + 4 * tid); RS[(size_t)(u.pm * BM + tid) * 4 + u.pn] = (q[0] + q[1]) + (q[2] + q[3]); }
#pragma unroll
        for (int ai = 0; ai < 2; ++ai)
#pragma unroll
            for (int m = 0; m < 4; ++m) { bf16_t* rowp = XB + ((size_t)(col0 >> 6) * M + (u.pm * BM + rl0 + ai * HALF + m * 16)) * 64 + (col0 & 63);
#pragma unroll
                for (int bj = 0; bj < 2; ++bj) { const f32x4 v0 = acc[ai][bj][m][0], v1 = acc[ai][bj][m][1];
                    u32x4 w; w.x = cvt_pk_bf16_v(v0[0], v0[1]); w.y = cvt_pk_bf16_v(v0[2], v0[3]); w.z = cvt_pk_bf16_v(v1[0], v1[1]); w.w = cvt_pk_bf16_v(v1[2], v1[3]);
                    *(u32x4*)(rowp + bj * 32) = w; } }
    }
};
struct EpiNormResFFN {
    static constexpr bool PERM = true, AFTER_DRAIN = false, PREFETCH = false;
    bf16_t* XB; const float* gain; float* SLOT1; unsigned* CNT1; float* RS; PG8_LAS float* red; float* XF; const float* WF; const float* bias; float* LPART; unsigned* CNT2; float* LOGF; PG8_LAS float* lgl;
    __device__ __forceinline__ void operator()(f32x4 (&acc)[2][2][4][2], const Unit& u, int wr, int wc, int fr, int fq) const {
        { const int l_ = fresh_lane(); fr = l_ & 15; fq = l_ >> 4; }
        const int tid = (wr * 4 + wc) * 64 + fq * 16 + fr, rl0 = wr * 64 + fr;
        PG8_LAS float* rowfac = red + 1024; volatile PG8_LAS unsigned* bc = (volatile PG8_LAS unsigned*)(red + 1280);
        const int col0 = u.pn * BM + wc * 64 + 8 * fq;
        lgl[tid] = gain[tid]; lgl[tid + 512] = gain[tid + 512];
#pragma unroll
        for (int ai = 0; ai < 2; ++ai)
#pragma unroll
            for (int m = 0; m < 4; ++m) { float s = 0.f;
#pragma unroll
                for (int bj = 0; bj < 2; ++bj)
#pragma unroll
                    for (int n = 0; n < 2; ++n) { const f32x4 a = acc[ai][bj][m][n]; s += (a[0] * a[0] + a[1] * a[1]) + (a[2] * a[2] + a[3] * a[3]); }
                s = fq_sum(s); if (fq == 0) red[(rl0 + ai * HALF + m * 16) * 4 + wc] = s; }
        asm volatile("s_waitcnt lgkmcnt(0)" ::: "memory"); __builtin_amdgcn_s_barrier(); asm volatile("" ::: "memory");
        if (tid < 256) { const f32x4 q = *(const PG8_LAS f32x4*)(red + 4 * tid); __hip_atomic_store(SLOT1 + (size_t)(u.pm * 4 + u.pn) * 256 + tid, (q[0] + q[1]) + (q[2] + q[3]), __ATOMIC_RELAXED, __HIP_MEMORY_SCOPE_AGENT); }
        asm volatile("s_waitcnt vmcnt(0)" ::: "memory"); __builtin_amdgcn_s_barrier(); asm volatile("" ::: "memory");
        u32x4 xw[2][4][2];
#pragma unroll
        for (int ai = 0; ai < 2; ++ai)
#pragma unroll
            for (int m = 0; m < 4; ++m)
#pragma unroll
                for (int bj = 0; bj < 2; ++bj) xw[ai][m][bj] = *(const u32x4*)(XB + ((size_t)(col0 >> 6) * M + (u.pm * BM + rl0 + ai * HALF + m * 16)) * 64 + (col0 & 63) + 32 * bj);
        if (tid == 0) { unsigned* c = CNT1 + u.pm * 16; __hip_atomic_fetch_add(c, 1u, __ATOMIC_RELAXED, __HIP_MEMORY_SCOPE_AGENT); unsigned sp = 0u;
            while (__hip_atomic_load(c, __ATOMIC_RELAXED, __HIP_MEMORY_SCOPE_AGENT) < 4u) { __builtin_amdgcn_s_sleep(1); if (++sp > (1u << 22)) break; }
            __builtin_amdgcn_fence(__ATOMIC_ACQUIRE, "agent"); asm volatile("s_waitcnt vmcnt(0)" ::: "memory"); }
        __builtin_amdgcn_s_barrier(); asm volatile("" ::: "memory");
        if (tid < 256) { float tot = 0.f;
#pragma unroll
            for (int q = 0; q < 4; ++q) tot += SLOT1[(size_t)(u.pm * 4 + q) * 256 + tid];
            rowfac[tid] = __builtin_amdgcn_rsqf(tot * (1.f / 1024.f) + 1e-6f); }
        asm volatile("s_waitcnt lgkmcnt(0)" ::: "memory"); __builtin_amdgcn_s_barrier(); asm volatile("" ::: "memory");
#pragma unroll
        for (int ai = 0; ai < 2; ++ai)
#pragma unroll
            for (int m = 0; m < 4; ++m) { const int rl = rl0 + ai * HALF + m * 16; const float ry = rowfac[rl]; float s2 = 0.f;
#pragma unroll
                for (int bj = 0; bj < 2; ++bj) { const u32x4 xo = xw[ai][m][bj];
                    const PG8_LAS float* gp = lgl + col0 + bj * 32;
                    f32x4 v0 = acc[ai][bj][m][0] * ry * *(const PG8_LAS f32x4*)gp, v1 = acc[ai][bj][m][1] * ry * *(const PG8_LAS f32x4*)(gp + 4);
                    v0[0] += __uint_as_float(xo.x << 16); v0[1] += __uint_as_float(xo.x & 0xffff0000u); v0[2] += __uint_as_float(xo.y << 16); v0[3] += __uint_as_float(xo.y & 0xffff0000u);
                    v1[0] += __uint_as_float(xo.z << 16); v1[1] += __uint_as_float(xo.z & 0xffff0000u); v1[2] += __uint_as_float(xo.w << 16); v1[3] += __uint_as_float(xo.w & 0xffff0000u);
                    s2 += ((v0[0] * v0[0] + v0[1] * v0[1]) + (v0[2] * v0[2] + v0[3] * v0[3])) + ((v1[0] * v1[0] + v1[1] * v1[1]) + (v1[2] * v1[2] + v1[3] * v1[3]));
                    acc[ai][bj][m][0] = v0; acc[ai][bj][m][1] = v1; }
                if (!XF) { s2 = fq_sum(s2); if (fq == 0) red[rl * 4 + wc] = s2; } }
        if (XF) {
            int rl0b = rl0, col0b = col0; asm volatile("" : "+v"(rl0b), "+v"(col0b));
#pragma unroll
            for (int ai = 0; ai < 2; ++ai)
#pragma unroll
                for (int m = 0; m < 4; ++m) { float* rowp = XF + (size_t)(u.pm * BM + rl0b + ai * HALF + m * 16) * 1024 + col0b;
#pragma unroll
                    for (int bj = 0; bj < 2; ++bj) { *(f32x4*)(rowp + bj * 32) = acc[ai][bj][m][0]; *(f32x4*)(rowp + bj * 32 + 4) = acc[ai][bj][m][1]; } }
            return; }
        f32x4 wfc[2][2], wfn[2][2];
#pragma unroll
        for (int bj = 0; bj < 2; ++bj)
#pragma unroll
            for (int n = 0; n < 2; ++n) wfc[bj][n] = *(const f32x4*)(WF + col0 + bj * 32 + 4 * n);
        asm volatile("s_waitcnt lgkmcnt(0)" ::: "memory"); __builtin_amdgcn_s_barrier(); asm volatile("" ::: "memory");
#pragma unroll
        for (int j = 0; j < 6; ++j) {
            if (j < 5) {
#pragma unroll
                for (int bj = 0; bj < 2; ++bj)
#pragma unroll
                    for (int n = 0; n < 2; ++n) wfn[bj][n] = *(const f32x4*)(WF + (j + 1) * 1024 + col0 + bj * 32 + 4 * n); }
#pragma unroll
            for (int ai = 0; ai < 2; ++ai)
#pragma unroll
                for (int m = 0; m < 4; ++m) { float d = 0.f;
#pragma unroll
                    for (int bj = 0; bj < 2; ++bj)
#pragma unroll
                        for (int n = 0; n < 2; ++n) { const f32x4 a = acc[ai][bj][m][n], w = wfc[bj][n]; d += (a[0] * w[0] + a[1] * w[1]) + (a[2] * w[2] + a[3] * w[3]); }
                    d = fq_sum(d); if (fq == 0) lgl[((rl0 + ai * HALF + m * 16) * 4 + wc) * 6 + j] = d; }
#pragma unroll
            for (int bj = 0; bj < 2; ++bj)
#pragma unroll
                for (int n = 0; n < 2; ++n) wfc[bj][n] = wfn[bj][n]; }
        asm volatile("s_waitcnt lgkmcnt(0)" ::: "memory"); __builtin_amdgcn_s_barrier(); asm volatile("" ::: "memory");
        if (tid < 256) { const f32x4 q = *(const PG8_LAS f32x4*)(red + 4 * tid); const float s2t = (q[0] + q[1]) + (q[2] + q[3]);
            RS[(size_t)(u.pm * BM + tid) * 4 + u.pn] = s2t;
            float* lp = LPART + ((size_t)(u.pm * 4 + u.pn) * 256 + tid) * 8; __hip_atomic_store(lp, s2t, __ATOMIC_RELAXED, __HIP_MEMORY_SCOPE_AGENT);
#pragma unroll
            for (int j = 0; j < 6; ++j) { const PG8_LAS float* lg = lgl + (tid * 4) * 6 + j; __hip_atomic_store(lp + 1 + j, (lg[0] + lg[6]) + (lg[12] + lg[18]), __ATOMIC_RELAXED, __HIP_MEMORY_SCOPE_AGENT); } }
        asm volatile("s_waitcnt vmcnt(0)" ::: "memory"); __builtin_amdgcn_s_barrier(); asm volatile("" ::: "memory");
        if (tid == 0) { const unsigned old = __hip_atomic_fetch_add(CNT2 + u.pm * 16, 1u, __ATOMIC_RELAXED, __HIP_MEMORY_SCOPE_AGENT);
            if (old == 3u) { __builtin_amdgcn_fence(__ATOMIC_ACQUIRE, "agent"); asm volatile("s_waitcnt vmcnt(0)" ::: "memory"); }
            *bc = old; }
        asm volatile("s_waitcnt lgkmcnt(0)" ::: "memory"); __builtin_amdgcn_s_barrier(); asm volatile("" ::: "memory");
        if (*bc == 3u && tid < 256) { float t7[7];
#pragma unroll
            for (int j = 0; j < 7; ++j) t7[j] = 0.f;
#pragma unroll
            for (int q = 0; q < 4; ++q) { const f32x4* lp = (const f32x4*)(LPART + ((size_t)(u.pm * 4 + q) * 256 + tid) * 8); const f32x4 p0 = lp[0], p1 = lp[1];
                t7[0] += p0[0]; t7[1] += p0[1]; t7[2] += p0[2]; t7[3] += p0[3]; t7[4] += p1[0]; t7[5] += p1[1]; t7[6] += p1[2]; }
            const float rs = __builtin_amdgcn_rsqf(t7[0] * (1.f / 1024.f) + 1e-6f);
#pragma unroll
            for (int j = 0; j < 6; ++j) LOGF[(size_t)(u.pm * BM + tid) * 8 + j] = ::log_sigmoid_f(t7[1 + j] * rs + bias[j]); }
        int rl0c = rl0, col0c = col0; asm volatile("" : "+v"(rl0c), "+v"(col0c));
#pragma unroll
        for (int ai = 0; ai < 2; ++ai)
#pragma unroll
            for (int m = 0; m < 4; ++m) { bf16_t* rowp = XB + ((size_t)(col0c >> 6) * M + (u.pm * BM + rl0c + ai * HALF + m * 16)) * 64 + (col0c & 63);
#pragma unroll
                for (int bj = 0; bj < 2; ++bj) { const f32x4 v0 = acc[ai][bj][m][0], v1 = acc[ai][bj][m][1];
                    u32x4 w; w.x = cvt_pk_bf16_v(v0[0], v0[1]); w.y = cvt_pk_bf16_v(v0[2], v0[3]); w.z = cvt_pk_bf16_v(v1[0], v1[1]); w.w = cvt_pk_bf16_v(v1[2], v1[3]);
                    *(u32x4*)(rowp + bj * 32) = w; } }
    }
};
}

typedef float f32x16 __attribute__((ext_vector_type(16)));
typedef short s16x4 __attribute__((ext_vector_type(4)));
typedef unsigned u32x4 __attribute__((ext_vector_type(4)));
typedef float f32x2_t __attribute__((ext_vector_type(2))); typedef __bf16 bf16x2_t __attribute__((ext_vector_type(2)));
__device__ __forceinline__ unsigned cvt_pk_bf16(float lo, float hi) { f32x2_t v = {lo, hi}; bf16x2_t b = __builtin_convertvector(v, bf16x2_t); return __builtin_bit_cast(unsigned, b); }
__device__ __forceinline__ int crow(int r, int hi) { return (r & 3) + 8 * (r >> 2) + 4 * hi; }
__device__ __forceinline__ s16x4 vtr(const LAS unsigned char* p) { return __builtin_bit_cast(s16x4, __builtin_amdgcn_ds_read_tr16_b64_v4i16((LAS s16x4*)p)); }
constexpr float ATT_THR = 40.0f, ATT_MOVE = 8.0f;
__device__ __forceinline__ float half_swap_max(float v) { auto r = __builtin_amdgcn_permlane32_swap(__float_as_uint(v), __float_as_uint(v), false, false); return fmaxf(__uint_as_float(r[0]), __uint_as_float(r[1])); }
__device__ __forceinline__ float half_swap_sum(float v) { auto r = __builtin_amdgcn_permlane32_swap(__float_as_uint(v), __float_as_uint(v), false, false); return __uint_as_float(r[0]) + __uint_as_float(r[1]); }
__device__ __forceinline__ void attn_v3(LAS unsigned char* lds, bf16* P, const float* FCUM, int tid, unsigned* qctr, float bound2, const float* qgain, const float* kgain) {
    constexpr int A2_KA = 0, A2_KB = 9216, A2_VA = 18432, A2_VB = 26624, A2_BUF = 34816, A2_Z = 2 * A2_BUF, A2_Q = A2_Z + 1024;
    const int wid = __builtin_amdgcn_readfirstlane(tid >> 6), tid_in = tid;
    int qsel = (int)(xb_xcc_id() & 7u), qleft = 8, par = 0;
    if (tid == 0) { unsigned v = 192u;
        while (qleft > 0) { v = __hip_atomic_fetch_add(qctr + 16 * qsel, 1u, __ATOMIC_RELAXED, __HIP_MEMORY_SCOPE_AGENT); if (v < 192u) break; qsel = (qsel + 1) & 7; --qleft; }
        *(LAS unsigned*)(lds + A2_Q) = qleft > 0 ? (unsigned)qsel * 192u + v : 0xffffffffu; }
    if (tid < 64) *(LAS float*)(lds + A2_Q + 64 + 4 * tid) = qgain[tid] * kgain[tid];
    v4u qraw[4]; uint2 gwr[2][4]; v4u kA, vA, kB, vB; float freg, fq0;
    auto fetch = [&](int uc, int t_, v4u (&q_)[4], uint2 (&g_)[2][4]) {
        const int lane = t_ & 63, r32 = lane & 31, hi = lane >> 5, sr = t_ >> 3, sch = t_ & 7;
        const int bh = uc >> 4, qb = 15 - (uc & 15), b = bh / 6, h = bh % 6;
        const size_t rowbase = (size_t)b * T; const int q0 = qb * 256, tq = q0 + wid * 32 + r32, NT = (q0 + 256) / 64;
        const bf16* qp = (P + CB(PC_BQ) + ((size_t)h * M + rowbase) * 64) + (tq * 64 + hi * 8);
#pragma unroll
        for (int ks = 0; ks < 4; ++ks) q_[ks] = *(const v4u*)(qp + 16 * ks);
        const int kvo = sr * 64 + sch * 8; const bf16* kg = (P + CB(PC_BK) + ((size_t)h * M + rowbase) * 64) + kvo; const bf16* vg = (P + CB(PC_BV) + ((size_t)h * M + rowbase) * 64) + kvo;
        kA = *(const v4u*)(kg + (size_t)(NT - 1) * 64 * 64); vA = *(const v4u*)(vg + (size_t)(NT - 1) * 64 * 64); kB = *(const v4u*)(kg + (size_t)(NT - 2) * 64 * 64); vB = *(const v4u*)(vg + (size_t)(NT - 2) * 64 * 64);
        const float* fb = FCUM + (size_t)bh * T;
        freg = fb[(t_ & 127) + (NT - 2) * 64]; fq0 = fb[q0];
        const bf16* gp = (P + CB(PC_BG) + ((size_t)h * M + rowbase) * 64) + tq * 64;
#pragma unroll
        for (int db = 0; db < 2; ++db)
#pragma unroll
            for (int jg = 0; jg < 4; ++jg) g_[db][jg] = *(const uint2*)(gp + 32 * db + 8 * jg + 4 * hi); };
    __syncthreads();
    int u = __builtin_amdgcn_readfirstlane((int)*(const LAS unsigned*)(lds + A2_Q));
    fetch(u < 0 ? 0 : u, tid_in, qraw, gwr);
    for (;;) {
        if (u < 0) break;
        int tid = tid_in; asm volatile("" : "+v"(tid));
        const int lane = tid & 63, r32 = lane & 31, hi = lane >> 5;
        const int sr = tid >> 3, sch = tid & 7;
        const int vb0 = ((lane >> 4) & 1) * 32 + (lane & 3) * 8 + (4 * hi + ((lane & 15) >> 2)) * 64;
        unsigned nv = 192u;
        if (tid == 0 && qleft > 0) nv = __hip_atomic_fetch_add(qctr + 16 * qsel, 1u, __ATOMIC_RELAXED, __HIP_MEMORY_SCOPE_AGENT);
        par ^= 1;
        {
            const int bh = u >> 4, qb = 15 - (u & 15), b = bh / 6, h = bh % 6;
            const size_t rowbase = (size_t)b * T; const int q0 = qb * 256, tq = q0 + wid * 32 + r32;
            bf16x8 qf[4];
            { const LAS float* gl = (const LAS float*)(lds + A2_Q + 64);
              float qx[4][8]; float ss = 0.f;
#pragma unroll
              for (int ks = 0; ks < 4; ++ks) { const v4u w = qraw[ks];
                  qx[ks][0] = bf_lo(w.x); qx[ks][1] = bf_hi(w.x); qx[ks][2] = bf_lo(w.y); qx[ks][3] = bf_hi(w.y); qx[ks][4] = bf_lo(w.z); qx[ks][5] = bf_hi(w.z); qx[ks][6] = bf_lo(w.w); qx[ks][7] = bf_hi(w.w);
#pragma unroll
                  for (int e = 0; e < 8; ++e) ss += qx[ks][e] * qx[ks][e]; }
              ss = half_swap_sum(ss);
              const float rs = (0.125f * 1.4426950408889634f) / sqrtf(ss * (1.f / 64.f) + EPS);
#pragma unroll
              for (int ks = 0; ks < 4; ++ks) { const f32x4 g0 = *(const LAS f32x4*)(gl + 16 * ks + 8 * hi), g1 = *(const LAS f32x4*)(gl + 16 * ks + 8 * hi + 4); float y[8];
#pragma unroll
                  for (int e = 0; e < 4; ++e) { y[e] = qx[ks][e] * rs * g0[e]; y[4 + e] = qx[ks][4 + e] * rs * g1[e]; }
                  u32x4 w; w.x = cvt_pk_bf16(y[0], y[1]); w.y = cvt_pk_bf16(y[2], y[3]); w.z = cvt_pk_bf16(y[4], y[5]); w.w = cvt_pk_bf16(y[6], y[7]); qf[ks] = __builtin_bit_cast(bf16x8, w); }
            }
            float m = 0.f, lsum = 0.f; f32x16 o0, o1;
#pragma unroll
            for (int r = 0; r < 16; ++r) { o0[r] = 0.f; o1[r] = 0.f; }
            const int NT = (q0 + 256) / 64, NS = NT / 2;
            const int kvo = sr * 64 + sch * 8; const bf16* kg = (P + CB(PC_BK) + ((size_t)h * M + rowbase) * 64) + kvo; const bf16* vg = (P + CB(PC_BV) + ((size_t)h * M + rowbase) * 64) + kvo;
            const float* fb = FCUM + (size_t)bh * T; const float* fg = fb + (tid & 127);
            const float lim = -ATT_THR - bound2 - fq0 * 1.4426950408889634f;
#pragma unroll 1
            for (int it = 0; it < NS; ++it) {
                const int jA = NT - 1 - 2 * it, jB = jA - 1;
                { LAS unsigned char* buf = lds + (it & 1) * A2_BUF;
#pragma unroll
                  for (int tl = 0; tl < 2; ++tl) { const v4u kr = tl ? kB : kA;
                    float kx[8] = {bf_lo(kr.x), bf_hi(kr.x), bf_lo(kr.y), bf_hi(kr.y), bf_lo(kr.z), bf_hi(kr.z), bf_lo(kr.w), bf_hi(kr.w)}; float ss = 0.f;
#pragma unroll
                    for (int e = 0; e < 8; ++e) ss += kx[e] * kx[e];
                    ss += dppf<0xB1>(ss); ss += dppf<0x4E>(ss); ss += dppf<0x141>(ss);
                    const float rs = __builtin_amdgcn_rsqf(ss * (1.f / 64.f) + EPS);
#pragma unroll
                    for (int e = 0; e < 8; ++e) kx[e] = kx[e] * rs;
                    u32x4 w; w.x = cvt_pk_bf16(kx[0], kx[1]); w.y = cvt_pk_bf16(kx[2], kx[3]); w.z = cvt_pk_bf16(kx[4], kx[5]); w.w = cvt_pk_bf16(kx[6], kx[7]);
                    *(LAS u32x4*)(buf + (tl ? A2_KB : A2_KA) + sch * 1024 + sr * 16) = w; }
                  *(LAS v4u*)(buf + A2_VA + (sch >> 2) * 4096 + sr * 64 + (sch & 3) * 16) = vA;
                  *(LAS v4u*)(buf + A2_VB + (sch >> 2) * 4096 + sr * 64 + (sch & 3) * 16) = vB;
                  if (tid < 128) *(LAS float*)(buf + (tid < 64 ? A2_KB : A2_KA) + 8 * 1024 + (tid & 63) * 4) = -freg * 1.4426950408889634f; }
                const int ja2 = jA - 2 > 0 ? jA - 2 : 0, jb2 = jB - 2 > 0 ? jB - 2 : 0, jb1 = jB - 1 > 0 ? jB - 1 : 0;
                kA = *(const v4u*)(kg + (size_t)ja2 * 64 * 64); vA = *(const v4u*)(vg + (size_t)ja2 * 64 * 64); kB = *(const v4u*)(kg + (size_t)jb2 * 64 * 64); vB = *(const v4u*)(vg + (size_t)jb2 * 64 * 64);
                if (tid < 128) freg = fg[jb2 * 64];
                const float fchk = fb[jb1 * 64 + 63];
                asm volatile("s_waitcnt lgkmcnt(0)" ::: "memory"); __builtin_amdgcn_s_barrier(); asm volatile("" ::: "memory");
                if (jB * 64 <= q0 + wid * 32 + 31) {
                    const LAS unsigned char* buf = lds + (it & 1) * A2_BUF;
                    f32x16 s[4];
                    bf16x8 ka[3][2];
#define A2_KLOAD(g_, d_) do { const LAS unsigned char* kp_ = buf + (((g_) & 1) ? A2_KA : A2_KB) + (2 * ((g_) >> 1) + hi) * 1024 + r32 * 16; d_[0] = *(const LAS bf16x8*)kp_; d_[1] = *(const LAS bf16x8*)(kp_ + 512); } while (0)
                    A2_KLOAD(0, ka[0]); A2_KLOAD(1, ka[1]);
#pragma unroll
                    for (int c = 0; c < 4; ++c) { const LAS unsigned char* bp = buf + (c < 2 ? A2_KB : A2_KA) + 8 * 1024 + (32 * (c & 1) + 4 * hi) * 4;
#pragma unroll
                        for (int g = 0; g < 4; ++g) { const f32x4 b4 = *(const LAS f32x4*)(bp + 32 * g);
#pragma unroll
                            for (int e = 0; e < 4; ++e) s[c][4 * g + e] = b4[e]; } }
                    __builtin_amdgcn_sched_barrier(0);
#pragma unroll
                    for (int c = 0; c < 4; ++c)
#pragma unroll
                        for (int r = 0; r < 16; ++r) s[c][r] -= m;
                    __builtin_amdgcn_sched_barrier(0);
#pragma unroll
                    for (int g = 0; g < 8; ++g) { const int ks = g >> 1, tl = g & 1;
                        if (g + 2 < 8) A2_KLOAD(g + 2, ka[(g + 2) % 3]);
                        __builtin_amdgcn_sched_barrier(0);
                        s[2 * tl] = __builtin_amdgcn_mfma_f32_32x32x16_bf16(ka[g % 3][0], qf[ks], s[2 * tl], 0, 0, 0);
                        s[2 * tl + 1] = __builtin_amdgcn_mfma_f32_32x32x16_bf16(ka[g % 3][1], qf[ks], s[2 * tl + 1], 0, 0, 0);
                        __builtin_amdgcn_sched_barrier(0); }
#undef A2_KLOAD
                    if (it < 2) {
#pragma unroll
                        for (int c = 0; c < 4; ++c)
#pragma unroll
                            for (int r = 0; r < 16; ++r) { const int kv = (c < 2 ? jB : jA) * 64 + 32 * (c & 1) + crow(r, hi); if (kv > tq) s[c][r] = -1e30f; } }
                    float mxa = fmaxf(s[0][0], s[1][0]), mxb = fmaxf(s[2][0], s[3][0]);
#pragma unroll
                    for (int r = 1; r < 16; ++r) { mxa = fmaxf(fmaxf(mxa, s[0][r]), s[1][r]); mxb = fmaxf(fmaxf(mxb, s[2][r]), s[3][r]); }
                    const float mx = half_swap_max(fmaxf(mxa, mxb));
                    float ps = 0.f;
                    if (it == 0 || __builtin_amdgcn_ballot_w64(mx > ATT_MOVE) != 0ull) {
                        const float d = (it == 0) ? mx : fmaxf(mx, 0.f), alpha = __builtin_amdgcn_exp2f(-d); m += d;
#pragma unroll
                        for (int c = 0; c < 4; ++c)
#pragma unroll
                            for (int r = 0; r < 16; ++r) { s[c][r] = __builtin_amdgcn_exp2f(s[c][r] - d); ps += s[c][r]; }
                        lsum = lsum * alpha + ps;
#pragma unroll
                        for (int r = 0; r < 16; ++r) { o0[r] *= alpha; o1[r] *= alpha; }
                    } else {
#pragma unroll
                        for (int c = 0; c < 4; ++c)
#pragma unroll
                            for (int r = 0; r < 16; ++r) { s[c][r] = __builtin_amdgcn_exp2f(s[c][r]); ps += s[c][r]; }
                        lsum += ps;
                    }
                    bf16x8 vfa[3], vfb[3];
#define A2_VLOAD(g_, i_) do { const LAS unsigned char* vp_ = buf + (((g_) >> 1) < 2 ? A2_VB : A2_VA) + vb0 + (((g_) >> 1) & 1) * 2048 + ((g_) & 1) * 1024; \
                        const s16x4 al_ = vtr(vp_), ah_ = vtr(vp_ + 512), bl_ = vtr(vp_ + 4096), bh_ = vtr(vp_ + 4096 + 512); \
                        vfa[i_] = (bf16x8){al_[0], al_[1], al_[2], al_[3], ah_[0], ah_[1], ah_[2], ah_[3]}; vfb[i_] = (bf16x8){bl_[0], bl_[1], bl_[2], bl_[3], bh_[0], bh_[1], bh_[2], bh_[3]}; } while (0)
                    A2_VLOAD(0, 0); A2_VLOAD(1, 1);
                    __builtin_amdgcn_sched_barrier(0);
#pragma unroll
                    for (int g = 0; g < 8; ++g) { const int c = g >> 1, h2 = g & 1;
                        if (g + 2 < 8) A2_VLOAD(g + 2, (g + 2) % 3);
                        u32x4 w; w.x = cvt_pk_bf16(s[c][8 * h2 + 0], s[c][8 * h2 + 1]); w.y = cvt_pk_bf16(s[c][8 * h2 + 2], s[c][8 * h2 + 3]); w.z = cvt_pk_bf16(s[c][8 * h2 + 4], s[c][8 * h2 + 5]); w.w = cvt_pk_bf16(s[c][8 * h2 + 6], s[c][8 * h2 + 7]);
                        const bf16x8 pa = __builtin_bit_cast(bf16x8, w);
                        __builtin_amdgcn_sched_barrier(0);
                        o0 = __builtin_amdgcn_mfma_f32_32x32x16_bf16(vfa[g % 3], pa, o0, 0, 0, 0);
                        o1 = __builtin_amdgcn_mfma_f32_32x32x16_bf16(vfb[g % 3], pa, o1, 0, 0, 0);
                        __builtin_amdgcn_sched_barrier(0); }
#undef A2_VLOAD
                }
                if (jB > 0 && jB - 1 < NT - 4 && -fchk * 1.4426950408889634f < lim) break;
            }
            lsum = half_swap_sum(lsum);
            const float inv = 1.0f / lsum;
            if (tid == 0) { unsigned v = nv;
                while (v >= 192u && qleft > 0) { qsel = (qsel + 1) & 7; if (--qleft <= 0) break; v = __hip_atomic_fetch_add(qctr + 16 * qsel, 1u, __ATOMIC_RELAXED, __HIP_MEMORY_SCOPE_AGENT); }
                *(LAS unsigned*)(lds + A2_Q + 4 * par) = (qleft > 0 && v < 192u) ? (unsigned)qsel * 192u + v : 0xffffffffu; }
            asm volatile("s_waitcnt lgkmcnt(0)" ::: "memory"); __builtin_amdgcn_s_barrier(); asm volatile("" ::: "memory");
            const int un = __builtin_amdgcn_readfirstlane((int)*(const LAS unsigned*)(lds + A2_Q + 4 * par));
            uint2 gwn[2][4];
            fetch(un < 0 ? 0 : un, tid, qraw, gwn);
            __builtin_amdgcn_sched_barrier(0); asm volatile("" ::: "memory");
            bf16* op = (P + CB(PC_BQ) + ((size_t)h * M + rowbase) * 64) + tq * 64;
#pragma unroll
            for (int db = 0; db < 2; ++db)
#pragma unroll
                for (int jg = 0; jg < 4; ++jg) { const int d = 32 * db + 8 * jg + 4 * hi; const uint2 gw2 = gwr[db][jg];
                    const float g[4] = {bf_lo(gw2.x), bf_hi(gw2.x), bf_lo(gw2.y), bf_hi(gw2.y)}; float ov[4];
#pragma unroll
                    for (int e = 0; e < 4; ++e) ov[e] = (db ? o1[4 * jg + e] : o0[4 * jg + e]) * inv * __builtin_amdgcn_rcpf(1.0f + __builtin_amdgcn_exp2f(-g[e] * 1.4426950408889634f));
                    uint2 ow; ow.x = pk2(ov[0], ov[1]); ow.y = pk2(ov[2], ov[3]); *(uint2*)(op + d) = ow; }
#pragma unroll
            for (int db = 0; db < 2; ++db)
#pragma unroll
                for (int jg = 0; jg < 4; ++jg) gwr[db][jg] = gwn[db][jg];
            u = un;
        }
    }
}

constexpr size_t WS_U = WS_H;
constexpr size_t WS_ST = WS_H + 160 * MiB;
constexpr size_t WS_DK = WS_H + 240 * MiB;
constexpr int N_HG_UNITS = 96 * 64, N_RT_UNITS = 64 * 64;
__device__ __forceinline__ void stage_tile(LAS unsigned char* dst, const bf16* src, int lane) {
#pragma unroll
    for (int i = 0; i < 8; ++i) { const int r = i * 8 + (lane >> 3), ch = lane & 7; const v4u w = *(const v4u*)(src + (size_t)r * 64 + ch * 8);
        *(LAS v4u*)(dst + (ch >> 2) * 4096 + r * 64 + (ch & 3) * 16) = w; }
}
__device__ __forceinline__ bf16x8 ltri_op(int tb, int ts, int t_l, int hi) {
    const int t = 32 * tb + t_l; bf16x8 o;
#pragma unroll
    for (int j = 0; j < 8; ++j) { const int tp = 16 * ts + 8 * (j >> 2) + 4 * hi + (j & 3); o[j] = (tp <= t) ? (short)0x3f80 : (short)0; }
    return o;
}
__device__ __forceinline__ bf16x8 pack8(const float* x) { u32x4 w; w.x = cvt_pk_bf16(x[0], x[1]); w.y = cvt_pk_bf16(x[2], x[3]); w.z = cvt_pk_bf16(x[4], x[5]); w.w = cvt_pk_bf16(x[6], x[7]); return __builtin_bit_cast(bf16x8, w); }
__device__ __forceinline__ bf16x8 vfrag(const LAS unsigned char* p) { const s16x4 lo = vtr(p), hi4 = vtr(p + 512); return (bf16x8){lo[0], lo[1], lo[2], lo[3], hi4[0], hi4[1], hi4[2], hi4[3]}; }
__device__ __forceinline__ float s16f(short s) { return __uint_as_float(((unsigned)(unsigned short)s) << 16); }
#define MFMA32(a, b, c) __builtin_amdgcn_mfma_f32_32x32x16_bf16((a), (b), (c), 0, 0, 0)
__device__ __forceinline__ void hgrn_gate(float z, float lb, float& lf2, float& kk) {
    z = fminf(fmaxf(z, -30.f), 30.f);
    const float e = __builtin_amdgcn_exp2f(-z * 1.4426950408889634f), sig = __builtin_amdgcn_rcpf(1.0f + e);
    const float f = lb + (1.0f - lb) * sig; lf2 = __builtin_amdgcn_logf(fmaxf(f, 1e-12f)); kk = (1.0f - lb) * (e * sig);
}

struct TilePF { v4u a[8], b[8]; };
__device__ __forceinline__ void tile_fetch(TilePF& r, const bf16* sa, const bf16* sb, int lane) {
#pragma unroll
    for (int i = 0; i < 8; ++i) { const int rr = i * 8 + (lane >> 3), ch = lane & 7; r.a[i] = *(const v4u*)(sa + (size_t)rr * 64 + ch * 8); r.b[i] = *(const v4u*)(sb + (size_t)rr * 64 + ch * 8); }
}
__device__ __forceinline__ void tile_put(LAS unsigned char* da, LAS unsigned char* db, const TilePF& r, int lane) {
#pragma unroll
    for (int i = 0; i < 8; ++i) { const int rr = i * 8 + (lane >> 3), ch = lane & 7; const int o = (ch >> 2) * 4096 + rr * 64 + (ch & 3) * 16; *(LAS v4u*)(da + o) = r.a[i]; *(LAS v4u*)(db + o) = r.b[i]; }
}
__device__ __forceinline__ void tile_fetch_b(TilePF& r, const bf16* sb, int lane) {
#pragma unroll
    for (int i = 0; i < 8; ++i) { const int rr = i * 8 + (lane >> 3), ch = lane & 7; r.b[i] = *(const v4u*)(sb + (size_t)rr * 64 + ch * 8); }
}
__device__ __forceinline__ void tile_put_b(LAS unsigned char* db, const TilePF& r, int lane) {
#pragma unroll
    for (int i = 0; i < 8; ++i) { const int rr = i * 8 + (lane >> 3), ch = lane & 7; *(LAS v4u*)(db + (ch >> 2) * 4096 + rr * 64 + (ch & 3) * 16) = r.b[i]; }
}
__device__ __forceinline__ const bf16* hgrn_tile(const bf16* P, int unit) { const int chain = unit >> 6, n = unit & 63, b = chain / 6, h = chain % 6; return P + ((size_t)h * M + (size_t)b * T + n * 64) * 64; }
template <bool WT  >
__device__ __forceinline__ void rec_pass1_hgrn(LAS unsigned char* wl, const bf16* P, const float* LBl, bf16* U, float* DK, int unit, int lane, TilePF& pf, bool has_next) {
    const int c_l = lane & 31, hi = lane >> 5, chain = unit >> 6, h = chain % 6;
    const bf16* tile = hgrn_tile(P, unit);
    const float lb0_ = LBl[h * 64 + c_l], lb1_ = LBl[h * 64 + 32 + c_l];
    tile_put(wl, wl + 8192, pf, lane);
    { const size_t nx = has_next ? (size_t)NWAVES * 4096 : 0; tile_fetch(pf, tile + CB(PC_AF) + nx, tile + CB(PC_AI) + nx, lane); }
    asm volatile("s_waitcnt lgkmcnt(0)" ::: "memory");
    const int vb0 = ((lane >> 4) & 1) * 32 + (lane & 3) * 8 + (4 * hi + ((lane & 15) >> 2)) * 64;
    bf16* Uo = U + (size_t)unit * 4096;
#pragma unroll 1
    for (int fb = 0; fb < 2; ++fb) {
        const float lb = fb ? lb1_ : lb0_;
        float kk[4][8]; bf16x8 lfh[4], lfl[4]; s16x4 zr[4][2];
#pragma unroll
        for (int ts = 0; ts < 4; ++ts)
#pragma unroll
            for (int jj = 0; jj < 2; ++jj) zr[ts][jj] = vtr(wl + fb * 4096 + (16 * ts + 8 * jj) * 64 + vb0);
        __builtin_amdgcn_sched_barrier(0);
#pragma unroll
        for (int ts = 0; ts < 4; ++ts) { float lf[8], lo[8];
#pragma unroll
            for (int jj = 0; jj < 2; ++jj) { const s16x4 z4 = zr[ts][jj];
#pragma unroll
                for (int e = 0; e < 4; ++e) hgrn_gate(s16f(z4[e]), lb, lf[4 * jj + e], kk[ts][4 * jj + e]); }
            lfh[ts] = pack8(lf);
#pragma unroll
            for (int j = 0; j < 8; ++j) lo[j] = lf[j] - s16f(lfh[ts][j]);
            lfl[ts] = pack8(lo); }
        f32x16 cum[2];
#pragma unroll
        for (int tb = 0; tb < 2; ++tb) {
#pragma unroll
            for (int r = 0; r < 16; ++r) cum[tb][r] = 0.f;
#pragma unroll
            for (int ts = 0; ts < 2 * tb + 2; ++ts) { const bf16x8 L = ltri_op(tb, ts, c_l, hi); cum[tb] = MFMA32(L, lfh[ts], cum[tb]); cum[tb] = MFMA32(L, lfl[ts], cum[tb]); } }
        const float c63 = shfl_i(cum[1][15], 32 + c_l);
        if (hi == 0) { float* dkp = DK + (size_t)unit * 64 + 32 * fb + c_l; const float dkv = __builtin_amdgcn_exp2f(c63); if (WT) __hip_atomic_store(dkp, dkv, __ATOMIC_RELAXED, __HIP_MEMORY_SCOPE_AGENT); else *dkp = dkv; }
        bf16x8 kh[4];
#pragma unroll
        for (int ts = 0; ts < 4; ++ts) { float x[8];
#pragma unroll
            for (int j = 0; j < 8; ++j) x[j] = kk[ts][j] * __builtin_amdgcn_exp2f(c63 - cum[ts >> 1][8 * (ts & 1) + j]);
            kh[ts] = pack8(x); }
#pragma unroll
        for (int vb = 0; vb < 2; ++vb) { f32x16 acc;
#pragma unroll
            for (int r = 0; r < 16; ++r) acc[r] = 0.f;
#pragma unroll
            for (int ts = 0; ts < 4; ++ts) acc = MFMA32(vfrag(wl + 8192 + vb * 4096 + ts * 1024 + vb0), kh[ts], acc);
#pragma unroll
            for (int r = 0; r < 16; ++r) { bf16* up_ = Uo + (32 * vb + crow(r, hi)) * 64 + 32 * fb + c_l; const bf16 uv_ = (bf16)f2bf(acc[r]); if (WT) __hip_atomic_store(up_, uv_, __ATOMIC_RELAXED, __HIP_MEMORY_SCOPE_AGENT); else *up_ = uv_; } }
    }
}
__device__ __forceinline__ const bf16* ret_tile(const bf16* P, int unit) { const int chain = unit >> 6, n = unit & 63, b = chain / 4, h = chain % 4; return P + ((size_t)h * M + (size_t)b * T + n * 64) * 64; }
__device__ __forceinline__ void rec_pass1_ret(LAS unsigned char* wl, const bf16* P, bf16* U, int unit, int lane, TilePF& pf, bool has_next) {
    const int c_l = lane & 31, hi = lane >> 5, chain = unit >> 6, h = chain % 4;
    const bf16* tile = ret_tile(P, unit);
    tile_put(wl, wl + 8192, pf, lane);
    { const size_t nx = has_next ? (size_t)NWAVES * 4096 : 0; tile_fetch(pf, tile + CB(PC_CK) + nx, tile + CB(PC_CV) + nx, lane); }
    asm volatile("s_waitcnt lgkmcnt(0)" ::: "memory");
    const int vb0 = ((lane >> 4) & 1) * 32 + (lane & 3) * 8 + (4 * hi + ((lane & 15) >> 2)) * 64;
    const float lg2 = __builtin_amdgcn_logf(1.0f - __builtin_amdgcn_exp2f(-5.0f - (float)h));
    bf16* Uo = U + (size_t)(N_HG_UNITS + unit) * 4096;
    bf16x8 kh[2][4];
#pragma unroll
    for (int ts = 0; ts < 4; ++ts) { float x0[8], x1[8];
#pragma unroll
        for (int jj = 0; jj < 2; ++jj) { const s16x4 a4 = vtr(wl + (16 * ts + 8 * jj) * 64 + vb0), b4 = vtr(wl + 4096 + (16 * ts + 8 * jj) * 64 + vb0);
#pragma unroll
            for (int e = 0; e < 4; ++e) { const int t = 16 * ts + 8 * jj + 4 * hi + e; const float w = __builtin_amdgcn_exp2f(lg2 * (float)(63 - t));
                x0[4 * jj + e] = s16f(a4[e]) * w; x1[4 * jj + e] = s16f(b4[e]) * w; } }
        kh[0][ts] = pack8(x0); kh[1][ts] = pack8(x1); }
#pragma unroll
    for (int vb = 0; vb < 2; ++vb) { bf16x8 vf[4];
#pragma unroll
        for (int ts = 0; ts < 4; ++ts) vf[ts] = vfrag(wl + 8192 + vb * 4096 + ts * 1024 + vb0);
#pragma unroll
        for (int fb = 0; fb < 2; ++fb) { f32x16 acc;
#pragma unroll
            for (int r = 0; r < 16; ++r) acc[r] = 0.f;
#pragma unroll
            for (int ts = 0; ts < 4; ++ts) acc = MFMA32(vf[ts], kh[fb][ts], acc);
#pragma unroll
            for (int r = 0; r < 16; ++r) Uo[(32 * vb + crow(r, hi)) * 64 + 32 * fb + c_l] = (bf16)f2bf(acc[r]); } }
}
__device__ __forceinline__ void rec_pass2_chain(const bf16* U, const float* DK, bf16* ST, int chain, int tid) {
    constexpr int NE = 8;
    const int k = tid & 63, kp = (k & ~12) | ((k & 8) >> 1) | ((k & 4) << 1); const bool hg = chain < 96;
    const bf16* up = U + (size_t)chain * 64 * 4096 + tid; bf16* sp = ST + (size_t)chain * 64 * 4096 + (tid & ~63) + kp;
    const float* dp = DK + (size_t)(hg ? chain : 0) * 64 * 64 + k; int h = (chain - 96) & 3; asm volatile("" : "+s"(h));
    const float g64 = __builtin_amdgcn_exp2f(64.0f * __builtin_amdgcn_logf(1.0f - __builtin_amdgcn_exp2f(-5.0f - (float)h)));
    float S[NE];
#pragma unroll
    for (int i = 0; i < NE; ++i) S[i] = 0.f;
    bf16 un[8][NE]; float dn[8];
#pragma unroll
    for (int j = 0; j < 8; ++j) { dn[j] = hg ? dp[j * 64] : g64;
#pragma unroll
        for (int i = 0; i < NE; ++i) un[j][i] = up[(size_t)j * 4096 + 512 * i]; }
#pragma unroll 1
    for (int nb = 0; nb < 64; nb += 8) { bf16 uc[8][NE]; float dc[8];
#pragma unroll
        for (int j = 0; j < 8; ++j) { dc[j] = dn[j];
#pragma unroll
            for (int i = 0; i < NE; ++i) uc[j][i] = un[j][i]; }
        if (nb + 8 < 64) {
#pragma unroll
            for (int j = 0; j < 8; ++j) { dn[j] = hg ? dp[(nb + 8 + j) * 64] : g64;
#pragma unroll
                for (int i = 0; i < NE; ++i) un[j][i] = up[(size_t)(nb + 8 + j) * 4096 + 512 * i]; } }
        asm volatile("" ::: "memory");
#pragma unroll
        for (int j = 0; j < 8; ++j)
#pragma unroll
            for (int i = 0; i < NE; ++i) { sp[(size_t)(nb + j) * 4096 + 512 * i] = (bf16)f2bf(S[i]); S[i] = dc[j] * S[i] + bf1(uc[j][i]); } }
}
__device__ __forceinline__ void rec_pass3_tail(const LAS unsigned char* vt, const bf16x8 (&qt)[2][2][2], const bf16x8 (&kt)[2][2][2], const bf16x8 (&qh)[2][2][2], const bf16* STu,
                                               const float* gain, const bf16* grow  , bf16* orow, int lane, TilePF* pf = nullptr, const bf16* nxa = nullptr, const bf16* nxb = nullptr) {
    asm volatile("" : "+v"(lane));
    const int t_l = lane & 31, hi = lane >> 5;
    const int vb0 = ((lane >> 4) & 1) * 32 + (lane & 3) * 8 + (4 * hi + ((lane & 15) >> 2)) * 64;
    bf16x8 sfr[2][2][2];
#pragma unroll
    for (int vb = 0; vb < 2; ++vb)
#pragma unroll
        for (int fb = 0; fb < 2; ++fb)
#pragma unroll
            for (int ks = 0; ks < 2; ++ks) sfr[vb][fb][ks] = *(const bf16x8*)(STu + (32 * vb + t_l) * 64 + 32 * fb + 16 * ks + 8 * hi);
    __builtin_amdgcn_sched_barrier(0);
    bf16x8 pt[3][2];
#pragma unroll
    for (int blk = 0; blk < 3; ++blk) { const int sb = blk == 2 ? 1 : 0, tb = blk == 0 ? 0 : 1; f32x16 sc;
#pragma unroll
        for (int r = 0; r < 16; ++r) sc[r] = 0.f;
#pragma unroll
        for (int fb = 0; fb < 2; ++fb)
#pragma unroll
            for (int ks = 0; ks < 2; ++ks) sc = MFMA32(kt[sb][fb][ks], qt[tb][fb][ks], sc);
        if (sb == tb) {
#pragma unroll
            for (int r = 0; r < 16; ++r) if (crow(r, hi) > t_l) sc[r] = 0.f; }
#pragma unroll
        for (int s16 = 0; s16 < 2; ++s16) { float x[8];
#pragma unroll
            for (int j = 0; j < 8; ++j) x[j] = sc[8 * s16 + j];
            pt[blk][s16] = pack8(x); } }
    uint2 gwr[2][2][4];
#pragma unroll
    for (int tb = 0; tb < 2; ++tb)
#pragma unroll
        for (int vb = 0; vb < 2; ++vb)
#pragma unroll
            for (int g4 = 0; g4 < 4; ++g4) gwr[tb][vb][g4] = *(const uint2*)(grow + (size_t)tb * 32 * 64 + 32 * vb + 8 * g4 + 4 * hi);
    __builtin_amdgcn_sched_barrier(0);
    f32x16 o[2][2];
#pragma unroll
    for (int vb = 0; vb < 2; ++vb) {
#pragma unroll
        for (int tb = 0; tb < 2; ++tb)
#pragma unroll
            for (int r = 0; r < 16; ++r) o[vb][tb][r] = 0.f;
#pragma unroll
        for (int sb = 0; sb < 2; ++sb)
#pragma unroll
            for (int s16 = 0; s16 < 2; ++s16) { const bf16x8 vf = vfrag(vt + vb * 4096 + (32 * sb + 16 * s16) * 64 + vb0);
                if (sb == 0) { o[vb][0] = MFMA32(vf, pt[0][s16], o[vb][0]); o[vb][1] = MFMA32(vf, pt[1][s16], o[vb][1]); }
                else o[vb][1] = MFMA32(vf, pt[2][s16], o[vb][1]); }
#pragma unroll
        for (int fb = 0; fb < 2; ++fb)
#pragma unroll
            for (int ks = 0; ks < 2; ++ks) { const bf16x8 sf = sfr[vb][fb][ks];
                o[vb][0] = MFMA32(sf, qh[0][fb][ks], o[vb][0]); o[vb][1] = MFMA32(sf, qh[1][fb][ks], o[vb][1]); }
    }
    f32x4 gnr[2][4];
#pragma unroll
    for (int vb = 0; vb < 2; ++vb)
#pragma unroll
        for (int g4 = 0; g4 < 4; ++g4) gnr[vb][g4] = *(const f32x4*)(gain + 32 * vb + 8 * g4 + 4 * hi);
    if (pf) { if (nxa) tile_fetch(*pf, nxa, nxb, lane); else tile_fetch_b(*pf, nxb, lane); }
    __builtin_amdgcn_sched_barrier(0);
#pragma unroll
    for (int tb = 0; tb < 2; ++tb) { float ss = 0.f;
#pragma unroll
        for (int vb = 0; vb < 2; ++vb)
#pragma unroll
            for (int r = 0; r < 16; ++r) ss += o[vb][tb][r] * o[vb][tb][r];
        ss += shfl_i(ss, lane ^ 32);
        const float rs = 1.0f / sqrtf(ss * (1.f / 64.f) + EPS);
#pragma unroll
        for (int vb = 0; vb < 2; ++vb)
#pragma unroll
            for (int g4 = 0; g4 < 4; ++g4) { const int c = 32 * vb + 8 * g4 + 4 * hi; const uint2 gw2 = gwr[tb][vb][g4]; const f32x4 gn = gnr[vb][g4];
                const float g[4] = {bf_lo(gw2.x), bf_hi(gw2.x), bf_lo(gw2.y), bf_hi(gw2.y)}; float y[4];
#pragma unroll
                for (int e = 0; e < 4; ++e) y[e] = o[vb][tb][4 * g4 + e] * rs * gn[e] * (g[e] * __builtin_amdgcn_rcpf(1.0f + __builtin_amdgcn_exp2f(-g[e] * 1.4426950408889634f)));
                uint2 ow; ow.x = pk2(y[0], y[1]); ow.y = pk2(y[2], y[3]); *(uint2*)(orow + (size_t)tb * 32 * 64 + c) = ow; } }
}
__device__ __forceinline__ void rec_pass3_hgrn(LAS unsigned char* wl, bf16* P, const float* LBl, const float* gainl, const bf16* ST, int unit, int lane, TilePF& pf, bool has_next) {
    const int t_l = lane & 31, hi = lane >> 5, chain = unit >> 6, n = unit & 63, b = chain / 6, h = chain % 6;
    bf16* tile = P + ((size_t)h * M + (size_t)b * T + n * 64) * 64;
    const float lbv_[2] = {LBl[h * 64 + t_l], LBl[h * 64 + 32 + t_l]};
    tile_put(wl, wl + 8192, pf, lane);
    asm volatile("s_waitcnt lgkmcnt(0)" ::: "memory");
    const int vb0 = ((lane >> 4) & 1) * 32 + (lane & 3) * 8 + (4 * hi + ((lane & 15) >> 2)) * 64;
    uint2 qwa[2][2][4];
#pragma unroll
    for (int fb = 0; fb < 2; ++fb)
#pragma unroll
        for (int tb = 0; tb < 2; ++tb)
#pragma unroll
            for (int g = 0; g < 4; ++g) qwa[fb][tb][g] = *(const uint2*)(tile + CB(PC_AQ) + (size_t)(32 * tb + t_l) * 64 + 32 * fb + 4 * hi + 8 * g);
    __builtin_amdgcn_sched_barrier(0);
    bf16x8 qt[2][2][2], kt[2][2][2], qh[2][2][2];
#pragma unroll
    for (int fb = 0; fb < 2; ++fb) {
        const float lb_l1 = lbv_[fb];
        f32x16 cumT[2];
        { const float lb = lb_l1;
          bf16x8 lfh[4], lfl[4]; s16x4 zr[4][2];
#pragma unroll
          for (int ts = 0; ts < 4; ++ts)
#pragma unroll
              for (int jj = 0; jj < 2; ++jj) zr[ts][jj] = vtr(wl + fb * 4096 + (16 * ts + 8 * jj) * 64 + vb0);
          __builtin_amdgcn_sched_barrier(0);
#pragma unroll
          for (int ts = 0; ts < 4; ++ts) { float lf[8], lo[8];
#pragma unroll
              for (int jj = 0; jj < 2; ++jj) { const s16x4 z4 = zr[ts][jj];
#pragma unroll
                  for (int e = 0; e < 4; ++e) { float kkd; hgrn_gate(s16f(z4[e]), lb, lf[4 * jj + e], kkd);
                      *(LAS unsigned short*)(wl + fb * 4096 + (16 * ts + 8 * jj + 4 * hi + e) * 64 + t_l * 2) = (unsigned short)f2bf(kkd); } }
              lfh[ts] = pack8(lf);
#pragma unroll
              for (int j = 0; j < 8; ++j) lo[j] = lf[j] - s16f(lfh[ts][j]);
              lfl[ts] = pack8(lo); }
#pragma unroll
          for (int tb = 0; tb < 2; ++tb) {
#pragma unroll
              for (int r = 0; r < 16; ++r) cumT[tb][r] = 0.f;
#pragma unroll
              for (int ts = 0; ts < 2 * tb + 2; ++ts) { const bf16x8 L = ltri_op(tb, ts, t_l, hi); cumT[tb] = MFMA32(lfh[ts], L, cumT[tb]); cumT[tb] = MFMA32(lfl[ts], L, cumT[tb]); } } }
        float cmv[16];
#pragma unroll
        for (int r = 0; r < 16; ++r) { const int ci = (int)__float_as_uint(cumT[0][r]); const float s31 = __uint_as_float((unsigned)__builtin_amdgcn_readlane(ci, 31)), s63 = __uint_as_float((unsigned)__builtin_amdgcn_readlane(ci, 63)); cmv[r] = hi ? s63 : s31; }
#pragma unroll
        for (int tb = 0; tb < 2; ++tb) {
#pragma unroll
            for (int ks = 0; ks < 2; ++ks) { float xq[8], xk[8], xh[8];
#pragma unroll
                for (int gg = 0; gg < 2; ++gg) { const int g = 2 * ks + gg;
                    const uint2 qw = qwa[fb][tb][g]; const v2u kw = *(const LAS v2u*)(wl + fb * 4096 + (32 * tb + t_l) * 64 + (8 * g + 4 * hi) * 2);
                    const float qv[4] = {bf_lo(qw.x), bf_hi(qw.x), bf_lo(qw.y), bf_hi(qw.y)}, kv[4] = {bf_lo(kw.x), bf_hi(kw.x), bf_lo(kw.y), bf_hi(kw.y)};
#pragma unroll
                    for (int e = 0; e < 4; ++e) { const int r = 4 * g + e, x = 4 * gg + e; const float kk = kv[e];
                        const float cm = cmv[r], c = cumT[tb][r];
                        xq[x] = qv[e] * __builtin_amdgcn_exp2f(c - cm); xk[x] = kk * __builtin_amdgcn_exp2f(cm - c); xh[x] = qv[e] * __builtin_amdgcn_exp2f(c); } }
                qt[tb][fb][ks] = pack8(xq); kt[tb][fb][ks] = pack8(xk); qh[tb][fb][ks] = pack8(xh);
                asm volatile("" : "+v"(qt[tb][fb][ks]), "+v"(kt[tb][fb][ks]), "+v"(qh[tb][fb][ks])); }
        }
    }
    rec_pass3_tail(wl + 8192, qt, kt, qh, ST + (size_t)unit * 4096, gainl + h * 64, tile + CB(PC_AG) + (size_t)t_l * 64, tile + CB(PC_AQ) + (size_t)t_l * 64, lane, &pf, tile + CB(PC_AF) + (has_next ? (size_t)NWAVES * 4096 : 0), tile + CB(PC_AI) + (has_next ? (size_t)NWAVES * 4096 : 0));
}
__device__ __forceinline__ void rec_pass3_ret(LAS unsigned char* wl, bf16* P, const float* gainl, const bf16* ST, int unit, int lane, TilePF& pf, bool has_next) {
    const int t_l = lane & 31, hi = lane >> 5, chain = unit >> 6, n = unit & 63, b = chain / 4, h = chain % 4;
    bf16* tile = P + ((size_t)h * M + (size_t)b * T + n * 64) * 64;
    tile_put_b(wl + 8192, pf, lane);
    asm volatile("s_waitcnt lgkmcnt(0)" ::: "memory");
    const float lg2 = __builtin_amdgcn_logf(1.0f - __builtin_amdgcn_exp2f(-5.0f - (float)h));
    bf16x8 qt[2][2][2], kt[2][2][2], qh[2][2][2];
#pragma unroll
    for (int tb = 0; tb < 2; ++tb) {
        const int t = 32 * tb + t_l; const bf16* rowp = tile + (size_t)t * 64 + 4 * hi;
        uint2 qwr[2][4], kwr[2][4];
#pragma unroll
        for (int fb = 0; fb < 2; ++fb)
#pragma unroll
            for (int g = 0; g < 4; ++g) { qwr[fb][g] = *(const uint2*)(rowp + CB(PC_CQ) + 32 * fb + 8 * g); kwr[fb][g] = *(const uint2*)(rowp + CB(PC_CK) + 32 * fb + 8 * g); }
        __builtin_amdgcn_sched_barrier(0);
        const float wq = __builtin_amdgcn_exp2f(lg2 * (float)(t - 31)), wk = __builtin_amdgcn_exp2f(lg2 * (float)(31 - t)), wh = __builtin_amdgcn_exp2f(lg2 * (float)(t + 1));
#pragma unroll
        for (int fb = 0; fb < 2; ++fb)
#pragma unroll
            for (int ks = 0; ks < 2; ++ks) { float xq[8], xk[8], xh[8];
#pragma unroll
                for (int gg = 0; gg < 2; ++gg) { const int g = 2 * ks + gg;
                    const uint2 qw = qwr[fb][g], kw = kwr[fb][g];
                    const float qv[4] = {bf_lo(qw.x), bf_hi(qw.x), bf_lo(qw.y), bf_hi(qw.y)}, kv[4] = {bf_lo(kw.x), bf_hi(kw.x), bf_lo(kw.y), bf_hi(kw.y)};
#pragma unroll
                    for (int e = 0; e < 4; ++e) { const int x = 4 * gg + e; xq[x] = qv[e] * wq; xk[x] = kv[e] * wk; xh[x] = qv[e] * wh; } }
                qt[tb][fb][ks] = pack8(xq); kt[tb][fb][ks] = pack8(xk); qh[tb][fb][ks] = pack8(xh); }
    }
    rec_pass3_tail(wl + 8192, qt, kt, qh, ST + (size_t)(N_HG_UNITS + unit) * 4096, gainl + h * 64, tile + CB(PC_CG) + (size_t)t_l * 64, tile + CB(PC_CQ) + (size_t)t_l * 64, lane, &pf, nullptr, tile + CB(PC_CV) + (has_next ? (size_t)NWAVES * 4096 : 0));
}

struct Args { const float* in[17]; float* out; unsigned char* ws; };
enum { I_X = 0, I_WIN, I_BFOX, I_QG, I_KG, I_HLB, I_HOG, I_ROG, I_WOUT, I_GMPRE, I_GMPOST, I_WUP, I_CW, I_CB, I_WDN, I_GFPRE, I_GFPOST };
typedef const __attribute__((address_space(4))) Args* CArgs;
__device__ __forceinline__ int lane_id() { return pg8::fresh_lane(); }
__device__ __forceinline__ int opaque_tid(int wave_s) { int t = wave_s * 64 + lane_id(); asm volatile("" : "+v"(t)); return t; }
__device__ __forceinline__ CArgs opaque_args() { CArgs p = (CArgs)__builtin_amdgcn_kernarg_segment_ptr(); asm volatile("" : "+s"(p)); return p; }
#define PH_BEGIN const int tid = opaque_tid(wave_s), lane = tid & 63, wave = __builtin_amdgcn_readfirstlane(tid >> 6); const int G = gridDim.x, gw = blockIdx.x * NWAVES + wave, NGW = G * NWAVES; \
    CArgs ap = opaque_args(); unsigned char* ws = ap->ws; (void)lane; (void)gw; (void)NGW; (void)ws;

#define GRID_BAR() do { XcdBarrier b_; b_.bar = (unsigned*)((gu32*)(opaque_args()->ws + WS_CTL) + CW_BAR); b_.x = xb_xcc_id(); b_.st = (volatile LAS unsigned*)(lds + MISC_OFF) + 8; xcd_barrier(b_, opaque_tid(wave_s) == 0); } while (0)
__global__ void __launch_bounds__(NWAVES * 64, 2) fwd(Args args_unused) {
    extern __shared__ __attribute__((aligned(16))) unsigned char lds_raw[];
    LAS unsigned char* lds = (LAS unsigned char*)lds_raw;
    const int wave_s = __builtin_amdgcn_readfirstlane((int)threadIdx.x >> 6);
    { volatile LAS unsigned* MISC = (volatile LAS unsigned*)(lds + MISC_OFF);
      CArgs ap0 = opaque_args();
      for (int u = threadIdx.x; u < (LDS_BYTES - LDSCTL_OFF) / 4; u += NWAVES * 64) ((LAS unsigned*)(lds + LDSCTL_OFF))[u] = 0u;
      __syncthreads();
      (void)xcd_barrier_post((unsigned*)((gu32*)(ap0->ws + WS_CTL) + CW_BAR), MISC + 8); }

    { PH_BEGIN
        bf16* WinT = (bf16*)(ws + WS_WIN); bf16* WoutT = (bf16*)(ws + WS_WOUT); bf16* WupT = (bf16*)(ws + WS_WUP); bf16* WdnT = (bf16*)(ws + WS_WDN);
        float* WF = (float*)(ws + WS_WF); float* COS = (float*)(ws + WS_COS); float* SIN = (float*)(ws + WS_SIN); float* LB = (float*)(ws + WS_LB);
        LAS float* scr = (LAS float*)(lds + wave * 16384);
        constexpr int I_IN = 16 * 128, I_OUT = 16 * 32, I_UP = 16 * 176, I_DN = 44 * 32, I_L = I_IN + I_OUT + I_UP + I_DN;
        auto tr_decode = [&](int it) -> TrP {
            const int l = it / I_L; int r = it % I_L;
            if (r < I_IN) { const int kb = r / 128, nb = r % 128; const int pc = 32 * nb; const bool rot = (pc >= PC_CQ && pc < PC_CQ + 256) || (pc >= PC_CK && pc < PC_CK + 256);
                const int scol = rot ? pcol_to_orig(pc & ~63) + ((pc & 63) >> 1) : pcol_to_orig(pc);
                return TrP{ap->in[I_WIN] + (size_t)l * D * IN_COLS, IN_COLS, scol, 64 * kb, WinT + (size_t)l * NP * D, NP, pc, ap->in[I_GMPRE] + l * D, rot, true}; }
            r -= I_IN;
            if (r < I_OUT) { const int kb = r / 32, nb = r % 32; return TrP{ap->in[I_WOUT] + (size_t)l * D * D, D, 32 * nb, 64 * kb, WoutT + (size_t)l * D * D, D, 32 * nb, nullptr, false, true}; }
            r -= I_OUT;
            if (r < I_UP) { const int kb = r / 176, nb = r % 176; const int np = 32 * nb, srcc = ((np >> 7) & 1) * D_FF + 128 * (np >> 8) + (np & 127); return TrP{ap->in[I_WUP] + (size_t)l * D * NUP, NUP, srcc, 64 * kb, WupT + (size_t)l * NUP * D, NUP, np, ap->in[I_GFPRE] + l * D, false, false}; }
            r -= I_UP;
            { const int kb = r / 32, nb = r % 32; return TrP{ap->in[I_WDN] + (size_t)l * D_FF * D, D, 32 * nb, 64 * kb, WdnT + (size_t)l * D * D_FF, D, 32 * nb, nullptr, false, true}; } };
        if (gw < DEPTH * I_L) { TrP pn = tr_decode(gw); float wn[32]; f32x4 gn[2]; tr_load(wn, gn, pn, lane);
            for (int it = gw; it < DEPTH * I_L; it += NGW) { const TrP pc = pn; float wc[32]; f32x4 gc[2] = {gn[0], gn[1]};
#pragma unroll
                for (int i = 0; i < 32; ++i) wc[i] = wn[i];
                if (it + NGW < DEPTH * I_L) { pn = tr_decode(it + NGW); tr_load(wn, gn, pn, lane); }
                asm volatile("" ::: "memory");
                tr_finish(wc, gc, pc, scr, lane); } }
        const int gt = blockIdx.x * (NWAVES * 64) + tid, NGT = G * NWAVES * 64;
        for (int i = gt; i < DEPTH * 8 * 1024; i += NGT) { const int l = i / 8192, j = (i / 1024) & 7, k = i & 1023; WF[i] = j < 6 ? ap->in[I_WIN][((size_t)l * D + k) * IN_COLS + OC_BF + j] * ap->in[I_GMPRE][l * D + k] : 0.f; }
        for (int i = gt; i < 384; i += NGT) { float v[DEPTH], mx = -1e30f;
#pragma unroll
            for (int l = 0; l < DEPTH; ++l) { v[l] = ap->in[I_HLB][l * 384 + i]; mx = fmaxf(mx, v[l]); }
            float sum = 0.f;
#pragma unroll
            for (int l = 0; l < DEPTH; ++l) { v[l] = expf(v[l] - mx); sum += v[l]; }
            float run = 0.f; const float p0 = v[0] / sum;
#pragma unroll
            for (int l = 0; l < DEPTH; ++l) { run += v[l] / sum; LB[l * 384 + i] = run - p0; } }
        for (int i = gt; i < T * 32; i += NGT) { const int t = i >> 5, f = i & 31;
            const float invf = 1.0f / (float)exp2((double)f * (13.287712379549449 / 32.0));
            const float ang = (float)t * invf; const double rev = (double)ang * 0.15915494309189535; const float fr = (float)(rev - floor(rev));
            COS[i] = __builtin_amdgcn_cosf(fr); SIN[i] = __builtin_amdgcn_sinf(fr); }
        __syncthreads();
        { LAS float* wf0 = (LAS float*)lds;
          for (int i = tid; i < 6 * 1024; i += NWAVES * 64) { const int j = i >> 10, k = i & 1023; wf0[i] = ap->in[I_WIN][(size_t)k * IN_COLS + OC_BF + j] * ap->in[I_GMPRE][k]; } }
        __syncthreads();
        { f32x4 nx[4][4];
#pragma unroll
          for (int r = 0; r < 4; ++r)
#pragma unroll
              for (int j = 0; j < 4; ++j) nx[r][j] = *(const f32x4*)(ap->in[I_X] + (size_t)(4 * gw + r) * D + 4 * lane + 256 * j);
          for (int m = 4 * gw; m < M; m += 4 * NGW) { f32x4 cur[4][4];
#pragma unroll
              for (int r = 0; r < 4; ++r)
#pragma unroll
                  for (int j = 0; j < 4; ++j) cur[r][j] = nx[r][j];
              const int mn = (m + 4 * NGW < M) ? m + 4 * NGW : m;
#pragma unroll
              for (int r = 0; r < 4; ++r)
#pragma unroll
                  for (int j = 0; j < 4; ++j) nx[r][j] = *(const f32x4*)(ap->in[I_X] + (size_t)(mn + r) * D + 4 * lane + 256 * j);
              asm volatile("" ::: "memory");
              row_updateNx<4>(lane, (size_t)m, (size_t)1, ap->in[I_X], nullptr, nullptr, nullptr, (bf16*)(ws + WS_XB), nullptr, (float*)(ws + WS_RS), (const float*)lds_raw, ap->in[I_BFOX], (float*)(ws + WS_LOGF), cur); } }
    }
    GRID_BAR();

#pragma unroll 1
    for (int l = 0; l < DEPTH; ++l) {
        { PH_BEGIN
          if (gw < 96) {
            const float* LOGF = (const float*)(ws + WS_LOGF); float* FCUM = (float*)(ws + WS_FCUM);
            const int b = gw / 6, h = gw % 6; const float* lf = LOGF + ((size_t)b * T + lane) * 8 + h; float* Fo = FCUM + (size_t)gw * T + lane; float carry = 0.f;
#pragma unroll 4
            for (int i = 0; i < 64; ++i) { float v = lf[(size_t)i * 512];
                v += dppf<0x111>(v); v += dppf<0x112>(v); v += dppf<0x114>(v); v += dppf<0x118>(v);
                v += __uint_as_float((unsigned)__builtin_amdgcn_update_dpp(0, (int)__float_as_uint(v), 0x142, 0xA, 0xF, false));
                v += __uint_as_float((unsigned)__builtin_amdgcn_update_dpp(0, (int)__float_as_uint(v), 0x143, 0xC, 0xF, false));
                v += carry; Fo[i * 64] = v; carry = __uint_as_float((unsigned)__builtin_amdgcn_readlane((int)__float_as_uint(v), 63)); } }
          pg8::Gemm g{(const bf16*)(ws + WS_XB), (const bf16*)(ws + WS_WIN) + (size_t)l * NP * D, M, NP, D, 64, 64, (size_t)M * 64 * 2, (size_t)NP * 64 * 2}; pg8::StaticOrder S; S.init(M, NP, G, (int)blockIdx.x);
          pg8::EpiBf16RS E{(bf16*)(ws + WS_P), M, (const float*)(ws + WS_RS), (const float*)(ws + WS_COS), (const float*)(ws + WS_SIN), PC_CQ / 256, PC_CK / 256, lds + HALO_OFF};
          pg8::gemm_phase<pg8::EpiBf16RS, pg8::StaticOrder, true, true>(lds, g, S, E, tid); }
        GRID_BAR();
        { PH_BEGIN
          bf16* P = (bf16*)(ws + WS_P); LAS unsigned char* wl = lds + wave * 16384;
          const bool helpers = (G >= 256);
          gu32* hflag = (gu32*)(ws + WS_CTL) + CW_FLAGS + (l * 96) * 16;
          if (blockIdx.x < 160) {
              const int chain = blockIdx.x;
              if (chain < 96) { const int nend = helpers ? 32 : 64; TilePF pf; { const bf16* t0 = hgrn_tile(P, chain * 64 + wave); tile_fetch(pf, t0 + CB(PC_AF), t0 + CB(PC_AI), lane); }
                  for (int n = wave; n < nend; n += NWAVES) rec_pass1_hgrn<false>(wl, P, (const float*)(ws + WS_LB) + l * 384, (bf16*)(ws + WS_U), (float*)(ws + WS_DK), chain * 64 + n, lane, pf, n + NWAVES < nend); }
              else { TilePF pf; { const bf16* t0 = ret_tile(P, (chain - 96) * 64 + wave); tile_fetch(pf, t0 + CB(PC_CK), t0 + CB(PC_CV), lane); }
                  for (int n = wave; n < 64; n += NWAVES) rec_pass1_ret(wl, P, (bf16*)(ws + WS_U), (chain - 96) * 64 + n, lane, pf, n + NWAVES < 64); }
              asm volatile("s_waitcnt vmcnt(0)" ::: "memory"); __syncthreads();
              if (chain < 96 && helpers) {
                  if (tid == 0) { unsigned sp = 0u; while (__hip_atomic_load(hflag + chain * 16, RLX_AGENT) == 0u) { __builtin_amdgcn_s_sleep(2); if (++sp > (1u << 22)) break; }
                      __builtin_amdgcn_fence(__ATOMIC_ACQUIRE, "agent"); asm volatile("s_waitcnt vmcnt(0)" ::: "memory"); }
                  __syncthreads(); }
              rec_pass2_chain((const bf16*)(ws + WS_U), (const float*)(ws + WS_DK), (bf16*)(ws + WS_ST), chain, tid);
              asm volatile("s_waitcnt vmcnt(0)" ::: "memory"); __syncthreads();
              if (chain < 96) { TilePF pf; { const bf16* t0 = hgrn_tile(P, chain * 64 + wave); tile_fetch(pf, t0 + CB(PC_AF), t0 + CB(PC_AI), lane); }
                  for (int n = wave; n < 64; n += NWAVES) rec_pass3_hgrn(wl, P, (const float*)(ws + WS_LB) + l * 384, ap->in[I_HOG] + l * 384, (const bf16*)(ws + WS_ST), chain * 64 + n, lane, pf, n + NWAVES < 64); }
              else { TilePF pf; tile_fetch_b(pf, ret_tile(P, (chain - 96) * 64 + wave) + CB(PC_CV), lane);
                  for (int n = wave; n < 64; n += NWAVES) rec_pass3_ret(wl, P, ap->in[I_ROG] + l * 256, (const bf16*)(ws + WS_ST), (chain - 96) * 64 + n, lane, pf, n + NWAVES < 64); }
              __syncthreads();
          } else if (helpers && blockIdx.x < 256) {
              const int chain = blockIdx.x - 160;
              TilePF pf; { const bf16* t0 = hgrn_tile(P, chain * 64 + 32 + wave); tile_fetch(pf, t0 + CB(PC_AF), t0 + CB(PC_AI), lane); }
              for (int n = 32 + wave; n < 64; n += NWAVES) rec_pass1_hgrn<true>(wl, P, (const float*)(ws + WS_LB) + l * 384, (bf16*)(ws + WS_U), (float*)(ws + WS_DK), chain * 64 + n, lane, pf, n + NWAVES < 64);
              asm volatile("s_waitcnt vmcnt(0)" ::: "memory"); __syncthreads();
              if (tid == 0) __hip_atomic_store(hflag + chain * 16, 1u, RLX_AGENT);
              __syncthreads();
          }
          float gq = 0.f, gk = 0.f;
          for (int i = 0; i < 64; ++i) { gq = fmaxf(gq, fabsf(ap->in[I_QG][l * 64 + i])); gk = fmaxf(gk, fabsf(ap->in[I_KG][l * 64 + i])); }
          const float bound2 = 2.0f * (8.0f * gq * 0.125f * 1.4426950408889634f * 1.004f) * (8.0f * gk * 1.004f);
          attn_v3(lds, P, (const float*)(ws + WS_FCUM), tid, (unsigned*)((gu32*)(ws + WS_CTL) + CW_QUEUE + 128 * l), bound2, ap->in[I_QG] + l * 64, ap->in[I_KG] + l * 64); }
        GRID_BAR();
        { PH_BEGIN
          pg8::Gemm g{(const bf16*)(ws + WS_P), (const bf16*)(ws + WS_WOUT) + (size_t)l * D * D, M, D, D, 64, 64, (size_t)M * 64 * 2, (size_t)D * 64 * 2}; pg8::StaticOrder S; S.init(M, D, G, (int)blockIdx.x);
          { LAS float* gl = (LAS float*)(lds + GAIN_OFF); const float* gsrc = ap->in[I_GMPOST] + l * D; gl[tid] = gsrc[tid]; gl[tid + 512] = gsrc[tid + 512]; }
          pg8::EpiNormRes E{(bf16*)(ws + WS_XB), (const LAS float*)(lds + GAIN_OFF), (float*)(ws + WS_SLOT1), (unsigned*)((gu32*)(ws + WS_CTL) + CW_CNT + (l * 4 + 0) * 4096),
                            (float*)(ws + WS_RS), (LAS float*)(lds + HALO_OFF)};
          pg8::gemm_phase<pg8::EpiNormRes, pg8::StaticOrder, true, true>(lds, g, S, E, tid); }
        GRID_BAR();
        { PH_BEGIN
          pg8::Gemm g{(const bf16*)(ws + WS_XB), (const bf16*)(ws + WS_WUP) + (size_t)l * NUP * D, M, NUP, D, 64, 64, (size_t)M * 64 * 2, (size_t)NUP * 64 * 2}; pg8::StaticOrder S; S.init(M, NUP, G, (int)blockIdx.x);
          pg8::EpiConvAct E{(bf16*)(ws + WS_ACT), ap->in[I_CW] + (size_t)l * 3 * NUP, ap->in[I_CB] + (size_t)l * NUP, (float*)(ws + WS_EDGEL), (float*)(ws + WS_EDGEP), lds + HALO_OFF, D_FF, (const float*)(ws + WS_RS), (size_t)M * 64, lds + RING_BYTES + 10240};
          pg8::gemm_phase<pg8::EpiConvAct, pg8::StaticOrder, true, true>(lds, g, S, E, tid); }
        GRID_BAR();
        { PH_BEGIN
          pg8::Gemm g{(const bf16*)(ws + WS_ACT), (const bf16*)(ws + WS_WDN) + (size_t)l * D * D_FF, M, D, D_FF, 64, 64, (size_t)M * 64 * 2, (size_t)D * 64 * 2}; pg8::StaticOrder S; S.init(M, D, G, (int)blockIdx.x);
          { const float* EL = (const float*)(ws + WS_EDGEL); const float* EP = (const float*)(ws + WS_EDGEP); bf16* ACT = (bf16*)(ws + WS_ACT);
            const float* cw = ap->in[I_CW] + (size_t)l * 3 * NUP; pg8::Unit fu;
            for (int ui = 0; S.next(ui, fu); ++ui) { const int pm = fu.pm; if ((pm & 15) == 0) continue;
              for (int ch = tid; ch < D_FF; ch += NWAVES * 64) {
                const int ng = 256 * (ch >> 7) + (ch & 127), nv = ng + 128;
                const float w0g = cw[ch], w1g = cw[NUP + ch], w0v = cw[D_FF + ch], w1v = cw[NUP + D_FF + ch];
                const float lg0 = EL[(size_t)((pm - 1) * 2 + 0) * NUP + ng], lg1 = EL[(size_t)((pm - 1) * 2 + 1) * NUP + ng], lv0 = EL[(size_t)((pm - 1) * 2 + 0) * NUP + nv], lv1 = EL[(size_t)((pm - 1) * 2 + 1) * NUP + nv];
                const float g0 = EP[(size_t)(pm * 2 + 0) * NUP + ng] + w0g * lg0 + w1g * lg1, v0 = EP[(size_t)(pm * 2 + 0) * NUP + nv] + w0v * lv0 + w1v * lv1;
                const float g1 = EP[(size_t)(pm * 2 + 1) * NUP + ng] + w0g * lg1, v1 = EP[(size_t)(pm * 2 + 1) * NUP + nv] + w0v * lv1;
                ACT[((size_t)(ch >> 6) * M + (pm * 256 + 0)) * 64 + (ch & 63)] = (bf16)f2bf(g0 / (1.0f + __expf(-g0)) * v0);
                ACT[((size_t)(ch >> 6) * M + (pm * 256 + 1)) * 64 + (ch & 63)] = (bf16)f2bf(g1 / (1.0f + __expf(-g1)) * v1); } }
            asm volatile("s_waitcnt vmcnt(0)" ::: "memory"); __syncthreads(); }
          const bool last = (l == DEPTH - 1);
          pg8::EpiNormResFFN E{(bf16*)(ws + WS_XB), ap->in[I_GFPOST] + l * D, (float*)(ws + WS_SLOT1), (unsigned*)((gu32*)(ws + WS_CTL) + CW_CNT + (l * 4 + 2) * 4096), (float*)(ws + WS_RS), (LAS float*)(lds + HALO_OFF),
                               last ? ap->out : nullptr, (const float*)(ws + WS_WF) + (l + 1) * 8192, ap->in[I_BFOX] + (l + 1) * 6, (float*)(ws + WS_LPART), (unsigned*)((gu32*)(ws + WS_CTL) + CW_CNT + (l * 4 + 3) * 4096),
                               (float*)(ws + WS_LOGF), (LAS float*)(lds + LGL_OFF)};
          pg8::gemm_phase<pg8::EpiNormResFFN, pg8::StaticOrder, true, true>(lds, g, S, E, tid); }
        if (l < DEPTH - 1) GRID_BAR();
    }
}

extern "C" void kernel_launch(void* const* d_in, const int* in_sizes, int n_in, void* d_out, int out_size, void* d_ws, size_t ws_size, hipStream_t stream) {
    static int grid = 0;
    if (grid == 0) {
        if (n_in != 17 || in_sizes[0] != M * D || out_size != M * D || ws_size < WS_END) { fprintf(stderr, "kernel_launch: unexpected shapes (n_in %d, in0 %d, out %d, ws %zu)\n", n_in, n_in > 0 ? in_sizes[0] : -1, out_size, ws_size); grid = -1; return; }
        int dev = 0, cus = 0;
        if (hipGetDevice(&dev) != hipSuccess || hipDeviceGetAttribute(&cus, hipDeviceAttributeMultiprocessorCount, dev) != hipSuccess) { grid = -1; return; }
        if (hipFuncSetAttribute((const void*)fwd, hipFuncAttributeMaxDynamicSharedMemorySize, LDS_BYTES) != hipSuccess) { grid = -1; return; }
        (void)hipGetLastError();
        grid = cus;
    }
    if (grid < 0) return;
    if (hipMemsetAsync((char*)d_ws + WS_CTL, 0, CTL_ZERO_BYTES, stream) != hipSuccess) return;
    Args a{};
    for (int i = 0; i < 17; ++i) a.in[i] = (const float*)d_in[i];
    a.out = (float*)d_out; a.ws = (unsigned char*)d_ws;
    hipLaunchKernelGGL(fwd, dim3(grid), dim3(NWAVES * 64), LDS_BYTES, stream, a);
}
```

```cpp
#include <hip/hip_runtime.h>
#include <cstdio>
#include <cstdint>
#include <cmath>
__device__ __forceinline__ float shfl_i(float v, int src) { return __uint_as_float((unsigned)__builtin_amdgcn_ds_bpermute(src << 2, (int)__float_as_uint(v))); }
template <int CTRL> __device__ __forceinline__ float dppf(float v) { return __uint_as_float((unsigned)__builtin_amdgcn_update_dpp(0, (int)__float_as_uint(v), CTRL, 0xf, 0xf, true)); }
namespace pg8 {
#define PG8_LAS __attribute__((address_space(3)))
__device__ __forceinline__ int fresh_lane() { int l; asm volatile("v_mbcnt_lo_u32_b32 %0, -1, 0\n\tv_mbcnt_hi_u32_b32 %0, -1, %0\n\ts_nop 1" : "=v"(l)); return l; }
typedef unsigned short bf16_t;
typedef short bf16x8 __attribute__((ext_vector_type(8)));
typedef float f32x4 __attribute__((ext_vector_type(4)));
typedef unsigned u32x4 __attribute__((ext_vector_type(4)));
constexpr int BM = 256, BK = 64, HALF = 128, HTB = HALF * BK * 2  , STAGE_BYTES = 8 * HTB, NXCD = 8, WGM = 8;

__host__ __device__ __forceinline__ int lds_byte(int r, int c) { const int st = (r >> 4) * 2 + (c >> 5), rr = r & 15, cc = c & 31, ob = rr * 64 + cc * 2; return st * 1024 + (ob ^ (((ob >> 9) & 1) << 5)); }
__host__ __device__ __forceinline__ void stage_rc(int b, int& R, int& C) { const int st = b / 1024, sb = b % 1024, swz = sb ^ (((sb >> 9) & 1) << 5); R = (st >> 1) * 16 + swz / 64; C = (st & 1) * 32 + (swz % 64) / 2; }
__host__ __device__ __forceinline__ int perm32(int rho) { const int n = rho >> 4, i = rho & 15; return 8 * (i >> 2) + 4 * n + (i & 3); }

struct Unit { int pm, pn; };
struct Gemm { const bf16_t* A; const bf16_t* Bt; int M, N, K, lda, ldb; size_t kstrA, kstrB; };

struct StaticOrder {
    int nM, nN, nwg, G, c;
    __host__ __device__ void init(int M, int N, int G_, int c_) { nM = M / BM; nN = N / BM; nwg = nM * nN; G = G_; c = c_; }
    __host__ __device__ bool next(int i, Unit& u) const {
        const long L = (long)i * G + c; if (L >= nwg) return false;
        int wgid = (int)L; { const int q = nwg / NXCD, r = nwg % NXCD, xcd = wgid % NXCD, off = wgid / NXCD; wgid = (xcd < r ? xcd * (q + 1) : r * (q + 1) + (xcd - r) * q) + off; }
        const int nig = WGM * nN, gid = wgid / nig, fm = gid * WGM, gsz = (nM - fm) < WGM ? (nM - fm) : WGM;
        u.pm = fm + ((wgid % nig) % gsz); u.pn = (wgid % nig) / gsz; return true;
    }
    __device__ __forceinline__ void a_ready(const Unit&) const {}
    __device__ __forceinline__ void done(const Unit&) const {}
};


__device__ __forceinline__ unsigned cvt_pk_bf16(float lo, float hi) { unsigned r; asm volatile("v_cvt_pk_bf16_f32 %0, %1, %2" : "=v"(r) : "v"(lo), "v"(hi)); return r; }
typedef float f32x2 __attribute__((ext_vector_type(2)));

template <int ACT  > struct EpiBf16 {
    static constexpr bool PERM = true, AFTER_DRAIN = false, PREFETCH = false; static_assert(ACT == 0, "EpiBf16: ACT is 0");
    bf16_t* O; int ldc; const float* bias; int split_cols; size_t split_stride; float scale0;
    __device__ __forceinline__ void operator()(const f32x4 (&acc)[2][2][4][2], const Unit& u, int wr, int wc, int fr, int fq) const {
        const int row0 = u.pm * BM + wr * 64 + fr; int colt = u.pn * BM; bf16_t* base = O;
        float sc = 1.f; if (split_cols) { const int t = colt / split_cols; base += (size_t)t * split_stride; colt -= t * split_cols; if (t == 0) sc = scale0; }
        const int col0 = colt + wc * 32 + 8 * fq, bcol0 = u.pn * BM + wc * 32 + 8 * fq;
        f32x4 bv[2][2];
#pragma unroll
        for (int bj = 0; bj < 2; ++bj)
#pragma unroll
            for (int n = 0; n < 2; ++n) bv[bj][n] = bias ? *(const f32x4*)(bias + bcol0 + bj * HALF + 4 * n) : (f32x4){0.f, 0.f, 0.f, 0.f};
#pragma unroll
        for (int ai = 0; ai < 2; ++ai)
#pragma unroll
            for (int m = 0; m < 4; ++m) { bf16_t* rowp = base + (size_t)(row0 + ai * HALF + m * 16) * ldc + col0;
#pragma unroll
                for (int bj = 0; bj < 2; ++bj) { f32x4 v0 = acc[ai][bj][m][0] + bv[bj][0], v1 = acc[ai][bj][m][1] + bv[bj][1];

                    v0 = v0 * sc; v1 = v1 * sc; u32x4 w; w.x = cvt_pk_bf16(v0[0], v0[1]); w.y = cvt_pk_bf16(v0[2], v0[3]); w.z = cvt_pk_bf16(v1[0], v1[1]); w.w = cvt_pk_bf16(v1[2], v1[3]);
                    *(u32x4*)(rowp + bj * HALF) = w; } }
    }
};


struct EpiBf16RS {
    static constexpr bool PERM = true, AFTER_DRAIN = false, PREFETCH = true;
    bf16_t* O; int ldc; const float* rs; const float* cosT; const float* sinT; int pn_q, pn_k; PG8_LAS unsigned char* rbuf;
    __device__ __forceinline__ void prefetch(const Unit& u, int par, int wid, int lane) const {
        if (wid < 4) __builtin_amdgcn_global_load_lds((const unsigned*)(rs + ((size_t)u.pm * BM + wid * 64 + lane) * 4), (PG8_LAS unsigned*)(rbuf + par * 4096 + wid * 1024), 16, 0, 0); }
    __device__ __forceinline__ void operator()(const f32x4 (&acc)[2][2][4][2], const Unit& u, int wr, int wc, int fr, int fq, int par) const {
        const int row0 = u.pm * BM + wr * 64 + fr, col0 = u.pn * BM + wc * 64 + 8 * fq;
        const bool rot = (u.pn == pn_q) || (u.pn == pn_k); const float ksc = (u.pn == pn_k) ? 0.125f : 1.0f; const int p0 = 4 * fq;
        float scv[2][4];
#pragma unroll
        for (int ai = 0; ai < 2; ++ai)
#pragma unroll
            for (int m = 0; m < 4; ++m) { const f32x4 q4 = *(const PG8_LAS f32x4*)(rbuf + par * 4096 + (wr * 64 + fr + ai * HALF + m * 16) * 16); scv[ai][m] = __builtin_amdgcn_rsqf(((q4[0] + q4[1]) + (q4[2] + q4[3])) * (1.f / 1024.f) + 1e-6f); }
        bf16_t* rowb = O + ((size_t)(col0 >> 6) * (size_t)ldc + row0) * 64 + (col0 & 63);
        if (!rot) {
#pragma unroll
            for (int ai = 0; ai < 2; ++ai)
#pragma unroll
                for (int m = 0; m < 4; ++m) { const float sc = scv[ai][m]; bf16_t* rowp = rowb + (ai * HALF + m * 16) * 64;
#pragma unroll
                    for (int bj = 0; bj < 2; ++bj) { const f32x4 v0 = acc[ai][bj][m][0] * sc, v1 = acc[ai][bj][m][1] * sc;
                        u32x4 w; w.x = cvt_pk_bf16(v0[0], v0[1]); w.y = cvt_pk_bf16(v0[2], v0[3]); w.z = cvt_pk_bf16(v1[0], v1[1]); w.w = cvt_pk_bf16(v1[2], v1[3]);
                        *(u32x4*)(rowp + bj * 32) = w; } }
        } else {
            f32x4 cn[2], sn[2];
#pragma unroll
            for (int bj = 0; bj < 2; ++bj) { const int t = row0 & 4095; cn[bj] = *(const f32x4*)(cosT + t * 32 + p0 + 16 * bj); sn[bj] = *(const f32x4*)(sinT + t * 32 + p0 + 16 * bj); }
#pragma unroll
            for (int i = 0; i < 8; ++i) { const int ai = i >> 2, m = i & 3; const float sc = scv[ai][m]; bf16_t* rowp = rowb + (ai * HALF + m * 16) * 64;
                f32x4 c4b[2], s4b[2];
#pragma unroll
                for (int bj = 0; bj < 2; ++bj) { c4b[bj] = cn[bj] * ksc; s4b[bj] = sn[bj] * ksc; }
                if (i < 7) { const int t = (row0 + ((i + 1) >> 2) * HALF + ((i + 1) & 3) * 16) & 4095;
#pragma unroll
                    for (int bj = 0; bj < 2; ++bj) { cn[bj] = *(const f32x4*)(cosT + t * 32 + p0 + 16 * bj); sn[bj] = *(const f32x4*)(sinT + t * 32 + p0 + 16 * bj); } }
                asm volatile("" ::: "memory");
#pragma unroll
                for (int bj = 0; bj < 2; ++bj) { f32x4 v0 = acc[ai][bj][m][0] * sc, v1 = acc[ai][bj][m][1] * sc; const f32x4 c4 = c4b[bj], s4 = s4b[bj];
                    const f32x4 a0 = v0, a1 = v1;
                    v0[0] = a0[0] * c4[0] - a0[1] * s4[0]; v0[1] = a0[0] * s4[0] + a0[1] * c4[0]; v0[2] = a0[2] * c4[1] - a0[3] * s4[1]; v0[3] = a0[2] * s4[1] + a0[3] * c4[1];
                    v1[0] = a1[0] * c4[2] - a1[1] * s4[2]; v1[1] = a1[0] * s4[2] + a1[1] * c4[2]; v1[2] = a1[2] * c4[3] - a1[3] * s4[3]; v1[3] = a1[2] * s4[3] + a1[3] * c4[3];
                    u32x4 w; w.x = cvt_pk_bf16(v0[0], v0[1]); w.y = cvt_pk_bf16(v0[2], v0[3]); w.z = cvt_pk_bf16(v1[0], v1[1]); w.w = cvt_pk_bf16(v1[2], v1[3]);
                    *(u32x4*)(rowp + bj * 32) = w; } }
        }
    }
};

typedef float f32x2e __attribute__((ext_vector_type(2))); typedef __bf16 bf16x2e __attribute__((ext_vector_type(2)));
__device__ __forceinline__ unsigned cvt_pk_bf16_v(float lo, float hi) { f32x2e v = {lo, hi}; bf16x2e b = __builtin_convertvector(v, bf16x2e); return __builtin_bit_cast(unsigned, b); }
struct EpiConvAct {
    static constexpr bool PERM = true, AFTER_DRAIN = false, PREFETCH = true;
    bf16_t* ACT; const float* cw; const float* cb; float* EDGEL; float* EDGEP; PG8_LAS unsigned char* halo; int dff; const float* rs; size_t blk; PG8_LAS unsigned char* wbuf;
    __device__ __forceinline__ void prefetch(const Unit& u, int par, int wid, int lane) const {
        if (wid < 4) { const int sg = 2 * wid + (lane >> 5); const float* src = (sg < 6 ? cw + (size_t)(sg >> 1) * (2 * dff) : cb) + (sg & 1) * dff + 128 * u.pn + (lane & 31) * 4;
            __builtin_amdgcn_global_load_lds((const unsigned*)src, (PG8_LAS unsigned*)(wbuf + par * 8192 + wid * 1024), 16, 0, 0); }
        else { const float* src = rs + ((size_t)u.pm * BM + (wid - 4) * 64 + lane) * 4;
            __builtin_amdgcn_global_load_lds((const unsigned*)src, (PG8_LAS unsigned*)(wbuf + par * 8192 + 4096 + (wid - 4) * 1024), 16, 0, 0); } }
    __device__ __forceinline__ void operator()(const f32x4 (&acc)[2][2][4][2], const Unit& u, int wr, int wc, int fr, int fq, int par) const {
        { const int l_ = fresh_lane(); fr = l_ & 15; fq = l_ >> 4; }
        const int wave = wr * 4 + wc, lane = fq * 16 + fr, nup = 2 * dff;
        const int ch0 = 128 * u.pn + 32 * wc + 8 * fq;
        float rsv[2][4];
#pragma unroll
        for (int ai = 0; ai < 2; ++ai)
#pragma unroll
            for (int m = 0; m < 4; ++m) { const f32x4 q4 = *(const PG8_LAS f32x4*)(wbuf + par * 8192 + 4096 + (ai * HALF + wr * 64 + m * 16 + fr) * 16); rsv[ai][m] = __builtin_amdgcn_rsqf(((q4[0] + q4[1]) + (q4[2] + q4[3])) * (1.f / 1024.f) + 1e-6f); }
#pragma unroll
        for (int ai = 0; ai < 2; ++ai) if (fr >= 14) {
#pragma unroll
            for (int bj = 0; bj < 2; ++bj)
#pragma unroll
                for (int n = 0; n < 2; ++n) *(PG8_LAS f32x4*)(halo + ((((wave * 2 + ai) * 2 + (fr - 14)) * 4 + fq) * 64) + (bj * 2 + n) * 16) = acc[ai][bj][3][n] * rsv[ai][3]; }
        if (wr == 1 && fr >= 14) {
#pragma unroll
            for (int bj = 0; bj < 2; ++bj)
#pragma unroll
                for (int n = 0; n < 2; ++n) *(f32x4*)(EDGEL + ((size_t)(u.pm * 2 + (fr - 14))) * nup + 256 * u.pn + 128 * bj + 32 * wc + 8 * fq + 4 * n) = acc[1][bj][3][n] * rsv[1][3]; }
        asm volatile("s_waitcnt lgkmcnt(0)" ::: "memory"); __builtin_amdgcn_s_barrier(); asm volatile("" ::: "memory");
        const size_t acb = (size_t)(ch0 >> 6) * blk + (ch0 & 63);
        typedef unsigned u32x2 __attribute__((ext_vector_type(2)));
        u32x2 pend[2][4];
#pragma unroll
        for (int n = 0; n < 2; ++n) {
            f32x4 w[3][2], bb[2];
#pragma unroll
            for (int bj = 0; bj < 2; ++bj) { const PG8_LAS float* wl_ = (const PG8_LAS float*)(wbuf + par * 8192) + bj * 128 + 32 * wc + 8 * fq + 4 * n; bb[bj] = *(const PG8_LAS f32x4*)(wl_ + 6 * 128);
#pragma unroll
                for (int j = 0; j < 3; ++j) w[j][bj] = *(const PG8_LAS f32x4*)(wl_ + j * 256); }
#pragma unroll
            for (int ai = 0; ai < 2; ++ai) {
                const bool none = (ai == 0 && wr == 0); const int pw = wr == 1 ? wave - 4 : wave + 4, pai = wr == 1 ? ai : 0;
                float r1p[2][4], r2p[2][4];
#pragma unroll
                for (int bj = 0; bj < 2; ++bj) { f32x4 h = (f32x4){0.f, 0.f, 0.f, 0.f};
                    if (!none && fr >= 14) h = *(const PG8_LAS f32x4*)(halo + ((((pw * 2 + pai) * 2 + (fr - 14)) * 4 + fq) * 64) + (bj * 2 + n) * 16);
#pragma unroll
                    for (int e = 0; e < 4; ++e) { r1p[bj][e] = dppf<0x121>(h[e]); r2p[bj][e] = dppf<0x122>(h[e]); } }
#pragma unroll
                for (int m = 0; m < 4; ++m) { f32x4 c[2];
#pragma unroll
                    for (int bj = 0; bj < 2; ++bj)
#pragma unroll
                        for (int e = 0; e < 4; ++e) { const float x = acc[ai][bj][m][n][e] * rsv[ai][m]; const float r1 = dppf<0x121>(x), r2 = dppf<0x122>(x);
                            const float u1 = fr == 0 ? r1p[bj][e] : r1, u2 = fr < 2 ? r2p[bj][e] : r2;
                            c[bj][e] = bb[bj][e] + w[0][bj][e] * u2 + w[1][bj][e] * u1 + w[2][bj][e] * x; r1p[bj][e] = r1; r2p[bj][e] = r2; }
                    if (none && m == 0 && fr < 2) {
#pragma unroll
                        for (int bj = 0; bj < 2; ++bj) *(f32x4*)(EDGEP + ((size_t)(u.pm * 2 + fr)) * nup + 256 * u.pn + 128 * bj + 32 * wc + 8 * fq + 4 * n) = c[bj]; }
                    float o[4];
#pragma unroll
                    for (int e = 0; e < 4; ++e) { const float g = c[0][e]; o[e] = g * __builtin_amdgcn_rcpf(1.0f + __builtin_amdgcn_exp2f(-g * 1.4426950408889634f)) * c[1][e]; }
                    u32x2 ow; ow.x = cvt_pk_bf16_v(o[0], o[1]); ow.y = cvt_pk_bf16_v(o[2], o[3]);
                    if (n == 0) { pend[ai][m] = ow; asm volatile("" : "+v"(pend[ai][m])); }
                    else { u32x4 w4; w4.x = pend[ai][m].x; w4.y = pend[ai][m].y; w4.z = ow.x; w4.w = ow.y; *(u32x4*)(ACT + acb + (u.pm * BM + ai * HALF + wr * 64 + m * 16 + fr) * 64) = w4; } }
            }
        }
    }
};

template <class Epi, class Sched, bool ALIGN_EPI = false, bool SP2 = false>
__device__ __forceinline__ void gemm_phase(PG8_LAS unsigned char* lds, const Gemm g, const Sched& S, const Epi& E, int tid_) {
    asm volatile("" : "+v"(tid_)); const int tid = tid_, wid = __builtin_amdgcn_readfirstlane(tid >> 6), lane = tid & 63, wr = wid >> 2, wc = wid & 3, fr = lane & 15, fq = lane >> 4;
    const int K = g.K, nt = K / BK, lda = g.lda, ldb = g.ldb;
    unsigned voffA[2], voffB[2];
#pragma unroll
    for (int i = 0; i < 2; ++i) { int R, C; stage_rc(tid * 16 + i * 8192, R, C); const int Rb = Epi::PERM ? ((R & ~31) + perm32(R & 31)) : R;
        voffA[i] = (unsigned)(R * lda + C) * 2u; voffB[i] = (unsigned)(Rb * ldb + C) * 2u; }
    const size_t kstepB = g.kstrB ? g.kstrB : (size_t)(BK * 2), kstepA = g.kstrA ? g.kstrA : (size_t)(BK * 2);
    const size_t hstepA = (size_t)HALF * lda * 2, hstepB = (size_t)HALF * ldb * 2;
    const size_t tstepA = 2 * hstepA, tstepB = 2 * hstepB;
    const unsigned ldsw = (unsigned)wid * 1024u;
    const int aoff = lds_byte(wr * 64 + fr, fq * 8), boff = lds_byte(wc * 32 + fr, fq * 8);
#define PG8_SA(b, h) (((b) * 2 + (h)) * HTB)
#define PG8_SB(b, h) ((4 + (b) * 2 + (h)) * HTB)
#define PG8_STAGE(bufoff, gbase, voff) do { _Pragma("unroll") for (int _i = 0; _i < 2; ++_i) \
        __builtin_amdgcn_global_load_lds((const unsigned*)((const char*)(gbase) + (voff)[_i]), (PG8_LAS unsigned*)(lds + (bufoff) + ldsw + _i * 8192), 16, 0, 0); } while (0)
#define PG8_LDA(dst, b, h) do { _Pragma("unroll") for (int m = 0; m < 4; ++m) _Pragma("unroll") for (int k = 0; k < 2; ++k) dst[m][k] = *(const PG8_LAS bf16x8*)(lds + PG8_SA(b, h) + aoff + m * 2048 + k * 1024); } while (0)
#define PG8_LDB(dst, b, h) do { _Pragma("unroll") for (int n = 0; n < 2; ++n) _Pragma("unroll") for (int k = 0; k < 2; ++k) dst[n][k] = *(const PG8_LAS bf16x8*)(lds + PG8_SB(b, h) + boff + n * 2048 + k * 1024); } while (0)
#define PG8_MMA(ai, bj, At, Bt) do { __builtin_amdgcn_s_setprio(1); _Pragma("unroll") for (int m = 0; m < 4; ++m) _Pragma("unroll") for (int n = 0; n < 2; ++n) _Pragma("unroll") for (int k = 0; k < 2; ++k) \
        acc[ai][bj][m][n] = __builtin_amdgcn_mfma_f32_16x16x32_bf16(Bt[n][k], At[m][k], acc[ai][bj][m][n], 0, 0, 0); __builtin_amdgcn_s_setprio(0); } while (0)
#define PG8_WAIT_V(n) asm volatile("s_waitcnt vmcnt(" #n ")" ::: "memory")
#define PG8_WAIT_L(n) asm volatile("s_waitcnt lgkmcnt(" #n ")" ::: "memory")
#define PG8_BAR __builtin_amdgcn_s_barrier()
#define PG8_SCHED __builtin_amdgcn_sched_barrier(0)
    Unit cur, nxt; int ui = 0;
    if (!S.next(0, cur)) return;
    f32x4 acc[2][2][4][2];
#pragma unroll
    for (int a = 0; a < 2; ++a)
#pragma unroll
        for (int b = 0; b < 2; ++b)
#pragma unroll
            for (int m = 0; m < 4; ++m)
#pragma unroll
                for (int n = 0; n < 2; ++n) acc[a][b][m][n] = (f32x4){0.f, 0.f, 0.f, 0.f};
    bf16x8 At[4][2], B0[2][2], B1[2][2];
    const char* cA = (const char*)g.A + (size_t)cur.pm * tstepA; const char* cB = (const char*)g.Bt + (size_t)cur.pn * tstepB;
    S.a_ready(cur);
    if constexpr (Epi::PREFETCH) E.prefetch(cur, 0, wid, lane);
    if constexpr (SP2) {
        PG8_STAGE(PG8_SB(0, 0), cB, voffB); PG8_STAGE(PG8_SB(0, 1), cB + hstepB, voffB); PG8_STAGE(PG8_SA(0, 0), cA, voffA); PG8_STAGE(PG8_SA(0, 1), cA + hstepA, voffA);
        if (wr == 1) PG8_BAR;
        PG8_WAIT_V(2); PG8_BAR;
        PG8_STAGE(PG8_SB(1, 0), cB + kstepB, voffB); PG8_STAGE(PG8_SA(1, 0), cA + kstepA, voffA); PG8_STAGE(PG8_SB(1, 1), cB + hstepB + kstepB, voffB);
        PG8_WAIT_V(6); PG8_BAR;
    } else {
        PG8_STAGE(PG8_SB(0, 0), cB, voffB); PG8_STAGE(PG8_SA(0, 0), cA, voffA); PG8_STAGE(PG8_SB(0, 1), cB + hstepB, voffB); PG8_STAGE(PG8_SA(0, 1), cA + hstepA, voffA);
        if (wr == 1) PG8_BAR;
        PG8_WAIT_V(4); PG8_BAR;
        PG8_STAGE(PG8_SB(1, 0), cB + kstepB, voffB); PG8_STAGE(PG8_SA(1, 0), cA + kstepA, voffA); PG8_STAGE(PG8_SB(1, 1), cB + hstepB + kstepB, voffB);
        PG8_WAIT_V(6); PG8_BAR;
    }
    for (;;) {
        const bool has_next = S.next(ui + 1, nxt);
        const char* nA = has_next ? (const char*)g.A + (size_t)nxt.pm * tstepA : cA; const char* nB = has_next ? (const char*)g.Bt + (size_t)nxt.pn * tstepB : cB;
        for (int t = 0; t < nt; t += 2) {
            const bool last = (t == nt - 2);
            const char* a1 = cA + (size_t)(t + 1) * kstepA;
            const char* a2 = last ? nA : cA + (size_t)(t + 2) * kstepA; const char* b2 = last ? nB : cB + (size_t)(t + 2) * kstepB;
            const char* a3 = a2 + kstepA; const char* b3 = b2 + kstepB;
            if (last && has_next) { S.a_ready(nxt); if constexpr (Epi::PREFETCH) E.prefetch(nxt, (ui + 1) & 1, wid, lane); }
            if constexpr (SP2) {
            PG8_LDB(B0, 0, 0); PG8_LDB(B1, 0, 1); PG8_SCHED; PG8_LDA(At, 0, 0); PG8_STAGE(PG8_SA(1, 1), a1 + hstepA, voffA);
            PG8_WAIT_V(8); PG8_WAIT_L(0); PG8_BAR; PG8_MMA(0, 0, At, B0); PG8_MMA(0, 1, At, B1); PG8_BAR; PG8_SCHED;
            PG8_LDA(At, 0, 1); PG8_STAGE(PG8_SB(0, 0), b2, voffB); PG8_STAGE(PG8_SB(0, 1), b2 + hstepB, voffB); PG8_STAGE(PG8_SA(0, 0), a2, voffA);
            PG8_WAIT_V(8); PG8_WAIT_L(0); PG8_BAR; PG8_MMA(1, 0, At, B0); PG8_MMA(1, 1, At, B1); PG8_BAR; PG8_SCHED;
            PG8_LDB(B0, 1, 0); PG8_LDB(B1, 1, 1); PG8_SCHED; PG8_LDA(At, 1, 0); PG8_STAGE(PG8_SA(0, 1), a2 + hstepA, voffA);
            PG8_WAIT_V(8); PG8_WAIT_L(0); PG8_BAR; PG8_MMA(0, 0, At, B0); PG8_MMA(0, 1, At, B1); PG8_BAR; PG8_SCHED;
            PG8_LDA(At, 1, 1); PG8_STAGE(PG8_SB(1, 0), b3, voffB); PG8_STAGE(PG8_SB(1, 1), b3 + hstepB, voffB); PG8_STAGE(PG8_SA(1, 0), a3, voffA);
            PG8_WAIT_V(8); PG8_WAIT_L(0); PG8_BAR; PG8_MMA(1, 0, At, B0); PG8_MMA(1, 1, At, B1); PG8_BAR; PG8_SCHED;
            } else {
            PG8_LDB(B0, 0, 0); PG8_SCHED; PG8_LDA(At, 0, 0); PG8_STAGE(PG8_SA(1, 1), a1 + hstepA, voffA);
            PG8_WAIT_L(8); PG8_BAR; PG8_WAIT_L(0); PG8_MMA(0, 0, At, B0); PG8_BAR; PG8_SCHED;
            PG8_LDB(B1, 0, 1); PG8_STAGE(PG8_SB(0, 0), b2, voffB);
            PG8_BAR; PG8_WAIT_L(0); PG8_MMA(0, 1, At, B1); PG8_BAR;
            PG8_LDA(At, 0, 1); PG8_STAGE(PG8_SA(0, 0), a2, voffA);
            PG8_BAR; PG8_WAIT_L(0); PG8_MMA(1, 0, At, B0); PG8_BAR; PG8_SCHED;
            PG8_STAGE(PG8_SB(0, 1), b2 + hstepB, voffB);
            PG8_WAIT_V(6); PG8_BAR; PG8_MMA(1, 1, At, B1); PG8_BAR;
            PG8_LDB(B0, 1, 0); PG8_SCHED; PG8_LDA(At, 1, 0); PG8_STAGE(PG8_SA(0, 1), a2 + hstepA, voffA);
            PG8_WAIT_L(8); PG8_BAR; PG8_WAIT_L(0); PG8_MMA(0, 0, At, B0); PG8_BAR; PG8_SCHED;
            PG8_LDB(B1, 1, 1); PG8_STAGE(PG8_SB(1, 0), b3, voffB);
            PG8_BAR; PG8_WAIT_L(0); PG8_MMA(0, 1, At, B1); PG8_BAR;
            PG8_LDA(At, 1, 1); PG8_STAGE(PG8_SA(1, 0), a3, voffA);
            PG8_BAR; PG8_WAIT_L(0); PG8_MMA(1, 0, At, B0); PG8_BAR; PG8_SCHED;
            PG8_STAGE(PG8_SB(1, 1), b3 + hstepB, voffB);
            PG8_WAIT_V(6); PG8_BAR; PG8_MMA(1, 1, At, B1); PG8_BAR;
            }
        }
        if constexpr (ALIGN_EPI) { if (wr == 0) PG8_BAR; }
        if constexpr (!Epi::AFTER_DRAIN) { if constexpr (Epi::PREFETCH) E(acc, cur, wr, wc, fr, fq, ui & 1); else E(acc, cur, wr, wc, fr, fq); S.done(cur); }
        if (!has_next) break;
#pragma unroll
        for (int a = 0; a < 2; ++a)
#pragma unroll
            for (int b = 0; b < 2; ++b)
#pragma unroll
                for (int m = 0; m < 4; ++m)
#pragma unroll
                    for (int n = 0; n < 2; ++n) acc[a][b][m][n] = (f32x4){0.f, 0.f, 0.f, 0.f};
        cur = nxt; cA = nA; cB = nB; ++ui;
        if constexpr (ALIGN_EPI) { if (wr == 1) PG8_BAR; }
    }
    PG8_WAIT_V(0);
    if constexpr (!ALIGN_EPI) { if (wr == 0) PG8_BAR; }
    PG8_BAR;
    if constexpr (Epi::AFTER_DRAIN) { E.fused(acc, cur, wr, wc, fr, fq, lds, wid, lane); S.done(cur); }
#undef PG8_SA
#undef PG8_SB
#undef PG8_STAGE
#undef PG8_LDA
#undef PG8_LDB
#undef PG8_MMA
#undef PG8_WAIT_V
#undef PG8_WAIT_L
#undef PG8_BAR
#undef PG8_SCHED
}
}

#define GAS __attribute__((address_space(1)))
#define LAS __attribute__((address_space(3)))
typedef unsigned short bf16;
typedef unsigned v4u __attribute__((ext_vector_type(4)));
typedef unsigned v2u __attribute__((ext_vector_type(2)));
typedef float f32x4 __attribute__((ext_vector_type(4)));
typedef short bf16x8 __attribute__((ext_vector_type(8)));
typedef GAS unsigned gu32;
typedef GAS unsigned long long gu64;
#define RLX_AGENT __ATOMIC_RELAXED, __HIP_MEMORY_SCOPE_AGENT
#define LDS_WAIT() asm volatile("s_waitcnt lgkmcnt(0)" ::: "memory")
#define VM_WAIT() asm volatile("s_waitcnt vmcnt(0)" ::: "memory")
__device__ __forceinline__ unsigned long long rt() { return __builtin_amdgcn_s_memrealtime(); }
__device__ __forceinline__ unsigned f2bf(float f) { unsigned u = __builtin_bit_cast(unsigned, f); return (u + 0x7fffu + ((u >> 16) & 1u)) >> 16; }
__device__ __forceinline__ unsigned pk2(float lo, float hi) { return f2bf(lo) | (f2bf(hi) << 16); }

#define XB_TMO      128
#define XB_XCNT(j)  (256  + 64 * (j))
#define XB_XSUB(j)  (1280 + 64 * (j))
#define XB_XGEN(j)  (2304 + 64 * (j))
#define XB_TOP      3328
#define XB_TOPGEN   3392
#define XCD_BAR_WORDS 3456
#define XB_SPIN_CAP (1u << 18)

__device__ __forceinline__ unsigned xb_ld(unsigned* p)              { return __hip_atomic_load(p, __ATOMIC_RELAXED, __HIP_MEMORY_SCOPE_AGENT); }
__device__ __forceinline__ unsigned xb_add(unsigned* p, unsigned v) { return __hip_atomic_fetch_add(p, v, __ATOMIC_RELAXED, __HIP_MEMORY_SCOPE_AGENT); }
__device__ __forceinline__ unsigned xb_xcc_id() { return (unsigned)__builtin_amdgcn_s_getreg((3 << 11) | 20) & 0xFu; }
#define XB_SPIN(cond, bar) do { unsigned _sp = 0; while (cond) { __builtin_amdgcn_s_sleep(1); \
    if ((++_sp & 255u) == 0u) { if (xb_ld(&(bar)[XB_TMO])) break; if (_sp > XB_SPIN_CAP) { atomicAdd(&(bar)[XB_TMO], 1u); break; } } } } while (0)

struct XcdBarrier {
    unsigned* bar; unsigned x;
    volatile LAS unsigned* st;
};

__device__ __forceinline__ XcdBarrier xcd_barrier_post(unsigned* bar, volatile LAS unsigned* st) {
    XcdBarrier b; b.bar = bar; b.x = xb_xcc_id(); b.st = st;
    if (threadIdx.x == 0) (void)xb_add(&bar[XB_XCNT(b.x)], 1u);
    return b;
}
__device__ __forceinline__ void xcd_barrier_complete(unsigned* bar, unsigned x, unsigned& nloc, unsigned& nx) {
    const unsigned G = gridDim.x * gridDim.y * gridDim.z;
    unsigned sum, cnt, mine, sp = 0u;
    for (;;) {
        sum = 0u; cnt = 0u; mine = 0u;
#pragma unroll
        for (unsigned j = 0; j < 16; ++j) { const unsigned c = xb_ld(&bar[XB_XCNT(j)]); sum += c; cnt += (c > 0u) ? 1u : 0u; mine = (j == x) ? c : mine; }
        if (sum == G) break;
        __builtin_amdgcn_s_sleep(1);
        if ((++sp & 255u) == 0u) { if (xb_ld(&bar[XB_TMO])) break; if (sp > XB_SPIN_CAP) { atomicAdd(&bar[XB_TMO], 1u); break; } }
    }
    nloc = mine > 0u ? mine : 1u; nx = cnt > 0u ? cnt : 1u;
}

__device__ __forceinline__ void xcd_barrier(const XcdBarrier& b, bool is_t0) {
    asm volatile("s_waitcnt vmcnt(0)" ::: "memory");
    __syncthreads();
    if (is_t0) {
        unsigned* bar = b.bar;
        __builtin_amdgcn_s_waitcnt(0);
        unsigned nloc = b.st[0], nx = b.st[1];
        if (nloc == 0u) { xcd_barrier_complete(bar, b.x, nloc, nx); b.st[0] = nloc; b.st[1] = nx; }
        const unsigned old = xb_add(&bar[XB_XSUB(b.x)], 1u);
        const unsigned gen = old / nloc;
        if (old + 1u == (gen + 1u) * nloc) {
            __builtin_amdgcn_fence(__ATOMIC_RELEASE, "agent");
            asm volatile("s_waitcnt vmcnt(0)" ::: "memory");
            const unsigned og = xb_add(&bar[XB_TOP], 1u);
            const unsigned tg = og / nx;
            if (og + 1u == (tg + 1u) * nx) xb_add(&bar[XB_TOPGEN], 1u);
            else XB_SPIN(xb_ld(&bar[XB_TOPGEN]) == tg, bar);
            __builtin_amdgcn_fence(__ATOMIC_ACQUIRE, "agent");
            xb_add(&bar[XB_XGEN(b.x)], 1u);
            asm volatile("s_waitcnt vmcnt(0)" ::: "memory");
        } else {
            XB_SPIN(xb_ld(&bar[XB_XGEN(b.x)]) == gen, bar);
            __builtin_amdgcn_fence(__ATOMIC_ACQUIRE, "agent");
            asm volatile("s_waitcnt vmcnt(0)" ::: "memory");
        }
    }
    __syncthreads();
}


constexpr int NB = 16, T = 4096, D = 1024, DEPTH = 4, M = NB * T;
constexpr int HD = 64, H_HGRN = 6, H_FOX = 6, H_RET = 4;
constexpr int IN_COLS = 4102, NP = 4096, D_FF = 2816, NUP = 2 * D_FF;
constexpr float EPS = 1e-6f;
constexpr int OC_AQ = 0, OC_AF = 384, OC_AI = 768, OC_AG = 1152, OC_BQ = 1536, OC_BK = 1920, OC_BV = 2304, OC_BF = 2688, OC_BG = 2694, OC_CQ = 3078, OC_CK = 3334, OC_CV = 3590, OC_CG = 3846;
constexpr int PC_AQ = 0, PC_BQ = 384, PC_CQ = 768, PC_AF = 1024, PC_AI = 1408, PC_AG = 1792, PC_BK = 2176, PC_BV = 2560, PC_BG = 2944, PC_CK = 3328, PC_CV = 3584, PC_CG = 3840;
#define CB(pc) ((size_t)((pc) >> 6) * (size_t)M * 64)
__device__ __forceinline__ int pcol_to_orig(int n) {
    if (n < 384) return OC_AQ + n; if (n < 768) return OC_BQ + (n - 384); if (n < 1024) return OC_CQ + (n - 768);
    if (n < 1408) return OC_AF + (n - 1024); if (n < 1792) return OC_AI + (n - 1408); if (n < 2176) return OC_AG + (n - 1792);
    if (n < 2560) return OC_BK + (n - 2176); if (n < 2944) return OC_BV + (n - 2560); if (n < 3328) return OC_BG + (n - 2944);
    if (n < 3584) return OC_CK + (n - 3328); if (n < 3840) return OC_CV + (n - 3584); return OC_CG + (n - 3840);
}
constexpr size_t MiB = 1u << 20;
constexpr size_t WS_CTL = 0, CTL_ZERO_BYTES = 1 * MiB;
constexpr size_t WS_WIN = 2 * MiB, WS_WOUT = 34 * MiB, WS_WUP = 42 * MiB, WS_WDN = 86 * MiB;
constexpr size_t WS_WF = 108 * MiB;
constexpr size_t WS_COS = 109 * MiB, WS_SIN = WS_COS + 512 * 1024;
constexpr size_t WS_LB = 110 * MiB;
constexpr size_t WS_LOGF = 111 * MiB;
constexpr size_t WS_FCUM = 113 * MiB;
constexpr size_t WS_H = 116 * MiB;
constexpr size_t WS_MIX = 244 * MiB;
constexpr size_t WS_P = 372 * MiB;
constexpr size_t WS_ACT = WS_P;
constexpr size_t WS_EDGEL = WS_P + 352 * MiB, WS_EDGEP = WS_P + 364 * MiB;
constexpr size_t WS_SLOT1 = WS_MIX, WS_SLOT2 = WS_MIX + 1 * MiB, WS_LPART = WS_MIX + 2 * MiB;
constexpr size_t WS_XB = 884 * MiB;
constexpr size_t WS_RS = 114 * MiB + 512 * 1024;
constexpr size_t WS_END = 1012 * MiB;
constexpr int CW_BAR = 4096, CW_QUEUE = 16384, CW_FLAGS = 20480, CW_CNT = 65536, CW_FIX = 196608  ;
constexpr int RING_BYTES = 131072, LDSCTL_OFF = RING_BYTES, MISC_OFF = LDSCTL_OFF + 320, HALO_OFF = RING_BYTES + 1024, GAIN_OFF = RING_BYTES + 10240, LGL_OFF = RING_BYTES + 6400, LDS_BYTES = 163840;
constexpr int NWAVES = 8;

__device__ __forceinline__ float wave_sum(float v, int lane) {
    (void)lane;
    v += dppf<0xB1>(v); v += dppf<0x4E>(v); v += dppf<0x141>(v); v += dppf<0x140>(v);
    { auto r = __builtin_amdgcn_permlane16_swap(__float_as_uint(v), __float_as_uint(v), false, false); v = __uint_as_float(r[0]) + __uint_as_float(r[1]); }
    { auto r = __builtin_amdgcn_permlane32_swap(__float_as_uint(v), __float_as_uint(v), false, false); v = __uint_as_float(r[0]) + __uint_as_float(r[1]); }
    return v;
}
__device__ __forceinline__ float bf_lo(unsigned w) { return __uint_as_float(w << 16); }
__device__ __forceinline__ float bf_hi(unsigned w) { return __uint_as_float(w & 0xffff0000u); }
__device__ __forceinline__ float bf1(bf16 w) { return __uint_as_float(((unsigned)w) << 16); }

__device__ __forceinline__ void tr_item(const float* W, int ldw, int src_col0, int k0, bf16* WT, int ldt, int dst_row0_, LAS float* scr, int lane, const float* gk = nullptr, bool ilv = false, bool wperm = false) {
    const int dst_row0 = wperm ? ((dst_row0_ & ~255) | (((dst_row0_ >> 5) & 1) << 7) | (((dst_row0_ >> 6) & 3) << 5)) : dst_row0_;
    const int j_ = lane & 31, scol = src_col0 + (ilv ? ((j_ & 1) ? (j_ >> 1) + 32 : (j_ >> 1)) : j_);
    float wv[32];
#pragma unroll
    for (int i = 0; i < 32; ++i) { const int kk = 2 * i + (lane >> 5); wv[i] = W[(size_t)(k0 + kk) * ldw + scol]; }
    asm volatile("" ::: "memory");
#pragma unroll
    for (int i = 0; i < 32; ++i) { const int kk = 2 * i + (lane >> 5); scr[kk * 33 + (lane & 31)] = wv[i] * (gk ? gk[k0 + kk] : 1.0f); }
    LDS_WAIT(); asm volatile("" ::: "memory");
    const int c = lane & 7;
#pragma unroll
    for (int j = 0; j < 4; ++j) { const int n = (lane >> 3) + 8 * j; const LAS float* s = scr + (8 * c) * 33 + n;
        v4u o; o.x = pk2(s[0 * 33], s[1 * 33]); o.y = pk2(s[2 * 33], s[3 * 33]); o.z = pk2(s[4 * 33], s[5 * 33]); o.w = pk2(s[6 * 33], s[7 * 33]);
        *(GAS v4u*)(WT + ((size_t)(k0 >> 6) * ldt + dst_row0 + n) * 64 + 8 * c) = o; }
    LDS_WAIT(); asm volatile("" ::: "memory");
}

struct TrP { const float* W; int ldw, scol0, k0; bf16* WT; int ldt, drow; const float* gk; bool ilv, wperm; };
__device__ __forceinline__ void tr_load(float (&wv)[32], f32x4 (&g8)[2], const TrP& p, int lane) {
    const int j_ = lane & 31, scol = p.scol0 + (p.ilv ? ((j_ & 1) ? (j_ >> 1) + 32 : (j_ >> 1)) : j_);
#pragma unroll
    for (int i = 0; i < 32; ++i) { const int kk = 2 * i + (lane >> 5); wv[i] = p.W[(size_t)(p.k0 + kk) * p.ldw + scol]; }
    g8[0] = (f32x4){1.f, 1.f, 1.f, 1.f}; g8[1] = g8[0];
    if (p.gk) { g8[0] = *(const f32x4*)(p.gk + p.k0 + 8 * (lane & 7)); g8[1] = *(const f32x4*)(p.gk + p.k0 + 8 * (lane & 7) + 4); }
}
__device__ __forceinline__ void tr_finish(const float (&wv)[32], const f32x4 (&g8)[2], const TrP& p, LAS float* scr, int lane) {
    const int dst_row0 = p.wperm ? ((p.drow & ~255) | (((p.drow >> 5) & 1) << 7) | (((p.drow >> 6) & 3) << 5)) : p.drow;
#pragma unroll
    for (int i = 0; i < 32; ++i) { const int kk = 2 * i + (lane >> 5); scr[kk * 33 + (lane & 31)] = wv[i]; }
    LDS_WAIT(); asm volatile("" ::: "memory");
    const int c = lane & 7;
#pragma unroll
    for (int j = 0; j < 4; ++j) { const int n = (lane >> 3) + 8 * j; const LAS float* s_ = scr + (8 * c) * 33 + n;
        v4u o; o.x = pk2(s_[0 * 33] * g8[0][0], s_[1 * 33] * g8[0][1]); o.y = pk2(s_[2 * 33] * g8[0][2], s_[3 * 33] * g8[0][3]); o.z = pk2(s_[4 * 33] * g8[1][0], s_[5 * 33] * g8[1][1]); o.w = pk2(s_[6 * 33] * g8[1][2], s_[7 * 33] * g8[1][3]);
        *(GAS v4u*)(p.WT + ((size_t)(p.k0 >> 6) * p.ldt + dst_row0 + n) * 64 + 8 * c) = o; }
    LDS_WAIT(); asm volatile("" ::: "memory");
}

__device__ __forceinline__ float log_sigmoid_f(float v) { return fminf(v, 0.f) - 0.6931471805599453f * __builtin_amdgcn_logf(1.0f + __builtin_amdgcn_exp2f(-fabsf(v) * 1.4426950408889634f)); }

template <int R> __device__ __forceinline__ void row_updateNx(int lane, size_t m, size_t dm, const float* xf_base, const bf16* xb_base, const bf16* add_base, const float* gpost,
                                             bf16* xb_obase, float* xf_obase, float* rs_base, const float* wf, const float* bfox, float* logf_base, const f32x4 (*pre)[4] = nullptr) {
    const float bfl = wf ? bfox[lane < 6 ? lane : 0] : 0.f;
    f32x4 v[R][4];
#pragma unroll
    for (int r = 0; r < R; ++r) { const size_t row = m + r * dm;
        if (pre) {
#pragma unroll
            for (int j = 0; j < 4; ++j) v[r][j] = pre[r][j];
        } else if (xf_base) {
#pragma unroll
            for (int j = 0; j < 4; ++j) v[r][j] = *(const f32x4*)(xf_base + row * D + 4 * lane + 256 * j);
        } else {
#pragma unroll
            for (int j = 0; j < 4; ++j) { const uint2 w = *(const uint2*)(xb_base + row * D + 4 * lane + 256 * j); v[r][j] = (f32x4){bf_lo(w.x), bf_hi(w.x), bf_lo(w.y), bf_hi(w.y)}; }
        } }
    if (add_base) {
        f32x4 a[R][4]; float ss[R];
#pragma unroll
        for (int r = 0; r < R; ++r) ss[r] = 0.f;
#pragma unroll
        for (int r = 0; r < R; ++r)
#pragma unroll
            for (int j = 0; j < 4; ++j) { const uint2 w = *(const uint2*)(add_base + (m + r * dm) * D + 4 * lane + 256 * j); a[r][j] = (f32x4){bf_lo(w.x), bf_hi(w.x), bf_lo(w.y), bf_hi(w.y)};
                ss[r] += (a[r][j].x * a[r][j].x + a[r][j].y * a[r][j].y) + (a[r][j].z * a[r][j].z + a[r][j].w * a[r][j].w); }
        f32x4 g[4];
#pragma unroll
        for (int j = 0; j < 4; ++j) g[j] = *(const f32x4*)(gpost + 4 * lane + 256 * j);
#pragma unroll
        for (int r = 0; r < R; ++r) { const float rs = 1.0f / sqrtf(wave_sum(ss[r], lane) * (1.f / D) + EPS);
#pragma unroll
            for (int j = 0; j < 4; ++j) v[r][j] = v[r][j] + a[r][j] * rs * g[j]; }
    }
#pragma unroll
    for (int r = 0; r < R; ++r) { const size_t row = m + r * dm;
        if (xf_obase) {
#pragma unroll
            for (int j = 0; j < 4; ++j) *(f32x4*)(xf_obase + row * D + 4 * lane + 256 * j) = v[r][j];
        }
        if (xb_obase) {
#pragma unroll
            for (int j = 0; j < 4; ++j) { uint2 w; w.x = pk2(v[r][j].x, v[r][j].y); w.y = pk2(v[r][j].z, v[r][j].w); *(uint2*)(xb_obase + ((size_t)(4 * j + (lane >> 4)) * M + row) * 64 + ((4 * lane) & 63)) = w; }
        } }
    if (rs_base) {
        float rs[R];
#pragma unroll
        for (int r = 0; r < R; ++r) { float ss = 0.f;
#pragma unroll
            for (int j = 0; j < 4; ++j) ss += (v[r][j].x * v[r][j].x + v[r][j].y * v[r][j].y) + (v[r][j].z * v[r][j].z + v[r][j].w * v[r][j].w);
            const float sst = wave_sum(ss, lane); rs[r] = 1.0f / sqrtf(sst * (1.f / D) + EPS);
            if (lane == 0) *(f32x4*)(rs_base + 4 * (m + r * dm)) = (f32x4){sst, 0.f, 0.f, 0.f}; }
        if (wf) {
            float mine[R];
#pragma unroll
            for (int r = 0; r < R; ++r) mine[r] = 0.f;
#pragma unroll
            for (int jj = 0; jj < 6; ++jj) { f32x4 w[4];
#pragma unroll
                for (int j = 0; j < 4; ++j) w[j] = *(const f32x4*)(wf + jj * 1024 + 4 * lane + 256 * j);
#pragma unroll
                for (int r = 0; r < R; ++r) { float d = 0.f;
#pragma unroll
                    for (int j = 0; j < 4; ++j) d += (v[r][j].x * w[j].x + v[r][j].y * w[j].y) + (v[r][j].z * w[j].z + v[r][j].w * w[j].w);
                    d = wave_sum(d, lane); if (lane == jj) mine[r] = d; } }
            if (lane < 6) {
#pragma unroll
                for (int r = 0; r < R; ++r) logf_base[(m + r * dm) * 8 + lane] = log_sigmoid_f(mine[r] * rs[r] + bfl); }
        }
    }
}


template <int R> __device__ __forceinline__ void row_pass_pf(int lane, int gw, int NGW, bf16* XB, const bf16* MIXp, const float* gpost, bool write_xb, float* xf_obase, float* rs_base,
                                                             const float* wf, const float* bfox, float* logf_base) {
    uint2 xr[R][4], ar[R][4];
    const size_t step = (size_t)R * NGW; size_t m = (size_t)R * gw;
#pragma unroll
    for (int r = 0; r < R; ++r)
#pragma unroll
        for (int j = 0; j < 4; ++j) { xr[r][j] = *(const uint2*)(XB + (m + r) * D + 4 * lane + 256 * j); ar[r][j] = *(const uint2*)(MIXp + (m + r) * D + 4 * lane + 256 * j); }
    f32x4 g[4];
#pragma unroll
    for (int j = 0; j < 4; ++j) g[j] = *(const f32x4*)(gpost + 4 * lane + 256 * j);
    for (; m < (size_t)M; m += step) {
        f32x4 v[R][4], a[R][4]; float ss[R];
#pragma unroll
        for (int r = 0; r < R; ++r) { ss[r] = 0.f;
#pragma unroll
            for (int j = 0; j < 4; ++j) { v[r][j] = (f32x4){bf_lo(xr[r][j].x), bf_hi(xr[r][j].x), bf_lo(xr[r][j].y), bf_hi(xr[r][j].y)}; a[r][j] = (f32x4){bf_lo(ar[r][j].x), bf_hi(ar[r][j].x), bf_lo(ar[r][j].y), bf_hi(ar[r][j].y)};
                ss[r] += (a[r][j].x * a[r][j].x + a[r][j].y * a[r][j].y) + (a[r][j].z * a[r][j].z + a[r][j].w * a[r][j].w); } }
        const size_t mn = m + step;
        if (mn < (size_t)M) {
#pragma unroll
            for (int r = 0; r < R; ++r)
#pragma unroll
                for (int j = 0; j < 4; ++j) { xr[r][j] = *(const uint2*)(XB + (mn + r) * D + 4 * lane + 256 * j); ar[r][j] = *(const uint2*)(MIXp + (mn + r) * D + 4 * lane + 256 * j); } }
        asm volatile("" ::: "memory");
        float rs2[R], s2t[R];
#pragma unroll
        for (int r = 0; r < R; ++r) { const float rs = 1.0f / sqrtf(wave_sum(ss[r], lane) * (1.f / D) + EPS); float s2 = 0.f;
#pragma unroll
            for (int j = 0; j < 4; ++j) { v[r][j] = v[r][j] + a[r][j] * rs * g[j]; s2 += (v[r][j].x * v[r][j].x + v[r][j].y * v[r][j].y) + (v[r][j].z * v[r][j].z + v[r][j].w * v[r][j].w); }
            s2t[r] = wave_sum(s2, lane); rs2[r] = 1.0f / sqrtf(s2t[r] * (1.f / D) + EPS); }
#pragma unroll
        for (int r = 0; r < R; ++r) {
            if (write_xb) {
#pragma unroll
                for (int j = 0; j < 4; ++j) { uint2 w; w.x = pk2(v[r][j].x, v[r][j].y); w.y = pk2(v[r][j].z, v[r][j].w); *(uint2*)(XB + (m + r) * D + 4 * lane + 256 * j) = w; }
            } else {
#pragma unroll
                for (int j = 0; j < 4; ++j) *(f32x4*)(xf_obase + (m + r) * D + 4 * lane + 256 * j) = v[r][j];
            }
            if (rs_base && lane == 0) *(f32x4*)(rs_base + 4 * (m + r)) = (f32x4){s2t[r], 0.f, 0.f, 0.f}; }
        if (wf) {
            float mine[R];
#pragma unroll
            for (int r = 0; r < R; ++r) mine[r] = 0.f;
#pragma unroll
            for (int jj = 0; jj < 6; ++jj) { f32x4 w[4];
#pragma unroll
                for (int j = 0; j < 4; ++j) w[j] = *(const f32x4*)(wf + jj * 1024 + 4 * lane + 256 * j);
#pragma unroll
                for (int r = 0; r < R; ++r) { float d = 0.f;
#pragma unroll
                    for (int j = 0; j < 4; ++j) d += (v[r][j].x * w[j].x + v[r][j].y * w[j].y) + (v[r][j].z * w[j].z + v[r][j].w * w[j].w);
                    d = wave_sum(d, lane); if (lane == jj) mine[r] = d; } }
            if (lane < 6) {
#pragma unroll
                for (int r = 0; r < R; ++r) logf_base[(m + r) * 8 + lane] = log_sigmoid_f(mine[r] * rs2[r] + bfox[lane]); }
        }
    }
}

namespace pg8 {
__device__ __forceinline__ float fq_sum(float v) {
    { auto r = __builtin_amdgcn_permlane16_swap(__float_as_uint(v), __float_as_uint(v), false, false); v = __uint_as_float(r[0]) + __uint_as_float(r[1]); }
    { auto r = __builtin_amdgcn_permlane32_swap(__float_as_uint(v), __float_as_uint(v), false, false); v = __uint_as_float(r[0]) + __uint_as_float(r[1]); }
    return v; }
struct EpiNormRes {
    static constexpr bool PERM = true, AFTER_DRAIN = false, PREFETCH = false;
    bf16_t* XB; const PG8_LAS float* gl; float* SLOT1; unsigned* CNT1; float* RS; PG8_LAS float* red;
    __device__ __forceinline__ void operator()(f32x4 (&acc)[2][2][4][2], const Unit& u, int wr, int wc, int fr, int fq) const {
        { const int l_ = fresh_lane(); fr = l_ & 15; fq = l_ >> 4; }
        const int tid = (wr * 4 + wc) * 64 + fq * 16 + fr, rl0 = wr * 64 + fr;
        PG8_LAS float* rowfac = red + 1024; volatile PG8_LAS unsigned* bc = (volatile PG8_LAS unsigned*)(red + 1280);
        const int col0 = u.pn * BM + wc * 64 + 8 * fq;
#pragma unroll
        for (int ai = 0; ai < 2; ++ai)
#pragma unroll
            for (int m = 0; m < 4; ++m) { float s = 0.f;
#pragma unroll
                for (int bj = 0; bj < 2; ++bj)
#pragma unroll
                    for (int n = 0; n < 2; ++n) { const f32x4 a = acc[ai][bj][m][n]; s += (a[0] * a[0] + a[1] * a[1]) + (a[2] * a[2] + a[3] * a[3]); }
                s = fq_sum(s); if (fq == 0) red[(rl0 + ai * HALF + m * 16) * 4 + wc] = s; }
        asm volatile("s_waitcnt lgkmcnt(0)" ::: "memory"); __builtin_amdgcn_s_barrier(); asm volatile("" ::: "memory");
        if (tid < 256) { const f32x4 q = *(const PG8_LAS f32x4*)(red + 4 * tid); __hip_atomic_store(SLOT1 + (size_t)(u.pm * 4 + u.pn) * 256 + tid, (q[0] + q[1]) + (q[2] + q[3]), __ATOMIC_RELAXED, __HIP_MEMORY_SCOPE_AGENT); }
        asm volatile("s_waitcnt vmcnt(0)" ::: "memory"); __builtin_amdgcn_s_barrier(); asm volatile("" ::: "memory");
        u32x4 xw[2][4][2];
#pragma unroll
        for (int ai = 0; ai < 2; ++ai)
#pragma unroll
            for (int m = 0; m < 4; ++m)
#pragma unroll
                for (int bj = 0; bj < 2; ++bj) xw[ai][m][bj] = *(const u32x4*)(XB + ((size_t)(col0 >> 6) * M + (u.pm * BM + rl0 + ai * HALF + m * 16)) * 64 + (col0 & 63) + 32 * bj);
        if (tid == 0) { unsigned* c = CNT1 + u.pm * 16; __hip_atomic_fetch_add(c, 1u, __ATOMIC_RELAXED, __HIP_MEMORY_SCOPE_AGENT); unsigned sp = 0u;
            while (__hip_atomic_load(c, __ATOMIC_RELAXED, __HIP_MEMORY_SCOPE_AGENT) < 4u) { __builtin_amdgcn_s_sleep(1); if (++sp > (1u << 22)) break; }
            __builtin_amdgcn_fence(__ATOMIC_ACQUIRE, "agent"); asm volatile("s_waitcnt vmcnt(0)" ::: "memory"); }
        __builtin_amdgcn_s_barrier(); asm volatile("" ::: "memory");
        if (tid < 256) { float tot = 0.f;
#pragma unroll
            for (int q = 0; q < 4; ++q) tot += SLOT1[(size_t)(u.pm * 4 + q) * 256 + tid];
            rowfac[tid] = __builtin_amdgcn_rsqf(tot * (1.f / 1024.f) + 1e-6f); }
        asm volatile("s_waitcnt lgkmcnt(0)" ::: "memory"); __builtin_amdgcn_s_barrier(); asm volatile("" ::: "memory");
#pragma unroll
        for (int ai = 0; ai < 2; ++ai)
#pragma unroll
            for (int m = 0; m < 4; ++m) { const int rl = rl0 + ai * HALF + m * 16; const float ry = rowfac[rl]; float s2 = 0.f;
#pragma unroll
                for (int bj = 0; bj < 2; ++bj) { const u32x4 xo = xw[ai][m][bj];
                    const PG8_LAS float* gp = gl + col0 + bj * 32;
                    f32x4 v0 = acc[ai][bj][m][0] * ry * *(const PG8_LAS f32x4*)gp, v1 = acc[ai][bj][m][1] * ry * *(const PG8_LAS f32x4*)(gp + 4);
                    v0[0] += __uint_as_float(xo.x << 16); v0[1] += __uint_as_float(xo.x & 0xffff0000u); v0[2] += __uint_as_float(xo.y << 16); v0[3] += __uint_as_float(xo.y & 0xffff0000u);
                    v1[0] += __uint_as_float(xo.z << 16); v1[1] += __uint_as_float(xo.z & 0xffff0000u); v1[2] += __uint_as_float(xo.w << 16); v1[3] += __uint_as_float(xo.w & 0xffff0000u);
                    s2 += ((v0[0] * v0[0] + v0[1] * v0[1]) + (v0[2] * v0[2] + v0[3] * v0[3])) + ((v1[0] * v1[0] + v1[1] * v1[1]) + (v1[2] * v1[2] + v1[3] * v1[3]));
                    acc[ai][bj][m][0] = v0; acc[ai][bj][m][1] = v1; }
                s2 = fq_sum(s2); if (fq == 0) red[rl * 4 + wc] = s2; }
        asm volatile("s_waitcnt lgkmcnt(0)" ::: "memory"); __builtin_amdgcn_s_barrier(); asm volatile("" ::: "memory");
        if (tid < 256) { const f32x4 q = *(const PG8_LAS f32x4*)(red + 4 * tid); RS[(size_t)(u.pm * BM + tid) * 4 + u.pn] = (q[0] + q[1]) + (q[2] + q[3]); }
#pragma unroll
        for (int ai = 0; ai < 2; ++ai)
#pragma unroll
            for (int m = 0; m < 4; ++m) { bf16_t* rowp = XB + ((size_t)(col0 >> 6) * M + (u.pm * BM + rl0 + ai * HALF + m * 16)) * 64 + (col0 & 63);
#pragma unroll
                for (int bj = 0; bj < 2; ++bj) { const f32x4 v0 = acc[ai][bj][m][0], v1 = acc[ai][bj][m][1];
                    u32x4 w; w.x = cvt_pk_bf16_v(v0[0], v0[1]); w.y = cvt_pk_bf16_v(v0[2], v0[3]); w.z = cvt_pk_bf16_v(v1[0], v1[1]); w.w = cvt_pk_bf16_v(v1[2], v1[3]);
                    *(u32x4*)(rowp + bj * 32) = w; } }
    }
};
struct EpiNormResFFN {
    static constexpr bool PERM = true, AFTER_DRAIN = false, PREFETCH = false;
    bf16_t* XB; const float* gain; float* SLOT1; unsigned* CNT1; float* RS; PG8_LAS float* red; float* XF; const float* WF; const float* bias; float* LPART; unsigned* CNT2; float* LOGF; PG8_LAS float* lgl;
    __device__ __forceinline__ void operator()(f32x4 (&acc)[2][2][4][2], const Unit& u, int wr, int wc, int fr, int fq) const {
        { const int l_ = fresh_lane(); fr = l_ & 15; fq = l_ >> 4; }
        const int tid = (wr * 4 + wc) * 64 + fq * 16 + fr, rl0 = wr * 64 + fr;
        PG8_LAS float* rowfac = red + 1024; volatile PG8_LAS unsigned* bc = (volatile PG8_LAS unsigned*)(red + 1280);
        const int col0 = u.pn * BM + wc * 64 + 8 * fq;
        lgl[tid] = gain[tid]; lgl[tid + 512] = gain[tid + 512];
#pragma unroll
        for (int ai = 0; ai < 2; ++ai)
#pragma unroll
            for (int m = 0; m < 4; ++m) { float s = 0.f;
#pragma unroll
                for (int bj = 0; bj < 2; ++bj)
#pragma unroll
                    for (int n = 0; n < 2; ++n) { const f32x4 a = acc[ai][bj][m][n]; s += (a[0] * a[0] + a[1] * a[1]) + (a[2] * a[2] + a[3] * a[3]); }
                s = fq_sum(s); if (fq == 0) red[(rl0 + ai * HALF + m * 16) * 4 + wc] = s; }
        asm volatile("s_waitcnt lgkmcnt(0)" ::: "memory"); __builtin_amdgcn_s_barrier(); asm volatile("" ::: "memory");
        if (tid < 256) { const f32x4 q = *(const PG8_LAS f32x4*)(red + 4 * tid); __hip_atomic_store(SLOT1 + (size_t)(u.pm * 4 + u.pn) * 256 + tid, (q[0] + q[1]) + (q[2] + q[3]), __ATOMIC_RELAXED, __HIP_MEMORY_SCOPE_AGENT); }
        asm volatile("s_waitcnt vmcnt(0)" ::: "memory"); __builtin_amdgcn_s_barrier(); asm volatile("" ::: "memory");
        u32x4 xw[2][4][2];
#pragma unroll
        for (int ai = 0; ai < 2; ++ai)
#pragma unroll
            for (int m = 0; m < 4; ++m)
#pragma unroll
                for (int bj = 0; bj < 2; ++bj) xw[ai][m][bj] = *(const u32x4*)(XB + ((size_t)(col0 >> 6) * M + (u.pm * BM + rl0 + ai * HALF + m * 16)) * 64 + (col0 & 63) + 32 * bj);
        if (tid == 0) { unsigned* c = CNT1 + u.pm * 16; __hip_atomic_fetch_add(c, 1u, __ATOMIC_RELAXED, __HIP_MEMORY_SCOPE_AGENT); unsigned sp = 0u;
            while (__hip_atomic_load(c, __ATOMIC_RELAXED, __HIP_MEMORY_SCOPE_AGENT) < 4u) { __builtin_amdgcn_s_sleep(1); if (++sp > (1u << 22)) break; }
            __builtin_amdgcn_fence(__ATOMIC_ACQUIRE, "agent"); asm volatile("s_waitcnt vmcnt(0)" ::: "memory"); }
        __builtin_amdgcn_s_barrier(); asm volatile("" ::: "memory");
        if (tid < 256) { float tot = 0.f;
#pragma unroll
            for (int q = 0; q < 4; ++q) tot += SLOT1[(size_t)(u.pm * 4 + q) * 256 + tid];
            rowfac[tid] = __builtin_amdgcn_rsqf(tot * (1.f / 1024.f) + 1e-6f); }
        asm volatile("s_waitcnt lgkmcnt(0)" ::: "memory"); __builtin_amdgcn_s_barrier(); asm volatile("" ::: "memory");
#pragma unroll
        for (int ai = 0; ai < 2; ++ai)
#pragma unroll
            for (int m = 0; m < 4; ++m) { const int rl = rl0 + ai * HALF + m * 16; const float ry = rowfac[rl]; float s2 = 0.f;
#pragma unroll
                for (int bj = 0; bj < 2; ++bj) { const u32x4 xo = xw[ai][m][bj];
                    const PG8_LAS float* gp = lgl + col0 + bj * 32;
                    f32x4 v0 = acc[ai][bj][m][0] * ry * *(const PG8_LAS f32x4*)gp, v1 = acc[ai][bj][m][1] * ry * *(const PG8_LAS f32x4*)(gp + 4);
                    v0[0] += __uint_as_float(xo.x << 16); v0[1] += __uint_as_float(xo.x & 0xffff0000u); v0[2] += __uint_as_float(xo.y << 16); v0[3] += __uint_as_float(xo.y & 0xffff0000u);
                    v1[0] += __uint_as_float(xo.z << 16); v1[1] += __uint_as_float(xo.z & 0xffff0000u); v1[2] += __uint_as_float(xo.w << 16); v1[3] += __uint_as_float(xo.w & 0xffff0000u);
                    s2 += ((v0[0] * v0[0] + v0[1] * v0[1]) + (v0[2] * v0[2] + v0[3] * v0[3])) + ((v1[0] * v1[0] + v1[1] * v1[1]) + (v1[2] * v1[2] + v1[3] * v1[3]));
                    acc[ai][bj][m][0] = v0; acc[ai][bj][m][1] = v1; }
                if (!XF) { s2 = fq_sum(s2); if (fq == 0) red[rl * 4 + wc] = s2; } }
        if (XF) {
            int rl0b = rl0, col0b = col0; asm volatile("" : "+v"(rl0b), "+v"(col0b));
#pragma unroll
            for (int ai = 0; ai < 2; ++ai)
#pragma unroll
                for (int m = 0; m < 4; ++m) { float* rowp = XF + (size_t)(u.pm * BM + rl0b + ai * HALF + m * 16) * 1024 + col0b;
#pragma unroll
                    for (int bj = 0; bj < 2; ++bj) { *(f32x4*)(rowp + bj * 32) = acc[ai][bj][m][0]; *(f32x4*)(rowp + bj * 32 + 4) = acc[ai][bj][m][1]; } }
            return; }
        f32x4 wfc[2][2], wfn[2][2];
#pragma unroll
        for (int bj = 0; bj < 2; ++bj)
#pragma unroll
            for (int n = 0; n < 2; ++n) wfc[bj][n] = *(const f32x4*)(WF + col0 + bj * 32 + 4 * n);
        asm volatile("s_waitcnt lgkmcnt(0)" ::: "memory"); __builtin_amdgcn_s_barrier(); asm volatile("" ::: "memory");
#pragma unroll
        for (int j = 0; j < 6; ++j) {
            if (j < 5) {
#pragma unroll
                for (int bj = 0; bj < 2; ++bj)
#pragma unroll
                    for (int n = 0; n < 2; ++n) wfn[bj][n] = *(const f32x4*)(WF + (j + 1) * 1024 + col0 + bj * 32 + 4 * n); }
#pragma unroll
            for (int ai = 0; ai < 2; ++ai)
#pragma unroll
                for (int m = 0; m < 4; ++m) { float d = 0.f;
#pragma unroll
                    for (int bj = 0; bj < 2; ++bj)
#pragma unroll
                        for (int n = 0; n < 2; ++n) { const f32x4 a = acc[ai][bj][m][n], w = wfc[bj][n]; d += (a[0] * w[0] + a[1] * w[1]) + (a[2] * w[2] + a[3] * w[3]); }
                    d = fq_sum(d); if (fq == 0) lgl[((rl0 + ai * HALF + m * 16) * 4 + wc) * 6 + j] = d; }
#pragma unroll
            for (int bj = 0; bj < 2; ++bj)
#pragma unroll
                for (int n = 0; n < 2; ++n) wfc[bj][n] = wfn[bj][n]; }
        asm volatile("s_waitcnt lgkmcnt(0)" ::: "memory"); __builtin_amdgcn_s_barrier(); asm volatile("" ::: "memory");
        if (tid < 256) { const f32x4 q = *(const PG8_LAS f32x4*)(red + 4 * tid); const float s2t = (q[0] + q[1]) + (q[2] + q[3]);
            RS[(size_t)(u.pm * BM + tid) * 4 + u.pn] = s2t;
            float* lp = LPART + ((size_t)(u.pm * 4 + u.pn) * 256 + tid) * 8; __hip_atomic_store(lp, s2t, __ATOMIC_RELAXED, __HIP_MEMORY_SCOPE_AGENT);
#pragma unroll
            for (int j = 0; j < 6; ++j) { const PG8_LAS float* lg = lgl + (tid * 4) * 6 + j; __hip_atomic_store(lp + 1 + j, (lg[0] + lg[6]) + (lg[12] + lg[18]), __ATOMIC_RELAXED, __HIP_MEMORY_SCOPE_AGENT); } }
        asm volatile("s_waitcnt vmcnt(0)" ::: "memory"); __builtin_amdgcn_s_barrier(); asm volatile("" ::: "memory");
        if (tid == 0) { const unsigned old = __hip_atomic_fetch_add(CNT2 + u.pm * 16, 1u, __ATOMIC_RELAXED, __HIP_MEMORY_SCOPE_AGENT);
            if (old == 3u) { __builtin_amdgcn_fence(__ATOMIC_ACQUIRE, "agent"); asm volatile("s_waitcnt vmcnt(0)" ::: "memory"); }
            *bc = old; }
        asm volatile("s_waitcnt lgkmcnt(0)" ::: "memory"); __builtin_amdgcn_s_barrier(); asm volatile("" ::: "memory");
        if (*bc == 3u && tid < 256) { float t7[7];
#pragma unroll
            for (int j = 0; j < 7; ++j) t7[j] = 0.f;
#pragma unroll
            for (int q = 0; q < 4; ++q) { const f32x4* lp = (const f32x4*)(LPART + ((size_t)(u.pm * 4 + q) * 256 + tid) * 8); const f32x4 p0 = lp[0], p1 = lp[1];
                t7[0] += p0[0]; t7[1] += p0[1]; t7[2] += p0[2]; t7[3] += p0[3]; t7[4] += p1[0]; t7[5] += p1[1]; t7[6] += p1[2]; }
            const float rs = __builtin_amdgcn_rsqf(t7[0] * (1.f / 1024.f) + 1e-6f);
#pragma unroll
            for (int j = 0; j < 6; ++j) LOGF[(size_t)(u.pm * BM + tid) * 8 + j] = ::log_sigmoid_f(t7[1 + j] * rs + bias[j]); }
        int rl0c = rl0, col0c = col0; asm volatile("" : "+v"(rl0c), "+v"(col0c));
#pragma unroll
        for (int ai = 0; ai < 2; ++ai)
#pragma unroll
            for (int m = 0; m < 4; ++m) { bf16_t* rowp = XB + ((size_t)(col0c >> 6) * M + (u.pm * BM + rl0c + ai * HALF + m * 16)) * 64 + (col0c & 63);
#pragma unroll
                for (int bj = 0; bj < 2; ++bj) { const f32x4 v0 = acc[ai][bj][m][0], v1 = acc[ai][bj][m][1];
                    u32x4 w; w.x = cvt_pk_bf16_v(v0[0], v0[1]); w.y = cvt_pk_bf16_v(v0[2], v0[3]); w.z = cvt_pk_bf16_v(v1[0], v1[1]); w.w = cvt_pk_bf16_v(v1[2], v1[3]);
                    *(u32x4*)(rowp + bj * 32) = w; } }
    }
};
}

typedef float f32x16 __attribute__((ext_vector_type(16)));
typedef short s16x4 __attribute__((ext_vector_type(4)));
typedef unsigned u32x4 __attribute__((ext_vector_type(4)));
typedef float f32x2_t __attribute__((ext_vector_type(2))); typedef __bf16 bf16x2_t __attribute__((ext_vector_type(2)));
__device__ __forceinline__ unsigned cvt_pk_bf16(float lo, float hi) { f32x2_t v = {lo, hi}; bf16x2_t b = __builtin_convertvector(v, bf16x2_t); return __builtin_bit_cast(unsigned, b); }
__device__ __forceinline__ int crow(int r, int hi) { return (r & 3) + 8 * (r >> 2) + 4 * hi; }
__device__ __forceinline__ s16x4 vtr(const LAS unsigned char* p) { return __builtin_bit_cast(s16x4, __builtin_amdgcn_ds_read_tr16_b64_v4i16((LAS s16x4*)p)); }
constexpr float ATT_THR = 40.0f, ATT_MOVE = 8.0f;
__device__ __forceinline__ float half_swap_max(float v) { auto r = __builtin_amdgcn_permlane32_swap(__float_as_uint(v), __float_as_uint(v), false, false); return fmaxf(__uint_as_float(r[0]), __uint_as_float(r[1])); }
__device__ __forceinline__ float half_swap_sum(float v) { auto r = __builtin_amdgcn_permlane32_swap(__float_as_uint(v), __float_as_uint(v), false, false); return __uint_as_float(r[0]) + __uint_as_float(r[1]); }
__device__ __forceinline__ void attn_v3(LAS unsigned char* lds, bf16* P, const float* FCUM, int tid, unsigned* qctr, float bound2, const float* qgain, const float* kgain) {
    constexpr int A2_KCH = 1056;
    constexpr int A2_KA = 0, A2_KB = 9216, A2_VA = 18432, A2_VB = 26624, A2_BUF = 34816, A2_Z = 2 * A2_BUF, A2_Q = A2_Z + 1024, A2_G = A2_Q + 1024;
    const int wid = __builtin_amdgcn_readfirstlane(tid >> 6), tid_in = tid;
    int qsel = (int)(xb_xcc_id() & 7u), qleft = 8, par = 0;
    if (tid == 0) { unsigned v = 192u;
        while (qleft > 0) { v = __hip_atomic_fetch_add(qctr + 16 * qsel, 1u, __ATOMIC_RELAXED, __HIP_MEMORY_SCOPE_AGENT); if (v < 192u) break; qsel = (qsel + 1) & 7; --qleft; }
        *(LAS unsigned*)(lds + A2_Q) = qleft > 0 ? (unsigned)qsel * 192u + v : 0xffffffffu; }
    if (tid < 64) *(LAS float*)(lds + A2_Q + 64 + 4 * tid) = qgain[tid] * kgain[tid];
    v4u qraw[4]; uint2 gwr[2][4]; v4u kA, vA, kB, vB; float freg, fq0;
    auto fetch = [&](int uc, int t_, v4u (&q_)[4], uint2 (&g_)[2][4]) {
        const int lane = t_ & 63, r32 = lane & 31, hi = lane >> 5, sr = t_ >> 3, sch = t_ & 7;
        const int vq_ = uc % 192, bh = 12 * (uc / 192) + vq_ % 12, qb = 15 - vq_ / 12, b = bh / 6, h = bh % 6;
        const size_t rowbase = (size_t)b * T; const int q0 = qb * 256, tq = q0 + wid * 32 + r32, NT = (q0 + 256) / 64;
        const bf16* qp = (P + CB(PC_BQ) + ((size_t)h * M + rowbase) * 64) + (tq * 64 + hi * 8);
#pragma unroll
        for (int ks = 0; ks < 4; ++ks) q_[ks] = *(const v4u*)(qp + 16 * ks);
        const int kvo = sr * 64 + sch * 8; const bf16* kg = (P + CB(PC_BK) + ((size_t)h * M + rowbase) * 64) + kvo; const bf16* vg = (P + CB(PC_BV) + ((size_t)h * M + rowbase) * 64) + kvo;
        kA = *(const v4u*)(kg + (size_t)(NT - 1) * 64 * 64); vA = *(const v4u*)(vg + (size_t)(NT - 1) * 64 * 64); kB = *(const v4u*)(kg + (size_t)(NT - 2) * 64 * 64); vB = *(const v4u*)(vg + (size_t)(NT - 2) * 64 * 64);
        const float* fb = FCUM + (size_t)bh * T;
        freg = fb[(t_ & 127) + (NT - 2) * 64]; fq0 = fb[q0];
        const bf16* gp = (P + CB(PC_BG) + ((size_t)h * M + rowbase) * 64) + tq * 64;
#pragma unroll
        for (int db = 0; db < 2; ++db)
#pragma unroll
            for (int jg = 0; jg < 4; ++jg) g_[db][jg] = *(const uint2*)(gp + 32 * db + 8 * jg + 4 * hi); };
    __syncthreads();
    int u = __builtin_amdgcn_readfirstlane((int)*(const LAS unsigned*)(lds + A2_Q));
    fetch(u < 0 ? 0 : u, tid_in, qraw, gwr);
    for (;;) {
        if (u < 0) break;
        int tid = tid_in; asm volatile("" : "+v"(tid));
        const int lane = tid & 63, r32 = lane & 31, hi = lane >> 5;
        const int sr = tid >> 3, sch = tid & 7;
        const int vb0 = ((lane >> 4) & 1) * 32 + (lane & 3) * 8 + (4 * hi + ((lane & 15) >> 2)) * 64;
        unsigned nv = 192u;
        if (tid == 0 && qleft > 0) nv = __hip_atomic_fetch_add(qctr + 16 * qsel, 1u, __ATOMIC_RELAXED, __HIP_MEMORY_SCOPE_AGENT);
        par ^= 1;
        {
            const int vq_ = u % 192, bh = 12 * (u / 192) + vq_ % 12, qb = 15 - vq_ / 12, b = bh / 6, h = bh % 6;
            const size_t rowbase = (size_t)b * T; const int q0 = qb * 256, tq = q0 + wid * 32 + r32;
            bf16x8 qf[4];
#pragma unroll
            for (int db = 0; db < 2; ++db)
#pragma unroll
                for (int jg = 0; jg < 4; ++jg) { v2u t_; t_.x = gwr[db][jg].x; t_.y = gwr[db][jg].y; *(LAS v2u*)(lds + A2_G + (db * 4 + jg) * 4096 + tid * 8) = t_; }
            { const LAS float* gl = (const LAS float*)(lds + A2_Q + 64);
              float qx[4][8]; float ss = 0.f;
#pragma unroll
              for (int ks = 0; ks < 4; ++ks) { const v4u w = qraw[ks];
                  qx[ks][0] = bf_lo(w.x); qx[ks][1] = bf_hi(w.x); qx[ks][2] = bf_lo(w.y); qx[ks][3] = bf_hi(w.y); qx[ks][4] = bf_lo(w.z); qx[ks][5] = bf_hi(w.z); qx[ks][6] = bf_lo(w.w); qx[ks][7] = bf_hi(w.w);
#pragma unroll
                  for (int e = 0; e < 8; ++e) ss += qx[ks][e] * qx[ks][e]; }
              ss = half_swap_sum(ss);
              const float rs = (0.125f * 1.4426950408889634f) / sqrtf(ss * (1.f / 64.f) + EPS);
#pragma unroll
              for (int ks = 0; ks < 4; ++ks) { const f32x4 g0 = *(const LAS f32x4*)(gl + 16 * ks + 8 * hi), g1 = *(const LAS f32x4*)(gl + 16 * ks + 8 * hi + 4); float y[8];
#pragma unroll
                  for (int e = 0; e < 4; ++e) { y[e] = qx[ks][e] * rs * g0[e]; y[4 + e] = qx[ks][4 + e] * rs * g1[e]; }
                  u32x4 w; w.x = cvt_pk_bf16(y[0], y[1]); w.y = cvt_pk_bf16(y[2], y[3]); w.z = cvt_pk_bf16(y[4], y[5]); w.w = cvt_pk_bf16(y[6], y[7]); qf[ks] = __builtin_bit_cast(bf16x8, w); }
            }
            float m = 0.f, lsum = 0.f; f32x16 o0, o1;
#pragma unroll
            for (int r = 0; r < 16; ++r) { o0[r] = 0.f; o1[r] = 0.f; }
            const int NT = (q0 + 256) / 64, NS = NT / 2;
            const int kvo = sr * 64 + sch * 8; const bf16* kg = (P + CB(PC_BK) + ((size_t)h * M + rowbase) * 64) + kvo; const bf16* vg = (P + CB(PC_BV) + ((size_t)h * M + rowbase) * 64) + kvo;
            const float* fb = FCUM + (size_t)bh * T; const float* fg = fb + (tid & 127);
            const float lim = -ATT_THR - bound2 - fq0 * 1.4426950408889634f;
#pragma unroll 1
            for (int it = 0; it < NS; ++it) {
                const int jA = NT - 1 - 2 * it, jB = jA - 1;
                { LAS unsigned char* buf = lds + (it & 1) * A2_BUF;
#pragma unroll
                  for (int tl = 0; tl < 2; ++tl) { const v4u kr = tl ? kB : kA;
                    float kx[8] = {bf_lo(kr.x), bf_hi(kr.x), bf_lo(kr.y), bf_hi(kr.y), bf_lo(kr.z), bf_hi(kr.z), bf_lo(kr.w), bf_hi(kr.w)}; float ss = 0.f;
#pragma unroll
                    for (int e = 0; e < 8; ++e) ss += kx[e] * kx[e];
                    ss += dppf<0xB1>(ss); ss += dppf<0x4E>(ss); ss += dppf<0x141>(ss);
                    const float rs = __builtin_amdgcn_rsqf(ss * (1.f / 64.f) + EPS);
#pragma unroll
                    for (int e = 0; e < 8; ++e) kx[e] = kx[e] * rs;
                    u32x4 w; w.x = cvt_pk_bf16(kx[0], kx[1]); w.y = cvt_pk_bf16(kx[2], kx[3]); w.z = cvt_pk_bf16(kx[4], kx[5]); w.w = cvt_pk_bf16(kx[6], kx[7]);
                    *(LAS u32x4*)(buf + (tl ? A2_KB : A2_KA) + sch * A2_KCH + sr * 16) = w; }
                  *(LAS v4u*)(buf + A2_VA + (sch >> 2) * 4096 + sr * 64 + (sch & 3) * 16) = vA;
                  *(LAS v4u*)(buf + A2_VB + (sch >> 2) * 4096 + sr * 64 + (sch & 3) * 16) = vB;
                  if (tid < 128) *(LAS float*)(buf + (tid < 64 ? A2_KB : A2_KA) + 8 * A2_KCH + (tid & 63) * 4) = -freg * 1.4426950408889634f; }
                const int ja2 = jA - 2 > 0 ? jA - 2 : 0, jb2 = jB - 2 > 0 ? jB - 2 : 0, jb1 = jB - 1 > 0 ? jB - 1 : 0;
                kA = *(const v4u*)(kg + (size_t)ja2 * 64 * 64); vA = *(const v4u*)(vg + (size_t)ja2 * 64 * 64); kB = *(const v4u*)(kg + (size_t)jb2 * 64 * 64); vB = *(const v4u*)(vg + (size_t)jb2 * 64 * 64);
                if (tid < 128) freg = fg[jb2 * 64];
                const float fchk = fb[jb1 * 64 + 63];
                asm volatile("s_waitcnt lgkmcnt(0)" ::: "memory"); __builtin_amdgcn_s_barrier(); asm volatile("" ::: "memory");
                if (jB * 64 <= q0 + wid * 32 + 31) {
                    const LAS unsigned char* buf = lds + (it & 1) * A2_BUF;
                    f32x16 s[4];
                    bf16x8 ka[3][2];
#define A2_KLOAD(g_, d_) do { const LAS unsigned char* kp_ = buf + (((g_) & 1) ? A2_KA : A2_KB) + (2 * ((g_) >> 1) + hi) * A2_KCH + r32 * 16; d_[0] = *(const LAS bf16x8*)kp_; d_[1] = *(const LAS bf16x8*)(kp_ + 512); } while (0)
                    A2_KLOAD(0, ka[0]); A2_KLOAD(1, ka[1]);
#pragma unroll
                    for (int c = 0; c < 4; ++c) { const LAS unsigned char* bp = buf + (c < 2 ? A2_KB : A2_KA) + 8 * A2_KCH + (32 * (c & 1) + 4 * hi) * 4;
#pragma unroll
                        for (int g = 0; g < 4; ++g) { const f32x4 b4 = *(const LAS f32x4*)(bp + 32 * g);
#pragma unroll
                            for (int e = 0; e < 4; ++e) s[c][4 * g + e] = b4[e]; } }
                    __builtin_amdgcn_sched_barrier(0);
#pragma unroll
                    for (int c = 0; c < 4; ++c)
#pragma unroll
                        for (int r = 0; r < 16; ++r) s[c][r] -= m;
                    __builtin_amdgcn_sched_barrier(0);
#pragma unroll
                    for (int g = 0; g < 8; ++g) { const int ks = g >> 1, tl = g & 1;
                        if (g + 2 < 8) A2_KLOAD(g + 2, ka[(g + 2) % 3]);
                        __builtin_amdgcn_sched_barrier(0);
                        s[2 * tl] = __builtin_amdgcn_mfma_f32_32x32x16_bf16(ka[g % 3][0], qf[ks], s[2 * tl], 0, 0, 0);
                        s[2 * tl + 1] = __builtin_amdgcn_mfma_f32_32x32x16_bf16(ka[g % 3][1], qf[ks], s[2 * tl + 1], 0, 0, 0);
                        __builtin_amdgcn_sched_barrier(0); }
#undef A2_KLOAD
                    if (it < 2) {
                        const int R0 = q0 + wid * 32;
#pragma unroll
                        for (int c = 0; c < 4; ++c) { const int kb = (c < 2 ? jB : jA) * 64 + 32 * (c & 1);
                            if (kb > R0) {
#pragma unroll
                                for (int r = 0; r < 16; ++r) s[c][r] = -1e30f; }
                            else if (kb == R0) {
#pragma unroll
                                for (int r = 0; r < 16; ++r) if (crow(r, hi) > r32) s[c][r] = -1e30f; } } }
                    float mxa = fmaxf(s[0][0], s[1][0]), mxb = fmaxf(s[2][0], s[3][0]);
#pragma unroll
                    for (int r = 1; r < 16; ++r) { mxa = fmaxf(fmaxf(mxa, s[0][r]), s[1][r]); mxb = fmaxf(fmaxf(mxb, s[2][r]), s[3][r]); }
                    const float mx = half_swap_max(fmaxf(mxa, mxb));
                    float ps = 0.f;
                    if (it == 0 || __builtin_amdgcn_ballot_w64(mx > ATT_MOVE) != 0ull) {
                        const float d = (it == 0) ? mx : fmaxf(mx, 0.f), alpha = __builtin_amdgcn_exp2f(-d); m += d;
#pragma unroll
                        for (int c = 0; c < 4; ++c)
#pragma unroll
                            for (int r = 0; r < 16; ++r) { s[c][r] = __builtin_amdgcn_exp2f(s[c][r] - d); ps += s[c][r]; }
                        lsum = lsum * alpha + ps;
#pragma unroll
                        for (int r = 0; r < 16; ++r) { o0[r] *= alpha; o1[r] *= alpha; }
                    } else {
#pragma unroll
                        for (int c = 0; c < 4; ++c)
#pragma unroll
                            for (int r = 0; r < 16; ++r) { s[c][r] = __builtin_amdgcn_exp2f(s[c][r]); ps += s[c][r]; }
                        lsum += ps;
                    }
                    bf16x8 vfa[3], vfb[3];
#define A2_VLOAD(g_, i_) do { const LAS unsigned char* vp_ = buf + (((g_) >> 1) < 2 ? A2_VB : A2_VA) + vb0 + (((g_) >> 1) & 1) * 2048 + ((g_) & 1) * 1024; \
                        const s16x4 al_ = vtr(vp_), ah_ = vtr(vp_ + 512), bl_ = vtr(vp_ + 4096), bh_ = vtr(vp_ + 4096 + 512); \
                        vfa[i_] = (bf16x8){al_[0], al_[1], al_[2], al_[3], ah_[0], ah_[1], ah_[2], ah_[3]}; vfb[i_] = (bf16x8){bl_[0], bl_[1], bl_[2], bl_[3], bh_[0], bh_[1], bh_[2], bh_[3]}; } while (0)
                    A2_VLOAD(0, 0); A2_VLOAD(1, 1);
                    __builtin_amdgcn_sched_barrier(0);
#pragma unroll
                    for (int g = 0; g < 8; ++g) { const int c = g >> 1, h2 = g & 1;
                        if (g + 2 < 8) A2_VLOAD(g + 2, (g + 2) % 3);
                        u32x4 w; w.x = cvt_pk_bf16(s[c][8 * h2 + 0], s[c][8 * h2 + 1]); w.y = cvt_pk_bf16(s[c][8 * h2 + 2], s[c][8 * h2 + 3]); w.z = cvt_pk_bf16(s[c][8 * h2 + 4], s[c][8 * h2 + 5]); w.w = cvt_pk_bf16(s[c][8 * h2 + 6], s[c][8 * h2 + 7]);
                        const bf16x8 pa = __builtin_bit_cast(bf16x8, w);
                        __builtin_amdgcn_sched_barrier(0);
                        o0 = __builtin_amdgcn_mfma_f32_32x32x16_bf16(vfa[g % 3], pa, o0, 0, 0, 0);
                        o1 = __builtin_amdgcn_mfma_f32_32x32x16_bf16(vfb[g % 3], pa, o1, 0, 0, 0);
                        __builtin_amdgcn_sched_barrier(0); }
#undef A2_VLOAD
                }
                if (jB > 0 && jB - 1 < NT - 4 && -fchk * 1.4426950408889634f < lim) break;
            }
            lsum = half_swap_sum(lsum);
            const float inv = 1.0f / lsum;
            if (tid == 0) { unsigned v = nv;
                while (v >= 192u && qleft > 0) { qsel = (qsel + 1) & 7; if (--qleft <= 0) break; v = __hip_atomic_fetch_add(qctr + 16 * qsel, 1u, __ATOMIC_RELAXED, __HIP_MEMORY_SCOPE_AGENT); }
                *(LAS unsigned*)(lds + A2_Q + 4 * par) = (qleft > 0 && v < 192u) ? (unsigned)qsel * 192u + v : 0xffffffffu; }
            asm volatile("s_waitcnt lgkmcnt(0)" ::: "memory"); __builtin_amdgcn_s_barrier(); asm volatile("" ::: "memory");
            const int un = __builtin_amdgcn_readfirstlane((int)*(const LAS unsigned*)(lds + A2_Q + 4 * par));
            fetch(un < 0 ? 0 : un, tid, qraw, gwr);
            __builtin_amdgcn_sched_barrier(0); asm volatile("" ::: "memory");
            bf16* op = (P + CB(PC_BQ) + ((size_t)h * M + rowbase) * 64) + tq * 64;
#pragma unroll
            for (int db = 0; db < 2; ++db)
#pragma unroll
                for (int jg = 0; jg < 4; ++jg) { const int d = 32 * db + 8 * jg + 4 * hi; const v2u gw2 = *(const LAS v2u*)(lds + A2_G + (db * 4 + jg) * 4096 + tid * 8);
                    const float g[4] = {bf_lo(gw2.x), bf_hi(gw2.x), bf_lo(gw2.y), bf_hi(gw2.y)}; float ov[4];
#pragma unroll
                    for (int e = 0; e < 4; ++e) ov[e] = (db ? o1[4 * jg + e] : o0[4 * jg + e]) * inv * __builtin_amdgcn_rcpf(1.0f + __builtin_amdgcn_exp2f(-g[e] * 1.4426950408889634f));
                    uint2 ow; ow.x = pk2(ov[0], ov[1]); ow.y = pk2(ov[2], ov[3]); *(uint2*)(op + d) = ow; }
            u = un;
        }
    }
}

constexpr size_t WS_U = WS_H;
constexpr size_t WS_ST = WS_H + 160 * MiB;
constexpr size_t WS_DK = WS_H + 240 * MiB;
constexpr int N_HG_UNITS = 96 * 64, N_RT_UNITS = 64 * 64;
__device__ __forceinline__ void stage_tile(LAS unsigned char* dst, const bf16* src, int lane) {
#pragma unroll
    for (int i = 0; i < 8; ++i) { const int r = i * 8 + (lane >> 3), ch = lane & 7; const v4u w = *(const v4u*)(src + (size_t)r * 64 + ch * 8);
        *(LAS v4u*)(dst + (ch >> 2) * 4096 + r * 64 + (ch & 3) * 16) = w; }
}
__device__ __forceinline__ bf16x8 ltri_op(int tb, int ts, int t_l, int hi) {
    const int t = 32 * tb + t_l; bf16x8 o;
#pragma unroll
    for (int j = 0; j < 8; ++j) { const int tp = 16 * ts + 8 * (j >> 2) + 4 * hi + (j & 3); o[j] = (tp <= t) ? (short)0x3f80 : (short)0; }
    return o;
}
__device__ __forceinline__ bf16x8 pack8(const float* x) { u32x4 w; w.x = cvt_pk_bf16(x[0], x[1]); w.y = cvt_pk_bf16(x[2], x[3]); w.z = cvt_pk_bf16(x[4], x[5]); w.w = cvt_pk_bf16(x[6], x[7]); return __builtin_bit_cast(bf16x8, w); }
__device__ __forceinline__ bf16x8 vfrag(const LAS unsigned char* p) { const s16x4 lo = vtr(p), hi4 = vtr(p + 512); return (bf16x8){lo[0], lo[1], lo[2], lo[3], hi4[0], hi4[1], hi4[2], hi4[3]}; }
__device__ __forceinline__ float s16f(short s) { return __uint_as_float(((unsigned)(unsigned short)s) << 16); }
#define MFMA32(a, b, c) __builtin_amdgcn_mfma_f32_32x32x16_bf16((a), (b), (c), 0, 0, 0)
__device__ __forceinline__ void hgrn_gate(float z, float lb, float& lf2, float& kk) {
    z = fminf(fmaxf(z, -30.f), 30.f);
    const float e = __builtin_amdgcn_exp2f(-z * 1.4426950408889634f), sig = __builtin_amdgcn_rcpf(1.0f + e);
    const float f = lb + (1.0f - lb) * sig; lf2 = __builtin_amdgcn_logf(fmaxf(f, 1e-12f)); kk = (1.0f - lb) * (e * sig);
}

struct TilePF { v4u a[8], b[8]; };
__device__ __forceinline__ void tile_fetch(TilePF& r, const bf16* sa, const bf16* sb, int lane) {
#pragma unroll
    for (int i = 0; i < 8; ++i) { const int rr = i * 8 + (lane >> 3), ch = lane & 7; r.a[i] = *(const v4u*)(sa + (size_t)rr * 64 + ch * 8); r.b[i] = *(const v4u*)(sb + (size_t)rr * 64 + ch * 8); }
}
__device__ __forceinline__ void tile_put(LAS unsigned char* da, LAS unsigned char* db, const TilePF& r, int lane) {
#pragma unroll
    for (int i = 0; i < 8; ++i) { const int rr = i * 8 + (lane >> 3), ch = lane & 7; const int o = (ch >> 2) * 4096 + rr * 64 + (ch & 3) * 16; *(LAS v4u*)(da + o) = r.a[i]; *(LAS v4u*)(db + o) = r.b[i]; }
}
__device__ __forceinline__ void tile_fetch_b(TilePF& r, const bf16* sb, int lane) {
#pragma unroll
    for (int i = 0; i < 8; ++i) { const int rr = i * 8 + (lane >> 3), ch = lane & 7; r.b[i] = *(const v4u*)(sb + (size_t)rr * 64 + ch * 8); }
}
__device__ __forceinline__ void tile_put_b(LAS unsigned char* db, const TilePF& r, int lane) {
#pragma unroll
    for (int i = 0; i < 8; ++i) { const int rr = i * 8 + (lane >> 3), ch = lane & 7; *(LAS v4u*)(db + (ch >> 2) * 4096 + rr * 64 + (ch & 3) * 16) = r.b[i]; }
}
__device__ __forceinline__ const bf16* hgrn_tile(const bf16* P, int unit) { const int chain = unit >> 6, n = unit & 63, b = chain / 6, h = chain % 6; return P + ((size_t)h * M + (size_t)b * T + n * 64) * 64; }
template <bool WT  >
__device__ __forceinline__ void rec_pass1_hgrn(LAS unsigned char* wl, const bf16* P, const float* LBl, bf16* U, float* DK, int unit, int lane, TilePF& pf, bool has_next) {
    const int c_l = lane & 31, hi = lane >> 5, chain = unit >> 6, h = chain % 6;
    const bf16* tile = hgrn_tile(P, unit);
    const float lb0_ = LBl[h * 64 + c_l], lb1_ = LBl[h * 64 + 32 + c_l];
    tile_put(wl, wl + 8192, pf, lane);
    { const size_t nx = has_next ? (size_t)NWAVES * 4096 : 0; tile_fetch(pf, tile + CB(PC_AF) + nx, tile + CB(PC_AI) + nx, lane); }
    asm volatile("s_waitcnt lgkmcnt(0)" ::: "memory");
    const int vb0 = ((lane >> 4) & 1) * 32 + (lane & 3) * 8 + (4 * hi + ((lane & 15) >> 2)) * 64;
    bf16* Uo = U + (size_t)unit * 4096;
#pragma unroll 1
    for (int fb = 0; fb < 2; ++fb) {
        const float lb = fb ? lb1_ : lb0_;
        float kk[4][8]; bf16x8 lfh[4], lfl[4]; s16x4 zr[4][2];
#pragma unroll
        for (int ts = 0; ts < 4; ++ts)
#pragma unroll
            for (int jj = 0; jj < 2; ++jj) zr[ts][jj] = vtr(wl + fb * 4096 + (16 * ts + 8 * jj) * 64 + vb0);
        __builtin_amdgcn_sched_barrier(0);
#pragma unroll
        for (int ts = 0; ts < 4; ++ts) { float lf[8], lo[8];
#pragma unroll
            for (int jj = 0; jj < 2; ++jj) { const s16x4 z4 = zr[ts][jj];
#pragma unroll
                for (int e = 0; e < 4; ++e) hgrn_gate(s16f(z4[e]), lb, lf[4 * jj + e], kk[ts][4 * jj + e]); }
            lfh[ts] = pack8(lf);
#pragma unroll
            for (int j = 0; j < 8; ++j) lo[j] = lf[j] - s16f(lfh[ts][j]);
            lfl[ts] = pack8(lo); }
        f32x16 cum[2];
#pragma unroll
        for (int tb = 0; tb < 2; ++tb) {
#pragma unroll
            for (int r = 0; r < 16; ++r) cum[tb][r] = 0.f;
#pragma unroll
            for (int ts = 0; ts < 2 * tb + 2; ++ts) { const bf16x8 L = ltri_op(tb, ts, c_l, hi); cum[tb] = MFMA32(L, lfh[ts], cum[tb]); cum[tb] = MFMA32(L, lfl[ts], cum[tb]); } }
        const float c63 = shfl_i(cum[1][15], 32 + c_l);
        if (hi == 0) { float* dkp = DK + (size_t)unit * 64 + 32 * fb + c_l; const float dkv = __builtin_amdgcn_exp2f(c63); if (WT) __hip_atomic_store(dkp, dkv, __ATOMIC_RELAXED, __HIP_MEMORY_SCOPE_AGENT); else *dkp = dkv; }
        bf16x8 kh[4];
#pragma unroll
        for (int ts = 0; ts < 4; ++ts) { float x[8];
#pragma unroll
            for (int j = 0; j < 8; ++j) x[j] = kk[ts][j] * __builtin_amdgcn_exp2f(c63 - cum[ts >> 1][8 * (ts & 1) + j]);
            kh[ts] = pack8(x); }
#pragma unroll
        for (int vb = 0; vb < 2; ++vb) { f32x16 acc;
#pragma unroll
            for (int r = 0; r < 16; ++r) acc[r] = 0.f;
#pragma unroll
            for (int ts = 0; ts < 4; ++ts) acc = MFMA32(vfrag(wl + 8192 + vb * 4096 + ts * 1024 + vb0), kh[ts], acc);
#pragma unroll
            for (int r = 0; r < 16; ++r) { bf16* up_ = Uo + (32 * vb + crow(r, hi)) * 64 + 32 * fb + c_l; const bf16 uv_ = (bf16)f2bf(acc[r]); if (WT) __hip_atomic_store(up_, uv_, __ATOMIC_RELAXED, __HIP_MEMORY_SCOPE_AGENT); else *up_ = uv_; } }
    }
}
__device__ __forceinline__ const bf16* ret_tile(const bf16* P, int unit) { const int chain = unit >> 6, n = unit & 63, b = chain / 4, h = chain % 4; return P + ((size_t)h * M + (size_t)b * T + n * 64) * 64; }
__device__ __forceinline__ void rec_pass1_ret(LAS unsigned char* wl, const bf16* P, bf16* U, int unit, int lane, TilePF& pf, bool has_next) {
    const int c_l = lane & 31, hi = lane >> 5, chain = unit >> 6, h = chain % 4;
    const bf16* tile = ret_tile(P, unit);
    tile_put(wl, wl + 8192, pf, lane);
    { const size_t nx = has_next ? (size_t)NWAVES * 4096 : 0; tile_fetch(pf, tile + CB(PC_CK) + nx, tile + CB(PC_CV) + nx, lane); }
    asm volatile("s_waitcnt lgkmcnt(0)" ::: "memory");
    const int vb0 = ((lane >> 4) & 1) * 32 + (lane & 3) * 8 + (4 * hi + ((lane & 15) >> 2)) * 64;
    const float lg2 = __builtin_amdgcn_logf(1.0f - __builtin_amdgcn_exp2f(-5.0f - (float)h));
    bf16* Uo = U + (size_t)(N_HG_UNITS + unit) * 4096;
    bf16x8 kh[2][4];
#pragma unroll
    for (int ts = 0; ts < 4; ++ts) { float x0[8], x1[8];
#pragma unroll
        for (int jj = 0; jj < 2; ++jj) { const s16x4 a4 = vtr(wl + (16 * ts + 8 * jj) * 64 + vb0), b4 = vtr(wl + 4096 + (16 * ts + 8 * jj) * 64 + vb0);
#pragma unroll
            for (int e = 0; e < 4; ++e) { const int t = 16 * ts + 8 * jj + 4 * hi + e; const float w = __builtin_amdgcn_exp2f(lg2 * (float)(63 - t));
                x0[4 * jj + e] = s16f(a4[e]) * w; x1[4 * jj + e] = s16f(b4[e]) * w; } }
        kh[0][ts] = pack8(x0); kh[1][ts] = pack8(x1); }
#pragma unroll
    for (int vb = 0; vb < 2; ++vb) { bf16x8 vf[4];
#pragma unroll
        for (int ts = 0; ts < 4; ++ts) vf[ts] = vfrag(wl + 8192 + vb * 4096 + ts * 1024 + vb0);
#pragma unroll
        for (int fb = 0; fb < 2; ++fb) { f32x16 acc;
#pragma unroll
            for (int r = 0; r < 16; ++r) acc[r] = 0.f;
#pragma unroll
            for (int ts = 0; ts < 4; ++ts) acc = MFMA32(vf[ts], kh[fb][ts], acc);
#pragma unroll
            for (int r = 0; r < 16; ++r) Uo[(32 * vb + crow(r, hi)) * 64 + 32 * fb + c_l] = (bf16)f2bf(acc[r]); } }
}
__device__ __forceinline__ void rec_pass2_chain(const bf16* U, const float* DK, bf16* ST, int chain, int tid) {
    constexpr int NE = 8;
    const int k = tid & 63, kp = (k & ~12) | ((k & 8) >> 1) | ((k & 4) << 1); const bool hg = chain < 96;
    const bf16* up = U + (size_t)chain * 64 * 4096 + tid; bf16* sp = ST + (size_t)chain * 64 * 4096 + (tid & ~63) + kp;
    const float* dp = DK + (size_t)(hg ? chain : 0) * 64 * 64 + k; int h = (chain - 96) & 3; asm volatile("" : "+s"(h));
    const float g64 = __builtin_amdgcn_exp2f(64.0f * __builtin_amdgcn_logf(1.0f - __builtin_amdgcn_exp2f(-5.0f - (float)h)));
    float S[NE];
#pragma unroll
    for (int i = 0; i < NE; ++i) S[i] = 0.f;
    bf16 un[8][NE]; float dn[8];
#pragma unroll
    for (int j = 0; j < 8; ++j) { dn[j] = hg ? dp[j * 64] : g64;
#pragma unroll
        for (int i = 0; i < NE; ++i) un[j][i] = up[(size_t)j * 4096 + 512 * i]; }
#pragma unroll 1
    for (int nb = 0; nb < 64; nb += 8) { bf16 uc[8][NE]; float dc[8];
#pragma unroll
        for (int j = 0; j < 8; ++j) { dc[j] = dn[j];
#pragma unroll
            for (int i = 0; i < NE; ++i) uc[j][i] = un[j][i]; }
        if (nb + 8 < 64) {
#pragma unroll
            for (int j = 0; j < 8; ++j) { dn[j] = hg ? dp[(nb + 8 + j) * 64] : g64;
#pragma unroll
                for (int i = 0; i < NE; ++i) un[j][i] = up[(size_t)(nb + 8 + j) * 4096 + 512 * i]; } }
        asm volatile("" ::: "memory");
#pragma unroll
        for (int j = 0; j < 8; ++j)
#pragma unroll
            for (int i = 0; i < NE; ++i) { sp[(size_t)(nb + j) * 4096 + 512 * i] = (bf16)f2bf(S[i]); S[i] = dc[j] * S[i] + bf1(uc[j][i]); } }
}
__device__ __forceinline__ void rec_pass3_tail(const LAS unsigned char* vt, const bf16x8 (&qt)[2][2][2], const bf16x8 (&kt)[2][2][2], const bf16x8 (&qh)[2][2][2], const bf16* STu,
                                               const float* gain, const bf16* grow  , bf16* orow, int lane, TilePF* pf = nullptr, const bf16* nxa = nullptr, const bf16* nxb = nullptr) {
    asm volatile("" : "+v"(lane));
    const int t_l = lane & 31, hi = lane >> 5;
    const int vb0 = ((lane >> 4) & 1) * 32 + (lane & 3) * 8 + (4 * hi + ((lane & 15) >> 2)) * 64;
    bf16x8 sfr[2][2][2];
#pragma unroll
    for (int vb = 0; vb < 2; ++vb)
#pragma unroll
        for (int fb = 0; fb < 2; ++fb)
#pragma unroll
            for (int ks = 0; ks < 2; ++ks) sfr[vb][fb][ks] = *(const bf16x8*)(STu + (32 * vb + t_l) * 64 + 32 * fb + 16 * ks + 8 * hi);
    __builtin_amdgcn_sched_barrier(0);
    bf16x8 pt[3][2];
#pragma unroll
    for (int blk = 0; blk < 3; ++blk) { const int sb = blk == 2 ? 1 : 0, tb = blk == 0 ? 0 : 1; f32x16 sc;
#pragma unroll
        for (int r = 0; r < 16; ++r) sc[r] = 0.f;
#pragma unroll
        for (int fb = 0; fb < 2; ++fb)
#pragma unroll
            for (int ks = 0; ks < 2; ++ks) sc = MFMA32(kt[sb][fb][ks], qt[tb][fb][ks], sc);
        if (sb == tb) {
#pragma unroll
            for (int r = 0; r < 16; ++r) if (crow(r, hi) > t_l) sc[r] = 0.f; }
#pragma unroll
        for (int s16 = 0; s16 < 2; ++s16) { float x[8];
#pragma unroll
            for (int j = 0; j < 8; ++j) x[j] = sc[8 * s16 + j];
            pt[blk][s16] = pack8(x); } }
    uint2 gwr[2][2][4];
#pragma unroll
    for (int tb = 0; tb < 2; ++tb)
#pragma unroll
        for (int vb = 0; vb < 2; ++vb)
#pragma unroll
            for (int g4 = 0; g4 < 4; ++g4) gwr[tb][vb][g4] = *(const uint2*)(grow + (size_t)tb * 32 * 64 + 32 * vb + 8 * g4 + 4 * hi);
    __builtin_amdgcn_sched_barrier(0);
    f32x16 o[2][2];
#pragma unroll
    for (int vb = 0; vb < 2; ++vb) {
#pragma unroll
        for (int tb = 0; tb < 2; ++tb)
#pragma unroll
            for (int r = 0; r < 16; ++r) o[vb][tb][r] = 0.f;
#pragma unroll
        for (int sb = 0; sb < 2; ++sb)
#pragma unroll
            for (int s16 = 0; s16 < 2; ++s16) { const bf16x8 vf = vfrag(vt + vb * 4096 + (32 * sb + 16 * s16) * 64 + vb0);
                if (sb == 0) { o[vb][0] = MFMA32(vf, pt[0][s16], o[vb][0]); o[vb][1] = MFMA32(vf, pt[1][s16], o[vb][1]); }
                else o[vb][1] = MFMA32(vf, pt[2][s16], o[vb][1]); }
#pragma unroll
        for (int fb = 0; fb < 2; ++fb)
#pragma unroll
            for (int ks = 0; ks < 2; ++ks) { const bf16x8 sf = sfr[vb][fb][ks];
                o[vb][0] = MFMA32(sf, qh[0][fb][ks], o[vb][0]); o[vb][1] = MFMA32(sf, qh[1][fb][ks], o[vb][1]); }
    }
    f32x4 gnr[2][4];
#pragma unroll
    for (int vb = 0; vb < 2; ++vb)
#pragma unroll
        for (int g4 = 0; g4 < 4; ++g4) gnr[vb][g4] = *(const f32x4*)(gain + 32 * vb + 8 * g4 + 4 * hi);
    if (pf) { if (nxa) tile_fetch(*pf, nxa, nxb, lane); else tile_fetch_b(*pf, nxb, lane); }
    __builtin_amdgcn_sched_barrier(0);
#pragma unroll
    for (int tb = 0; tb < 2; ++tb) { float ss = 0.f;
#pragma unroll
        for (int vb = 0; vb < 2; ++vb)
#pragma unroll
            for (int r = 0; r < 16; ++r) ss += o[vb][tb][r] * o[vb][tb][r];
        ss += shfl_i(ss, lane ^ 32);
        const float rs = 1.0f / sqrtf(ss * (1.f / 64.f) + EPS);
#pragma unroll
        for (int vb = 0; vb < 2; ++vb)
#pragma unroll
            for (int g4 = 0; g4 < 4; ++g4) { const int c = 32 * vb + 8 * g4 + 4 * hi; const uint2 gw2 = gwr[tb][vb][g4]; const f32x4 gn = gnr[vb][g4];
                const float g[4] = {bf_lo(gw2.x), bf_hi(gw2.x), bf_lo(gw2.y), bf_hi(gw2.y)}; float y[4];
#pragma unroll
                for (int e = 0; e < 4; ++e) y[e] = o[vb][tb][4 * g4 + e] * rs * gn[e] * (g[e] * __builtin_amdgcn_rcpf(1.0f + __builtin_amdgcn_exp2f(-g[e] * 1.4426950408889634f)));
                uint2 ow; ow.x = pk2(y[0], y[1]); ow.y = pk2(y[2], y[3]); *(uint2*)(orow + (size_t)tb * 32 * 64 + c) = ow; } }
}
__device__ __forceinline__ void rec_pass3_hgrn(LAS unsigned char* wl, bf16* P, const float* LBl, const float* gainl, const bf16* ST, int unit, int lane, TilePF& pf, bool has_next) {
    const int t_l = lane & 31, hi = lane >> 5, chain = unit >> 6, n = unit & 63, b = chain / 6, h = chain % 6;
    bf16* tile = P + ((size_t)h * M + (size_t)b * T + n * 64) * 64;
    const float lbv_[2] = {LBl[h * 64 + t_l], LBl[h * 64 + 32 + t_l]};
    tile_put(wl, wl + 8192, pf, lane);
    asm volatile("s_waitcnt lgkmcnt(0)" ::: "memory");
    const int vb0 = ((lane >> 4) & 1) * 32 + (lane & 3) * 8 + (4 * hi + ((lane & 15) >> 2)) * 64;
    uint2 qwa[2][2][4];
#pragma unroll
    for (int fb = 0; fb < 2; ++fb)
#pragma unroll
        for (int tb = 0; tb < 2; ++tb)
#pragma unroll
            for (int g = 0; g < 4; ++g) qwa[fb][tb][g] = *(const uint2*)(tile + CB(PC_AQ) + (size_t)(32 * tb + t_l) * 64 + 32 * fb + 4 * hi + 8 * g);
    __builtin_amdgcn_sched_barrier(0);
    bf16x8 qt[2][2][2], kt[2][2][2], qh[2][2][2];
#pragma unroll
    for (int fb = 0; fb < 2; ++fb) {
        const float lb_l1 = lbv_[fb];
        f32x16 cumT[2];
        { const float lb = lb_l1;
          bf16x8 lfh[4], lfl[4]; s16x4 zr[4][2];
#pragma unroll
          for (int ts = 0; ts < 4; ++ts)
#pragma unroll
              for (int jj = 0; jj < 2; ++jj) zr[ts][jj] = vtr(wl + fb * 4096 + (16 * ts + 8 * jj) * 64 + vb0);
          __builtin_amdgcn_sched_barrier(0);
#pragma unroll
          for (int ts = 0; ts < 4; ++ts) { float lf[8], lo[8];
#pragma unroll
              for (int jj = 0; jj < 2; ++jj) { const s16x4 z4 = zr[ts][jj];
#pragma unroll
                  for (int e = 0; e < 4; ++e) { float kkd; hgrn_gate(s16f(z4[e]), lb, lf[4 * jj + e], kkd);
                      *(LAS unsigned short*)(wl + fb * 4096 + (16 * ts + 8 * jj + 4 * hi + e) * 64 + t_l * 2) = (unsigned short)f2bf(kkd); } }
              lfh[ts] = pack8(lf);
#pragma unroll
              for (int j = 0; j < 8; ++j) lo[j] = lf[j] - s16f(lfh[ts][j]);
              lfl[ts] = pack8(lo); }
#pragma unroll
          for (int tb = 0; tb < 2; ++tb) {
#pragma unroll
              for (int r = 0; r < 16; ++r) cumT[tb][r] = 0.f;
#pragma unroll
              for (int ts = 0; ts < 2 * tb + 2; ++ts) { const bf16x8 L = ltri_op(tb, ts, t_l, hi); cumT[tb] = MFMA32(lfh[ts], L, cumT[tb]); cumT[tb] = MFMA32(lfl[ts], L, cumT[tb]); } } }
        float cmv[16];
#pragma unroll
        for (int r = 0; r < 16; ++r) { const int ci = (int)__float_as_uint(cumT[0][r]); const float s31 = __uint_as_float((unsigned)__builtin_amdgcn_readlane(ci, 31)), s63 = __uint_as_float((unsigned)__builtin_amdgcn_readlane(ci, 63)); cmv[r] = hi ? s63 : s31; }
#pragma unroll
        for (int tb = 0; tb < 2; ++tb) {
#pragma unroll
            for (int ks = 0; ks < 2; ++ks) { float xq[8], xk[8], xh[8];
#pragma unroll
                for (int gg = 0; gg < 2; ++gg) { const int g = 2 * ks + gg;
                    const uint2 qw = qwa[fb][tb][g]; const v2u kw = *(const LAS v2u*)(wl + fb * 4096 + (32 * tb + t_l) * 64 + (8 * g + 4 * hi) * 2);
                    const float qv[4] = {bf_lo(qw.x), bf_hi(qw.x), bf_lo(qw.y), bf_hi(qw.y)}, kv[4] = {bf_lo(kw.x), bf_hi(kw.x), bf_lo(kw.y), bf_hi(kw.y)};
#pragma unroll
                    for (int e = 0; e < 4; ++e) { const int r = 4 * g + e, x = 4 * gg + e; const float kk = kv[e];
                        const float cm = cmv[r], c = cumT[tb][r];
                        xq[x] = qv[e] * __builtin_amdgcn_exp2f(c - cm); xk[x] = kk * __builtin_amdgcn_exp2f(cm - c); xh[x] = qv[e] * __builtin_amdgcn_exp2f(c); } }
                qt[tb][fb][ks] = pack8(xq); kt[tb][fb][ks] = pack8(xk); qh[tb][fb][ks] = pack8(xh);
                asm volatile("" : "+v"(qt[tb][fb][ks]), "+v"(kt[tb][fb][ks]), "+v"(qh[tb][fb][ks])); }
        }
    }
    rec_pass3_tail(wl + 8192, qt, kt, qh, ST + (size_t)unit * 4096, gainl + h * 64, tile + CB(PC_AG) + (size_t)t_l * 64, tile + CB(PC_AQ) + (size_t)t_l * 64, lane, &pf, tile + CB(PC_AF) + (has_next ? (size_t)NWAVES * 4096 : 0), tile + CB(PC_AI) + (has_next ? (size_t)NWAVES * 4096 : 0));
}
__device__ __forceinline__ void rec_pass3_ret(LAS unsigned char* wl, bf16* P, const float* gainl, const bf16* ST, int unit, int lane, TilePF& pf, bool has_next) {
    const int t_l = lane & 31, hi = lane >> 5, chain = unit >> 6, n = unit & 63, b = chain / 4, h = chain % 4;
    bf16* tile = P + ((size_t)h * M + (size_t)b * T + n * 64) * 64;
    tile_put_b(wl + 8192, pf, lane);
    asm volatile("s_waitcnt lgkmcnt(0)" ::: "memory");
    const float lg2 = __builtin_amdgcn_logf(1.0f - __builtin_amdgcn_exp2f(-5.0f - (float)h));
    bf16x8 qt[2][2][2], kt[2][2][2], qh[2][2][2];
#pragma unroll
    for (int tb = 0; tb < 2; ++tb) {
        const int t = 32 * tb + t_l; const bf16* rowp = tile + (size_t)t * 64 + 4 * hi;
        uint2 qwr[2][4], kwr[2][4];
#pragma unroll
        for (int fb = 0; fb < 2; ++fb)
#pragma unroll
            for (int g = 0; g < 4; ++g) { qwr[fb][g] = *(const uint2*)(rowp + CB(PC_CQ) + 32 * fb + 8 * g); kwr[fb][g] = *(const uint2*)(rowp + CB(PC_CK) + 32 * fb + 8 * g); }
        __builtin_amdgcn_sched_barrier(0);
        const float wq = __builtin_amdgcn_exp2f(lg2 * (float)(t - 31)), wk = __builtin_amdgcn_exp2f(lg2 * (float)(31 - t)), wh = __builtin_amdgcn_exp2f(lg2 * (float)(t + 1));
#pragma unroll
        for (int fb = 0; fb < 2; ++fb)
#pragma unroll
            for (int ks = 0; ks < 2; ++ks) { float xq[8], xk[8], xh[8];
#pragma unroll
                for (int gg = 0; gg < 2; ++gg) { const int g = 2 * ks + gg;
                    const uint2 qw = qwr[fb][g], kw = kwr[fb][g];
                    const float qv[4] = {bf_lo(qw.x), bf_hi(qw.x), bf_lo(qw.y), bf_hi(qw.y)}, kv[4] = {bf_lo(kw.x), bf_hi(kw.x), bf_lo(kw.y), bf_hi(kw.y)};
#pragma unroll
                    for (int e = 0; e < 4; ++e) { const int x = 4 * gg + e; xq[x] = qv[e] * wq; xk[x] = kv[e] * wk; xh[x] = qv[e] * wh; } }
                qt[tb][fb][ks] = pack8(xq); kt[tb][fb][ks] = pack8(xk); qh[tb][fb][ks] = pack8(xh); }
    }
    rec_pass3_tail(wl + 8192, qt, kt, qh, ST + (size_t)(N_HG_UNITS + unit) * 4096, gainl + h * 64, tile + CB(PC_CG) + (size_t)t_l * 64, tile + CB(PC_CQ) + (size_t)t_l * 64, lane, &pf, nullptr, tile + CB(PC_CV) + (has_next ? (size_t)NWAVES * 4096 : 0));
}

struct Args { const float* in[17]; float* out; unsigned char* ws; };
enum { I_X = 0, I_WIN, I_BFOX, I_QG, I_KG, I_HLB, I_HOG, I_ROG, I_WOUT, I_GMPRE, I_GMPOST, I_WUP, I_CW, I_CB, I_WDN, I_GFPRE, I_GFPOST };
typedef const __attribute__((address_space(4))) Args* CArgs;
__device__ __forceinline__ int lane_id() { return pg8::fresh_lane(); }
__device__ __forceinline__ int opaque_tid(int wave_s) { int t = wave_s * 64 + lane_id(); asm volatile("" : "+v"(t)); return t; }
__device__ __forceinline__ CArgs opaque_args() { CArgs p = (CArgs)__builtin_amdgcn_kernarg_segment_ptr(); asm volatile("" : "+s"(p)); return p; }
#define PH_BEGIN const int tid = opaque_tid(wave_s), lane = tid & 63, wave = __builtin_amdgcn_readfirstlane(tid >> 6); const int G = gridDim.x, gw = blockIdx.x * NWAVES + wave, NGW = G * NWAVES; \
    CArgs ap = opaque_args(); unsigned char* ws = ap->ws; (void)lane; (void)gw; (void)NGW; (void)ws;

#define GRID_BAR() do { XcdBarrier b_; b_.bar = (unsigned*)((gu32*)(opaque_args()->ws + WS_CTL) + CW_BAR); b_.x = xb_xcc_id(); b_.st = (volatile LAS unsigned*)(lds + MISC_OFF) + 8; xcd_barrier(b_, opaque_tid(wave_s) == 0); } while (0)
__global__ void __launch_bounds__(NWAVES * 64, 2) fwd(Args args_unused) {
    extern __shared__ __attribute__((aligned(16))) unsigned char lds_raw[];
    LAS unsigned char* lds = (LAS unsigned char*)lds_raw;
    const int wave_s = __builtin_amdgcn_readfirstlane((int)threadIdx.x >> 6);
    { volatile LAS unsigned* MISC = (volatile LAS unsigned*)(lds + MISC_OFF);
      CArgs ap0 = opaque_args();
      for (int u = threadIdx.x; u < (LDS_BYTES - LDSCTL_OFF) / 4; u += NWAVES * 64) ((LAS unsigned*)(lds + LDSCTL_OFF))[u] = 0u;
      __syncthreads();
      (void)xcd_barrier_post((unsigned*)((gu32*)(ap0->ws + WS_CTL) + CW_BAR), MISC + 8); }

    { PH_BEGIN
        bf16* WinT = (bf16*)(ws + WS_WIN); bf16* WoutT = (bf16*)(ws + WS_WOUT); bf16* WupT = (bf16*)(ws + WS_WUP); bf16* WdnT = (bf16*)(ws + WS_WDN);
        float* WF = (float*)(ws + WS_WF); float* COS = (float*)(ws + WS_COS); float* SIN = (float*)(ws + WS_SIN); float* LB = (float*)(ws + WS_LB);
        LAS float* scr = (LAS float*)(lds + wave * 16384);
        constexpr int I_IN = 16 * 128, I_OUT = 16 * 32, I_UP = 16 * 176, I_DN = 44 * 32, I_L = I_IN + I_OUT + I_UP + I_DN;
        auto tr_decode = [&](int it) -> TrP {
            const int l = it / I_L; int r = it % I_L;
            if (r < I_IN) { const int kb = r / 128, nb = r % 128; const int pc = 32 * nb; const bool rot = (pc >= PC_CQ && pc < PC_CQ + 256) || (pc >= PC_CK && pc < PC_CK + 256);
                const int scol = rot ? pcol_to_orig(pc & ~63) + ((pc & 63) >> 1) : pcol_to_orig(pc);
                return TrP{ap->in[I_WIN] + (size_t)l * D * IN_COLS, IN_COLS, scol, 64 * kb, WinT + (size_t)l * NP * D, NP, pc, ap->in[I_GMPRE] + l * D, rot, true}; }
            r -= I_IN;
            if (r < I_OUT) { const int kb = r / 32, nb = r % 32; return TrP{ap->in[I_WOUT] + (size_t)l * D * D, D, 32 * nb, 64 * kb, WoutT + (size_t)l * D * D, D, 32 * nb, nullptr, false, true}; }
            r -= I_OUT;
            if (r < I_UP) { const int kb = r / 176, nb = r % 176; const int np = 32 * nb, srcc = ((np >> 7) & 1) * D_FF + 128 * (np >> 8) + (np & 127); return TrP{ap->in[I_WUP] + (size_t)l * D * NUP, NUP, srcc, 64 * kb, WupT + (size_t)l * NUP * D, NUP, np, ap->in[I_GFPRE] + l * D, false, false}; }
            r -= I_UP;
            { const int kb = r / 32, nb = r % 32; return TrP{ap->in[I_WDN] + (size_t)l * D_FF * D, D, 32 * nb, 64 * kb, WdnT + (size_t)l * D * D_FF, D, 32 * nb, nullptr, false, true}; } };
        if (gw < DEPTH * I_L) { TrP pn = tr_decode(gw); float wn[32]; f32x4 gn[2]; tr_load(wn, gn, pn, lane);
            for (int it = gw; it < DEPTH * I_L; it += NGW) { const TrP pc = pn; float wc[32]; f32x4 gc[2] = {gn[0], gn[1]};
#pragma unroll
                for (int i = 0; i < 32; ++i) wc[i] = wn[i];
                if (it + NGW < DEPTH * I_L) { pn = tr_decode(it + NGW); tr_load(wn, gn, pn, lane); }
                asm volatile("" ::: "memory");
                tr_finish(wc, gc, pc, scr, lane); } }
        const int gt = blockIdx.x * (NWAVES * 64) + tid, NGT = G * NWAVES * 64;
        for (int i = gt; i < DEPTH * 8 * 1024; i += NGT) { const int l = i / 8192, j = (i / 1024) & 7, k = i & 1023; WF[i] = j < 6 ? ap->in[I_WIN][((size_t)l * D + k) * IN_COLS + OC_BF + j] * ap->in[I_GMPRE][l * D + k] : 0.f; }
        for (int i = gt; i < 384; i += NGT) { float v[DEPTH], mx = -1e30f;
#pragma unroll
            for (int l = 0; l < DEPTH; ++l) { v[l] = ap->in[I_HLB][l * 384 + i]; mx = fmaxf(mx, v[l]); }
            float sum = 0.f;
#pragma unroll
            for (int l = 0; l < DEPTH; ++l) { v[l] = expf(v[l] - mx); sum += v[l]; }
            float run = 0.f; const float p0 = v[0] / sum;
#pragma unroll
            for (int l = 0; l < DEPTH; ++l) { run += v[l] / sum; LB[l * 384 + i] = run - p0; } }
        for (int i = gt; i < T * 32; i += NGT) { const int t = i >> 5, f = i & 31;
            const float invf = 1.0f / (float)exp2((double)f * (13.287712379549449 / 32.0));
            const float ang = (float)t * invf; const double rev = (double)ang * 0.15915494309189535; const float fr = (float)(rev - floor(rev));
            COS[i] = __builtin_amdgcn_cosf(fr); SIN[i] = __builtin_amdgcn_sinf(fr); }
        __syncthreads();
        { LAS float* wf0 = (LAS float*)lds;
          for (int i = tid; i < 6 * 1024; i += NWAVES * 64) { const int j = i >> 10, k = i & 1023; wf0[i] = ap->in[I_WIN][(size_t)k * IN_COLS + OC_BF + j] * ap->in[I_GMPRE][k]; } }
        __syncthreads();
        { f32x4 nx[4][4];
#pragma unroll
          for (int r = 0; r < 4; ++r)
#pragma unroll
              for (int j = 0; j < 4; ++j) nx[r][j] = *(const f32x4*)(ap->in[I_X] + (size_t)(4 * gw + r) * D + 4 * lane + 256 * j);
          for (int m = 4 * gw; m < M; m += 4 * NGW) { f32x4 cur[4][4];
#pragma unroll
              for (int r = 0; r < 4; ++r)
#pragma unroll
                  for (int j = 0; j < 4; ++j) cur[r][j] = nx[r][j];
              const int mn = (m + 4 * NGW < M) ? m + 4 * NGW : m;
#pragma unroll
              for (int r = 0; r < 4; ++r)
#pragma unroll
                  for (int j = 0; j < 4; ++j) nx[r][j] = *(const f32x4*)(ap->in[I_X] + (size_t)(mn + r) * D + 4 * lane + 256 * j);
              asm volatile("" ::: "memory");
              row_updateNx<4>(lane, (size_t)m, (size_t)1, ap->in[I_X], nullptr, nullptr, nullptr, (bf16*)(ws + WS_XB), nullptr, (float*)(ws + WS_RS), (const float*)lds_raw, ap->in[I_BFOX], (float*)(ws + WS_LOGF), cur); } }
    }
    GRID_BAR();

#pragma unroll 1
    for (int l = 0; l < DEPTH; ++l) {
        { PH_BEGIN
          int bxq = (int)blockIdx.x; asm volatile("" : "+s"(bxq));
          if (bxq < 96) {
            const float* LOGF = (const float*)(ws + WS_LOGF); float* FCUM = (float*)(ws + WS_FCUM);
            const int sq = bxq, b = sq / 6, h = sq % 6; const float* lf = LOGF + ((size_t)b * T + 512 * wave + lane) * 8 + h; float* Fo = FCUM + (size_t)sq * T + 512 * wave + lane;
            float sv[8]; float carry = 0.f;
#pragma unroll
            for (int i = 0; i < 8; ++i) sv[i] = lf[(size_t)i * 512];
#pragma unroll
            for (int i = 0; i < 8; ++i) { float v = sv[i];
                v += dppf<0x111>(v); v += dppf<0x112>(v); v += dppf<0x114>(v); v += dppf<0x118>(v);
                v += __uint_as_float((unsigned)__builtin_amdgcn_update_dpp(0, (int)__float_as_uint(v), 0x142, 0xA, 0xF, false));
                v += __uint_as_float((unsigned)__builtin_amdgcn_update_dpp(0, (int)__float_as_uint(v), 0x143, 0xC, 0xF, false));
                v += carry; sv[i] = v; carry = __uint_as_float((unsigned)__builtin_amdgcn_readlane((int)__float_as_uint(v), 63)); }
            LAS float* tot = (LAS float*)(lds + MISC_OFF + 128);
            if (lane == 0) tot[wave] = carry;
            __syncthreads();
            const f32x4 t0 = *(const LAS f32x4*)tot, t1 = *(const LAS f32x4*)(tot + 4);
            const float off = (wave > 0 ? t0[0] : 0.f) + (wave > 1 ? t0[1] : 0.f) + (wave > 2 ? t0[2] : 0.f) + (wave > 3 ? t0[3] : 0.f) + (wave > 4 ? t1[0] : 0.f) + (wave > 5 ? t1[1] : 0.f) + (wave > 6 ? t1[2] : 0.f);
#pragma unroll
            for (int i = 0; i < 8; ++i) Fo[i * 64] = sv[i] + off;
            __syncthreads(); }
          pg8::Gemm g{(const bf16*)(ws + WS_XB), (const bf16*)(ws + WS_WIN) + (size_t)l * NP * D, M, NP, D, 64, 64, (size_t)M * 64 * 2, (size_t)NP * 64 * 2}; pg8::StaticOrder S; S.init(M, NP, G, (int)blockIdx.x);
          pg8::EpiBf16RS E{(bf16*)(ws + WS_P), M, (const float*)(ws + WS_RS), (const float*)(ws + WS_COS), (const float*)(ws + WS_SIN), PC_CQ / 256, PC_CK / 256, lds + HALO_OFF};
          pg8::gemm_phase<pg8::EpiBf16RS, pg8::StaticOrder, true, true>(lds, g, S, E, tid); }
        GRID_BAR();
        { PH_BEGIN
          bf16* P = (bf16*)(ws + WS_P); LAS unsigned char* wl = lds + wave * 16384;
          const bool helpers = (G >= 256);
          gu32* hflag = (gu32*)(ws + WS_CTL) + CW_FLAGS + (l * 96) * 16;
          if (blockIdx.x < 160) {
              const int chain = blockIdx.x;
              if (chain < 96) { const int nend = helpers ? 32 : 64; TilePF pf; { const bf16* t0 = hgrn_tile(P, chain * 64 + wave); tile_fetch(pf, t0 + CB(PC_AF), t0 + CB(PC_AI), lane); }
                  for (int n = wave; n < nend; n += NWAVES) rec_pass1_hgrn<false>(wl, P, (const float*)(ws + WS_LB) + l * 384, (bf16*)(ws + WS_U), (float*)(ws + WS_DK), chain * 64 + n, lane, pf, n + NWAVES < nend); }
              else { TilePF pf; { const bf16* t0 = ret_tile(P, (chain - 96) * 64 + wave); tile_fetch(pf, t0 + CB(PC_CK), t0 + CB(PC_CV), lane); }
                  for (int n = wave; n < 64; n += NWAVES) rec_pass1_ret(wl, P, (bf16*)(ws + WS_U), (chain - 96) * 64 + n, lane, pf, n + NWAVES < 64); }
              asm volatile("s_waitcnt vmcnt(0)" ::: "memory"); __syncthreads();
              if (chain < 96 && helpers) {
                  if (tid == 0) { unsigned sp = 0u; while (__hip_atomic_load(hflag + chain * 16, RLX_AGENT) == 0u) { __builtin_amdgcn_s_sleep(2); if (++sp > (1u << 22)) break; }
                      __builtin_amdgcn_fence(__ATOMIC_ACQUIRE, "agent"); asm volatile("s_waitcnt vmcnt(0)" ::: "memory"); }
                  __syncthreads(); }
              rec_pass2_chain((const bf16*)(ws + WS_U), (const float*)(ws + WS_DK), (bf16*)(ws + WS_ST), chain, tid);
              asm volatile("s_waitcnt vmcnt(0)" ::: "memory"); __syncthreads();
              if (chain < 96) { TilePF pf; { const bf16* t0 = hgrn_tile(P, chain * 64 + wave); tile_fetch(pf, t0 + CB(PC_AF), t0 + CB(PC_AI), lane); }
                  for (int n = wave; n < 64; n += NWAVES) rec_pass3_hgrn(wl, P, (const float*)(ws + WS_LB) + l * 384, ap->in[I_HOG] + l * 384, (const bf16*)(ws + WS_ST), chain * 64 + n, lane, pf, n + NWAVES < 64); }
              else { TilePF pf; tile_fetch_b(pf, ret_tile(P, (chain - 96) * 64 + wave) + CB(PC_CV), lane);
                  for (int n = wave; n < 64; n += NWAVES) rec_pass3_ret(wl, P, ap->in[I_ROG] + l * 256, (const bf16*)(ws + WS_ST), (chain - 96) * 64 + n, lane, pf, n + NWAVES < 64); }
              __syncthreads();
          } else if (helpers && blockIdx.x < 256) {
              const int chain = blockIdx.x - 160;
              TilePF pf; { const bf16* t0 = hgrn_tile(P, chain * 64 + 32 + wave); tile_fetch(pf, t0 + CB(PC_AF), t0 + CB(PC_AI), lane); }
              for (int n = 32 + wave; n < 64; n += NWAVES) rec_pass1_hgrn<true>(wl, P, (const float*)(ws + WS_LB) + l * 384, (bf16*)(ws + WS_U), (float*)(ws + WS_DK), chain * 64 + n, lane, pf, n + NWAVES < 64);
              asm volatile("s_waitcnt vmcnt(0)" ::: "memory"); __syncthreads();
              if (tid == 0) __hip_atomic_store(hflag + chain * 16, 1u, RLX_AGENT);
              __syncthreads();
          }
          float gq = fabsf(ap->in[I_QG][l * 64 + lane]), gk = fabsf(ap->in[I_KG][l * 64 + lane]);
          gq = fmaxf(gq, dppf<0xB1>(gq)); gq = fmaxf(gq, dppf<0x4E>(gq)); gq = fmaxf(gq, dppf<0x141>(gq)); gq = fmaxf(gq, dppf<0x140>(gq));
          gk = fmaxf(gk, dppf<0xB1>(gk)); gk = fmaxf(gk, dppf<0x4E>(gk)); gk = fmaxf(gk, dppf<0x141>(gk)); gk = fmaxf(gk, dppf<0x140>(gk));
          { auto rl = [](float v, int ln) { return __uint_as_float((unsigned)__builtin_amdgcn_readlane((int)__float_as_uint(v), ln)); };
            gq = fmaxf(fmaxf(rl(gq, 0), rl(gq, 16)), fmaxf(rl(gq, 32), rl(gq, 48))); gk = fmaxf(fmaxf(rl(gk, 0), rl(gk, 16)), fmaxf(rl(gk, 32), rl(gk, 48))); }
          const float bound2 = 2.0f * (8.0f * gq * 0.125f * 1.4426950408889634f * 1.004f) * (8.0f * gk * 1.004f);
          attn_v3(lds, P, (const float*)(ws + WS_FCUM), tid, (unsigned*)((gu32*)(ws + WS_CTL) + CW_QUEUE + 128 * l), bound2, ap->in[I_QG] + l * 64, ap->in[I_KG] + l * 64); }
        GRID_BAR();
        { PH_BEGIN
          pg8::Gemm g{(const bf16*)(ws + WS_P), (const bf16*)(ws + WS_WOUT) + (size_t)l * D * D, M, D, D, 64, 64, (size_t)M * 64 * 2, (size_t)D * 64 * 2}; pg8::StaticOrder S; S.init(M, D, G, (int)blockIdx.x);
          { LAS float* gl = (LAS float*)(lds + GAIN_OFF); const float* gsrc = ap->in[I_GMPOST] + l * D; gl[tid] = gsrc[tid]; gl[tid + 512] = gsrc[tid + 512]; }
          pg8::EpiNormRes E{(bf16*)(ws + WS_XB), (const LAS float*)(lds + GAIN_OFF), (float*)(ws + WS_SLOT1), (unsigned*)((gu32*)(ws + WS_CTL) + CW_CNT + (l * 4 + 0) * 4096),
                            (float*)(ws + WS_RS), (LAS float*)(lds + HALO_OFF)};
          pg8::gemm_phase<pg8::EpiNormRes, pg8::StaticOrder, true, true>(lds, g, S, E, tid); }
        GRID_BAR();
        { PH_BEGIN
          pg8::Gemm g{(const bf16*)(ws + WS_XB), (const bf16*)(ws + WS_WUP) + (size_t)l * NUP * D, M, NUP, D, 64, 64, (size_t)M * 64 * 2, (size_t)NUP * 64 * 2}; pg8::StaticOrder S; S.init(M, NUP, G, (int)blockIdx.x);
          pg8::EpiConvAct E{(bf16*)(ws + WS_ACT), ap->in[I_CW] + (size_t)l * 3 * NUP, ap->in[I_CB] + (size_t)l * NUP, (float*)(ws + WS_EDGEL), (float*)(ws + WS_EDGEP), lds + HALO_OFF, D_FF, (const float*)(ws + WS_RS), (size_t)M * 64, lds + RING_BYTES + 10240};
          pg8::gemm_phase<pg8::EpiConvAct, pg8::StaticOrder, true, true>(lds, g, S, E, tid); }
        GRID_BAR();
        { PH_BEGIN
          pg8::Gemm g{(const bf16*)(ws + WS_ACT), (const bf16*)(ws + WS_WDN) + (size_t)l * D * D_FF, M, D, D_FF, 64, 64, (size_t)M * 64 * 2, (size_t)D * 64 * 2}; pg8::StaticOrder S; S.init(M, D, G, (int)blockIdx.x);
          { const float* EL = (const float*)(ws + WS_EDGEL); const float* EP = (const float*)(ws + WS_EDGEP); bf16* ACT = (bf16*)(ws + WS_ACT);
            const float* cw = ap->in[I_CW] + (size_t)l * 3 * NUP; pg8::Unit fu;
            int pmA = 0, pmB = 0, pmC = 0, pmD = 0, mypn = 0;
            if (S.next(0, fu)) { pmA = fu.pm; mypn = fu.pn; } if (S.next(1, fu)) pmB = fu.pm; if (S.next(2, fu)) pmC = fu.pm; if (S.next(3, fu)) pmD = fu.pm;
#pragma unroll 1
            for (int kb = 0; kb < 6; kb += 3) {
            float fw[3][4], fl[3][4], fp[3][4];
#pragma unroll
            for (int k = 0; k < 3; ++k) { const int j_ = tid + (kb + k) * (NWAVES * 64), j = j_ < 4 * 704 ? j_ : 4 * 704 - 1; const int ui = j / 704, ch = 704 * mypn + j % 704;
                const int pm_ = ui == 0 ? pmA : ui == 1 ? pmB : ui == 2 ? pmC : pmD, pm = (pm_ & 15) == 0 ? pm_ + 1 : pm_;
                const int ng = 256 * (ch >> 7) + (ch & 127), nv = ng + 128;
                fw[k][0] = cw[ch]; fw[k][1] = cw[NUP + ch]; fw[k][2] = cw[D_FF + ch]; fw[k][3] = cw[NUP + D_FF + ch];
                fl[k][0] = EL[(size_t)((pm - 1) * 2 + 0) * NUP + ng]; fl[k][1] = EL[(size_t)((pm - 1) * 2 + 1) * NUP + ng]; fl[k][2] = EL[(size_t)((pm - 1) * 2 + 0) * NUP + nv]; fl[k][3] = EL[(size_t)((pm - 1) * 2 + 1) * NUP + nv];
                fp[k][0] = EP[(size_t)(pm * 2 + 0) * NUP + ng]; fp[k][1] = EP[(size_t)(pm * 2 + 0) * NUP + nv]; fp[k][2] = EP[(size_t)(pm * 2 + 1) * NUP + ng]; fp[k][3] = EP[(size_t)(pm * 2 + 1) * NUP + nv]; }
            asm volatile("" ::: "memory");
#pragma unroll
            for (int k = 0; k < 3; ++k) { const int j = tid + (kb + k) * (NWAVES * 64); const int ui = j / 704, ch = 704 * mypn + j % 704; const int pm = ui == 0 ? pmA : ui == 1 ? pmB : ui == 2 ? pmC : pmD;
                if (j < 4 * 704 && (pm & 15) != 0) {
                    const float g0 = fp[k][0] + fw[k][0] * fl[k][0] + fw[k][1] * fl[k][1], v0 = fp[k][1] + fw[k][2] * fl[k][2] + fw[k][3] * fl[k][3];
                    const float g1 = fp[k][2] + fw[k][0] * fl[k][1], v1 = fp[k][3] + fw[k][2] * fl[k][3];
                    __hip_atomic_store(ACT + ((size_t)(ch >> 6) * M + (pm * 256 + 0)) * 64 + (ch & 63), (bf16)f2bf(g0 / (1.0f + __expf(-g0)) * v0), RLX_AGENT);
                    __hip_atomic_store(ACT + ((size_t)(ch >> 6) * M + (pm * 256 + 1)) * 64 + (ch & 63), (bf16)f2bf(g1 / (1.0f + __expf(-g1)) * v1), RLX_AGENT); } } }
            asm volatile("s_waitcnt vmcnt(0)" ::: "memory"); __syncthreads();
            if (tid == 0) { gu32* fc = (gu32*)(ws + WS_CTL) + CW_FIX + l * 4096 + pmA * 16; __hip_atomic_fetch_add(fc, 1u, RLX_AGENT);
                unsigned sp = 0u; while (__hip_atomic_load(fc, RLX_AGENT) < 4u) { __builtin_amdgcn_s_sleep(2); if (++sp > (1u << 22)) break; }
                __builtin_amdgcn_fence(__ATOMIC_ACQUIRE, "agent"); asm volatile("s_waitcnt vmcnt(0)" ::: "memory"); }
            __syncthreads(); }
          const bool last = (l == DEPTH - 1);
          pg8::EpiNormResFFN E{(bf16*)(ws + WS_XB), ap->in[I_GFPOST] + l * D, (float*)(ws + WS_SLOT1), (unsigned*)((gu32*)(ws + WS_CTL) + CW_CNT + (l * 4 + 2) * 4096), (float*)(ws + WS_RS), (LAS float*)(lds + HALO_OFF),
                               last ? ap->out : nullptr, (const float*)(ws + WS_WF) + (l + 1) * 8192, ap->in[I_BFOX] + (l + 1) * 6, (float*)(ws + WS_LPART), (unsigned*)((gu32*)(ws + WS_CTL) + CW_CNT + (l * 4 + 3) * 4096),
                               (float*)(ws + WS_LOGF), (LAS float*)(lds + LGL_OFF)};
          pg8::gemm_phase<pg8::EpiNormResFFN, pg8::StaticOrder, true, true>(lds, g, S, E, tid); }
        if (l < DEPTH - 1) GRID_BAR();
    }
}

extern "C" void kernel_launch(void* const* d_in, const int* in_sizes, int n_in, void* d_out, int out_size, void* d_ws, size_t ws_size, hipStream_t stream) {
    static int grid = 0;
    if (grid == 0) {
        if (n_in != 17 || in_sizes[0] != M * D || out_size != M * D || ws_size < WS_END) { fprintf(stderr, "kernel_launch: unexpected shapes (n_in %d, in0 %d, out %d, ws %zu)\n", n_in, n_in > 0 ? in_sizes[0] : -1, out_size, ws_size); grid = -1; return; }
        int dev = 0, cus = 0;
        if (hipGetDevice(&dev) != hipSuccess || hipDeviceGetAttribute(&cus, hipDeviceAttributeMultiprocessorCount, dev) != hipSuccess) { grid = -1; return; }
        if (hipFuncSetAttribute((const void*)fwd, hipFuncAttributeMaxDynamicSharedMemorySize, LDS_BYTES) != hipSuccess) { grid = -1; return; }
        (void)hipGetLastError();
        grid = cus;
    }
    if (grid < 0) return;
    if (hipMemsetAsync((char*)d_ws + WS_CTL, 0, CTL_ZERO_BYTES, stream) != hipSuccess) return;
    Args a{};
    for (int i = 0; i < 17; ++i) a.in[i] = (const float*)d_in[i];
    a.out = (float*)d_out; a.ws = (unsigned char*)d_ws;
    hipLaunchKernelGGL(fwd, dim3(grid), dim3(NWAVES * 64), LDS_BYTES, stream, a);
}
```
